# Optimizing an MI355X kernel written in HIP

```python
import math
import jax, jax.numpy as jnp
from jax import lax
import numpy as np

D_MODEL = 1024
BATCH = 8
SEQ = 2048
DEPTH = 2
DEC_BATCH = 128
DEC_SEQ = 4
PAST_LEN = 16384
PAGE_SIZE = 128

RET_HEADS = 4
RET_DK = D_MODEL // 8
RET_DV = D_MODEL // 4
RET_QK = RET_HEADS * RET_DK
RET_V = RET_HEADS * RET_DV
HG_HEADS = 8
HG_DK = D_MODEL // HG_HEADS
HG_DV = D_MODEL // HG_HEADS
HG_W = HG_HEADS * HG_DK
LRU_W = D_MODEL
LRU_BLOCKS = 8
LRU_BD = LRU_W // LRU_BLOCKS
CONV_W = 4
LRU_C = 8.0
N_BRANCH = 3
FFN_HIDDEN = 2816
CHUNK = 64
ROPE_BASE = 10000.0
EPS = 1e-6
IN_SPLITS = (RET_QK, RET_QK, RET_V, RET_V, HG_W, HG_W, HG_W, HG_W, LRU_W, LRU_W, N_BRANCH * D_MODEL)
IN_WIDTH = sum(IN_SPLITS)

kernel_name = "hybrid_retention_hgrn2_rglru_decode_step"


def _rmsnorm(x, g):
    xf = x.astype(jnp.float32)
    y = xf * lax.rsqrt(jnp.mean(xf * xf, axis=-1, keepdims=True) + EPS)
    return (y * g.astype(jnp.float32)).astype(x.dtype)


def _head_rms(x):
    return x * lax.rsqrt(jnp.mean(x * x, axis=-1, keepdims=True) + EPS)


def _swiglu(x, wg, wu, wd):
    return (jax.nn.silu(x @ wg) * (x @ wu)) @ wd


def _split(z):
    out = []
    o = 0
    for w in IN_SPLITS:
        out.append(z[..., o:o + w])
        o += w
    return out


def _rotary(x, pos):
    d = x.shape[-1]
    inv = ROPE_BASE ** (-jnp.arange(0, d, 2, dtype=jnp.float32) / d)
    ang = pos.astype(jnp.float32)[:, None] * inv[None, :]
    cos = jnp.cos(ang)[None, :, None, :]
    sin = jnp.sin(ang)[None, :, None, :]
    x1, x2 = x[..., : d // 2], x[..., d // 2:]
    return jnp.concatenate([x1 * cos - x2 * sin, x1 * sin + x2 * cos], axis=-1)


def _chunk_len(t):
    return CHUNK if t % CHUNK == 0 else t


def _to_chunks(x, c):
    b, t, h, d = x.shape
    return x.reshape(b, t // c, c, h, d).transpose(1, 0, 3, 2, 4)


def _from_chunks(y):
    n, b, h, c, d = y.shape
    return y.transpose(1, 0, 3, 2, 4).reshape(b, n * c, h, d)


def _retention(q, k, v, state):
    c = _chunk_len(q.shape[1])
    log_g = jnp.log1p(-jnp.exp2(-5.0 - jnp.arange(RET_HEADS, dtype=jnp.float32)))
    idx = jnp.arange(c, dtype=jnp.float32)
    diff = idx[:, None] - idx[None, :]
    causal = diff >= 0
    d_intra = jnp.where(causal, jnp.exp(log_g[:, None, None] * jnp.where(causal, diff, 0.0)), 0.0)
    q_dec = jnp.exp(log_g[:, None] * (idx + 1.0))[:, :, None]
    k_dec = jnp.exp(log_g[:, None] * (c - 1.0 - idx))[:, :, None]
    s_dec = jnp.exp(log_g * c)[:, None, None]

    def step(s, inp):
        qc, kc, vc = inp
        scores = jnp.einsum('bhtd,bhsd->bhts', qc, kc) * d_intra
        o = jnp.einsum('bhts,bhsv->bhtv', scores, vc) + jnp.einsum('bhtd,bhdv->bhtv', qc * q_dec, s)
        s = s * s_dec + jnp.einsum('bhsd,bhsv->bhdv', kc * k_dec, vc)
        return s, o

    s_fin, o = lax.scan(step, state, (_to_chunks(q, c), _to_chunks(k, c), _to_chunks(v, c)))
    return _from_chunks(o), s_fin


def _hgrn2(q, log_f, k, v, state):
    c = _chunk_len(q.shape[1])
    tri = jnp.tril(jnp.ones((c, c), dtype=bool))[:, :, None]

    def step(s, inp):
        qc, gc, kc, vc = inp
        b = jnp.cumsum(gc, axis=2)
        rel = jnp.where(tri, b[:, :, :, None, :] - b[:, :, None, :, :], -jnp.inf)
        a = jnp.einsum('bhtd,bhsd,bhtsd->bhts', qc, kc, jnp.exp(rel))
        o = jnp.einsum('bhts,bhsv->bhtv', a, vc) + jnp.einsum('bhtd,bhdv->bhtv', qc * jnp.exp(b), s)
        bl = b[:, :, -1:, :]
        s = s * jnp.exp(bl[:, :, 0, :, None]) + jnp.einsum('bhsd,bhsv->bhdv', kc * jnp.exp(bl - b), vc)
        return s, o

    s_fin, o = lax.scan(step, state, (_to_chunks(q, c), _to_chunks(log_f, c), _to_chunks(k, c), _to_chunks(v, c)))
    return _from_chunks(o), s_fin


def _causal_conv(x, buf, w, b):
    t = x.shape[1]
    xx = jnp.concatenate([buf, x], axis=1)
    y = b + sum(xx[:, i:i + t] * w[i] for i in range(CONV_W))
    return y, xx[:, xx.shape[1] - (CONV_W - 1):]


def _block_diag(x, w, b):
    bsz, t, _ = x.shape
    y = jnp.einsum('btnd,nde->btne', x.reshape(bsz, t, LRU_BLOCKS, LRU_BD), w)
    return y.reshape(bsz, t, LRU_W) + b


def _lin_combine(c1, c2):
    a1, b1 = c1
    a2, b2 = c2
    return a1 * a2, a2 * b1 + b2


def _rg_lru(x, h0, w_a, b_a, w_x, b_x, lam):
    r = jax.nn.sigmoid(_block_diag(x, w_a, b_a))
    i = jax.nn.sigmoid(_block_diag(x, w_x, b_x))
    log_a = -LRU_C * r * jax.nn.softplus(-lam)
    a = jnp.exp(log_a)
    u = jnp.sqrt(-jnp.expm1(2.0 * log_a)) * (i * x)
    u = u.at[:, 0].add(a[:, 0] * h0)
    _, hs = lax.associative_scan(_lin_combine, (a, u), axis=1)
    return hs, hs[:, -1]


def _mixer(h, pos, l, ret_s, hg_s, lru_h, conv_buf, p):
    f32 = jnp.float32
    bsz, t, _ = h.shape
    z = (h @ p['w_in'][l]).astype(f32)
    q_r, k_r, v_r, g_r, q_h, f_h, i_h, g_h, x_l, g_l, gate = _split(z)
    q = _rotary(q_r.reshape(bsz, t, RET_HEADS, RET_DK), pos)
    k = _rotary(k_r.reshape(bsz, t, RET_HEADS, RET_DK), pos) * (RET_DK ** -0.5)
    v = v_r.reshape(bsz, t, RET_HEADS, RET_DV)
    o_r, ret_new = _retention(q, k, v, ret_s.astype(f32))
    o_r = _head_rms(o_r).reshape(bsz, t, RET_V) * jax.nn.silu(g_r)
    br_r = (o_r.astype(h.dtype) @ p['w_ret_o'][l]).astype(f32)
    lbs = jnp.cumsum(jax.nn.softmax(p['hgrn_lb_logits'].astype(f32), axis=0), axis=0)
    lb = lbs[l] - lbs[0]
    log_f = jnp.logaddexp(jnp.log(lb), jnp.log1p(-lb) + jax.nn.log_sigmoid(f_h))
    k_h = -jnp.expm1(log_f)
    o_h, hg_new = _hgrn2(jax.nn.silu(q_h).reshape(bsz, t, HG_HEADS, HG_DK),
                         log_f.reshape(bsz, t, HG_HEADS, HG_DK),
                         k_h.reshape(bsz, t, HG_HEADS, HG_DK),
                         i_h.reshape(bsz, t, HG_HEADS, HG_DV), hg_s.astype(f32))
    o_h = _head_rms(o_h) * p['hgrn_norm'][l].astype(f32).reshape(HG_HEADS, HG_DV)
    o_h = o_h.reshape(bsz, t, HG_W) * jax.nn.silu(g_h)
    br_h = (o_h.astype(h.dtype) @ p['w_hgrn_o'][l]).astype(f32)
    xc, conv_new = _causal_conv(x_l, conv_buf.astype(f32), p['conv_w'][l].astype(f32), p['conv_b'][l].astype(f32))
    hs, h_new = _rg_lru(xc, lru_h.astype(f32), p['lru_w_a'][l].astype(f32), p['lru_b_a'][l].astype(f32),
                        p['lru_w_x'][l].astype(f32), p['lru_b_x'][l].astype(f32), p['lru_lambda'][l].astype(f32))
    br_l = ((hs * jax.nn.gelu(g_l)).astype(h.dtype) @ p['w_lru_o'][l]).astype(f32)
    gs = jax.nn.sigmoid(gate.reshape(bsz, t, N_BRANCH, D_MODEL) + p['merge_bias'][l].astype(f32))
    merged = gs[:, :, 0] * br_r + gs[:, :, 1] * br_h + gs[:, :, 2] * br_l
    out = merged.astype(h.dtype) @ p['w_mix_out'][l]
    return out, (ret_new, hg_new, h_new, conv_new)


def _trunk(x, pos, ret_s, hg_s, lru_h, conv_buf, p):
    news = ([], [], [], [])
    for l in range(DEPTH):
        x = x + 0.5 * _swiglu(_rmsnorm(x, p['ffn1_norm'][l]), p['ffn1_w_gate'][l], p['ffn1_w_up'][l], p['ffn1_w_down'][l])
        m, st = _mixer(_rmsnorm(x, p['mix_norm'][l]), pos, l, ret_s[l], hg_s[l], lru_h[l], conv_buf[l], p)
        x = x + m.astype(x.dtype)
        x = x + 0.5 * _swiglu(_rmsnorm(x, p['ffn2_norm'][l]), p['ffn2_w_gate'][l], p['ffn2_w_up'][l], p['ffn2_w_down'][l])
        for acc, s in zip(news, st):
            acc.append(s)
    y = _rmsnorm(x, p['final_norm'])
    return y, [jnp.stack(a, axis=0) for a in news]


def setup_inputs(seed: int = 0) -> dict:
    key = jax.random.key(seed)
    ks = iter(jax.random.split(key, 48))
    nrm = lambda shape, s: jax.random.normal(next(ks), shape, jnp.float32) * s
    gain = lambda shape: 1.0 + 0.01 * jax.random.normal(next(ks), shape, jnp.float32)
    d, f = D_MODEL, FFN_HIDDEN
    a0 = jax.random.uniform(next(ks), (DEPTH, LRU_W), jnp.float32, 0.9, 0.999)
    inp = {
        'x_prompt': nrm((BATCH, SEQ, d), 1.0),
        'x_sample': nrm((DEC_BATCH, DEC_SEQ, d), 1.0),
        'state_ret': nrm((DEPTH, DEC_BATCH, RET_HEADS, RET_DK, RET_DV), 1.0),
        'state_hgrn': nrm((DEPTH, DEC_BATCH, HG_HEADS, HG_DK, HG_DV), 1.0),
        'state_lru': nrm((DEPTH, DEC_BATCH, LRU_W), 0.5),
        'state_conv': nrm((DEPTH, DEC_BATCH, CONV_W - 1, LRU_W), 1.0),
        'ffn1_norm': gain((DEPTH, d)),
        'ffn1_w_gate': nrm((DEPTH, d, f), d ** -0.5),
        'ffn1_w_up': nrm((DEPTH, d, f), d ** -0.5),
        'ffn1_w_down': nrm((DEPTH, f, d), f ** -0.5),
        'mix_norm': gain((DEPTH, d)),
        'w_in': nrm((DEPTH, d, IN_WIDTH), d ** -0.5),
        'merge_bias': nrm((DEPTH, N_BRANCH, d), 0.01),
        'w_ret_o': nrm((DEPTH, RET_V, d), RET_V ** -0.5),
        'hgrn_lb_logits': nrm((DEPTH, HG_W), 0.5),
        'hgrn_norm': gain((DEPTH, HG_W)),
        'w_hgrn_o': nrm((DEPTH, HG_W, d), HG_W ** -0.5),
        'conv_w': nrm((DEPTH, CONV_W, LRU_W), CONV_W ** -0.5),
        'conv_b': nrm((DEPTH, LRU_W), 0.01),
        'lru_w_a': nrm((DEPTH, LRU_BLOCKS, LRU_BD, LRU_BD), LRU_BD ** -0.5),
        'lru_b_a': nrm((DEPTH, LRU_W), 0.01),
        'lru_w_x': nrm((DEPTH, LRU_BLOCKS, LRU_BD, LRU_BD), LRU_BD ** -0.5),
        'lru_b_x': nrm((DEPTH, LRU_W), 0.01),
        'lru_lambda': jnp.log(a0) - jnp.log1p(-a0),
        'w_lru_o': nrm((DEPTH, LRU_W, d), LRU_W ** -0.5),
        'w_mix_out': nrm((DEPTH, d, d), d ** -0.5),
        'ffn2_norm': gain((DEPTH, d)),
        'ffn2_w_gate': nrm((DEPTH, d, f), d ** -0.5),
        'ffn2_w_up': nrm((DEPTH, d, f), d ** -0.5),
        'ffn2_w_down': nrm((DEPTH, f, d), f ** -0.5),
        'final_norm': gain((d,)),
    }
    return inp


def reference(x_prompt, x_sample, state_ret, state_hgrn, state_lru, state_conv,
              ffn1_norm, ffn1_w_gate, ffn1_w_up, ffn1_w_down, mix_norm, w_in, merge_bias,
              w_ret_o, hgrn_lb_logits, hgrn_norm, w_hgrn_o, conv_w, conv_b,
              lru_w_a, lru_b_a, lru_w_x, lru_b_x, lru_lambda, w_lru_o, w_mix_out,
              ffn2_norm, ffn2_w_gate, ffn2_w_up, ffn2_w_down, final_norm):
    p = dict(ffn1_norm=ffn1_norm, ffn1_w_gate=ffn1_w_gate, ffn1_w_up=ffn1_w_up, ffn1_w_down=ffn1_w_down,
             mix_norm=mix_norm, w_in=w_in, merge_bias=merge_bias, w_ret_o=w_ret_o,
             hgrn_lb_logits=hgrn_lb_logits, hgrn_norm=hgrn_norm, w_hgrn_o=w_hgrn_o,
             conv_w=conv_w, conv_b=conv_b, lru_w_a=lru_w_a, lru_b_a=lru_b_a,
             lru_w_x=lru_w_x, lru_b_x=lru_b_x, lru_lambda=lru_lambda, w_lru_o=w_lru_o,
             w_mix_out=w_mix_out, ffn2_norm=ffn2_norm, ffn2_w_gate=ffn2_w_gate,
             ffn2_w_up=ffn2_w_up, ffn2_w_down=ffn2_w_down, final_norm=final_norm)
    f32 = jnp.float32
    bp = x_prompt.shape[0]
    pos_p = jnp.arange(x_prompt.shape[1])
    z_ret = jnp.zeros((DEPTH, bp, RET_HEADS, RET_DK, RET_DV), f32)
    z_hg = jnp.zeros((DEPTH, bp, HG_HEADS, HG_DK, HG_DV), f32)
    z_h = jnp.zeros((DEPTH, bp, LRU_W), f32)
    z_cv = jnp.zeros((DEPTH, bp, CONV_W - 1, LRU_W), f32)
    y_prompt, st_p = _trunk(x_prompt, pos_p, z_ret, z_hg, z_h, z_cv, p)
    pos_s = PAST_LEN + jnp.arange(x_sample.shape[1])
    y_sample, st_s = _trunk(x_sample, pos_s, state_ret, state_hgrn, state_lru, state_conv, p)
    dt = x_prompt.dtype
    return (y_prompt, y_sample,
            st_p[0].astype(dt), st_s[0].astype(state_ret.dtype),
            st_p[1].astype(dt), st_s[1].astype(state_hgrn.dtype),
            st_p[2].astype(dt), st_s[2].astype(state_lru.dtype),
            st_p[3].astype(dt), st_s[3].astype(state_conv.dtype))
```

```cpp
#include <hip/hip_runtime.h>
#include <hip/hip_cooperative_groups.h>
#include <cstdio>
namespace cg = cooperative_groups;

#define LAS __attribute__((address_space(3)))
typedef unsigned short bf16_t;
typedef short bf16x8 __attribute__((ext_vector_type(8)));
typedef short s16x4 __attribute__((ext_vector_type(4)));
typedef float f32x4 __attribute__((ext_vector_type(4)));
typedef unsigned u32x4 __attribute__((ext_vector_type(4)));
typedef unsigned u32x2 __attribute__((ext_vector_type(2)));

constexpr int T_ALL = 16896, T_P = 16384, DM = 1024, FH = 2816, NZ = 12288;
constexpr int LDS_BYTES = 163840;
constexpr size_t OFF_GU1 = 0, OFF_D1 = 5767168, OFF_WIN = 8650752, OFF_RO = 21233664, OFF_HO = 22282240, OFF_LO = 23330816,
                 OFF_MO = 24379392, OFF_GU2 = 25427968, OFF_D2 = 31195136, W_LAYER = 34078720;
constexpr size_t WS_W = 0, WS_XB = 2 * W_LAYER * 2, WS_Z = WS_XB + (size_t)T_ALL * DM * 2, WS_SS = WS_Z + (size_t)T_ALL * NZ * 2,
                 WS_ROPE = WS_SS + (size_t)8 * T_ALL * 4, WS_CTR = WS_ROPE + (size_t)2052 * 64 * 8, WS_END = WS_CTR + 256;
constexpr int ZC_QR = 0, ZC_KR = 512, ZC_VR = 1024, ZC_GR = 2048, ZC_QH = 3072, ZC_FH = 4096, ZC_IH = 5120, ZC_GH = 6144, ZC_XL = 7168, ZC_GL = 8192, ZC_GATE = 9216;
constexpr size_t O_RETP = 17301504, O_RETS = 19398656, O_HGP = 52953088, O_HGS = 55050240, O_LRUP = 88604672, O_LRUS = 88621056, O_CVP = 88883200, O_CVS = 88932352;

struct Params { const float* in[31]; float* out; unsigned char* ws; };

__device__ __forceinline__ float bf2f(bf16_t b) { return __uint_as_float(((unsigned)b) << 16); }
__device__ __forceinline__ bf16_t f2bf(float f) { unsigned u = __float_as_uint(f); u += 0x7FFFu + ((u >> 16) & 1u); return (bf16_t)(u >> 16); }
__device__ __forceinline__ unsigned pk2(float lo, float hi) { return (unsigned)f2bf(lo) | ((unsigned)f2bf(hi) << 16); }
__device__ __forceinline__ float lo2f(unsigned w) { return __uint_as_float(w << 16); }
__device__ __forceinline__ float hi2f(unsigned w) { return __uint_as_float(w & 0xffff0000u); }
__device__ __forceinline__ float sigmoidf_(float x) { return 1.0f / (1.0f + __expf(-x)); }
__device__ __forceinline__ float siluf_(float x) { return x / (1.0f + __expf(-x)); }
__device__ __forceinline__ float geluf_(float x) { float y = 0.7978845608028654f * (x + 0.044715f * x * x * x); float e = __expf(2.0f * y); float th = 1.0f - 2.0f / (e + 1.0f); return 0.5f * x * (1.0f + th); }

namespace pg8 {
constexpr int BM = 256, BK = 64, HALF = 128, HTB = HALF * BK * 2, NXCD = 8, WGM = 8;
__device__ __forceinline__ int lds_byte(int r, int c) { const int st = (r >> 4) * 2 + (c >> 5), rr = r & 15, cc = c & 31, ob = rr * 64 + cc * 2; return st * 1024 + (ob ^ (((ob >> 9) & 1) << 5)); }
__device__ __forceinline__ void stage_rc(int b, int& R, int& C) { const int st = b / 1024, sb = b % 1024, swz = sb ^ (((sb >> 9) & 1) << 5); R = (st >> 1) * 16 + swz / 64; C = (st & 1) * 32 + (swz % 64) / 2; }
__device__ __forceinline__ int perm32(int rho) { const int n = rho >> 4, i = rho & 15; return 8 * (i >> 2) + 4 * n + (i & 3); }

struct Unit { int pm, pn, br; };
struct Gemm { const bf16_t* A0; const bf16_t* A1; const bf16_t* A2; const bf16_t* B0; size_t bstride; int lda, K; };

struct StaticOrder {
    int nM, nN, nwg, G, c;
    __device__ void init(int M, int N, int G_, int c_) { nM = M / BM; nN = N / BM; nwg = nM * nN; G = G_; c = c_; }
    __device__ bool next(int i, Unit& u) const {
        const long L = (long)i * G + c; if (L >= nwg) return false;
        int wgid = (int)L; { const int q = nwg / NXCD, r = nwg % NXCD, xcd = wgid % NXCD, off = wgid / NXCD; wgid = (xcd < r ? xcd * (q + 1) : r * (q + 1) + (xcd - r) * q) + off; }
        const int nig = WGM * nN, gid = wgid / nig, fm = gid * WGM, gsz = (nM - fm) < WGM ? (nM - fm) : WGM;
        u.pm = fm + ((wgid % nig) % gsz); u.pn = (wgid % nig) / gsz; u.br = 0; return true;
    }
};
struct BranchOrder {
    StaticOrder so;
    __device__ bool next(int i, Unit& u) const { if (!so.next(i / 3, u)) return false; u.br = i % 3; return true; }
};

template <class Epi, class Sched>
__device__ __forceinline__ void gemm_phase(LAS unsigned char* lds, const Gemm g, const Sched& S, const Epi& E) {
    int tid = threadIdx.x; asm volatile("" : "+v"(tid));
    const int wid = __builtin_amdgcn_readfirstlane(tid >> 6), lane = tid & 63, wr = wid >> 2, wc = wid & 3, fr = lane & 15, fq = lane >> 4;
    const int K = g.K, nt = K / BK, lda = g.lda;
    unsigned voffA[2], voffB[2];
#pragma unroll
    for (int i = 0; i < 2; ++i) { int R, C; stage_rc(tid * 16 + i * 8192, R, C); const int Rb = Epi::PERM ? ((R & ~31) + perm32(R & 31)) : R;
        voffA[i] = (unsigned)(R * lda + C) * 2u; voffB[i] = (unsigned)(Rb * K + C) * 2u; }
    const size_t kstep = (size_t)(BK * 2);
    const size_t hstepA = (size_t)HALF * lda * 2, hstepB = (size_t)HALF * K * 2;
    const size_t tstepA = 2 * hstepA, tstepB = 2 * hstepB;
    const unsigned ldsw = (unsigned)wid * 1024u;
    const int aoff = lds_byte(wr * 64 + fr, fq * 8), boff = lds_byte(wc * 32 + fr, fq * 8);
#define PG8_SA(b, h) (((b) * 2 + (h)) * HTB)
#define PG8_SB(b, h) ((4 + (b) * 2 + (h)) * HTB)
#define PG8_STAGE(bufoff, gbase, voff) do { _Pragma("unroll") for (int _i = 0; _i < 2; ++_i) \
        __builtin_amdgcn_global_load_lds((const unsigned*)((const char*)(gbase) + (voff)[_i]), (LAS unsigned*)(lds + (bufoff) + ldsw + _i * 8192), 16, 0, 0); } while (0)
#define PG8_LDA(dst, b, h) do { _Pragma("unroll") for (int m = 0; m < 4; ++m) _Pragma("unroll") for (int k = 0; k < 2; ++k) dst[m][k] = *(const LAS bf16x8*)(lds + PG8_SA(b, h) + aoff + m * 2048 + k * 1024); } while (0)
#define PG8_LDB(dst, b, h) do { _Pragma("unroll") for (int n = 0; n < 2; ++n) _Pragma("unroll") for (int k = 0; k < 2; ++k) dst[n][k] = *(const LAS bf16x8*)(lds + PG8_SB(b, h) + boff + n * 2048 + k * 1024); } while (0)
#define PG8_MMA(ai, bj, At, Bt) do { __builtin_amdgcn_s_setprio(1); _Pragma("unroll") for (int m = 0; m < 4; ++m) _Pragma("unroll") for (int n = 0; n < 2; ++n) _Pragma("unroll") for (int k = 0; k < 2; ++k) \
        acc[ai][bj][m][n] = __builtin_amdgcn_mfma_f32_16x16x32_bf16(Bt[n][k], At[m][k], acc[ai][bj][m][n], 0, 0, 0); __builtin_amdgcn_s_setprio(0); } while (0)
#define PG8_WAIT_V(n) asm volatile("s_waitcnt vmcnt(" #n ")" ::: "memory")
#define PG8_WAIT_L(n) asm volatile("s_waitcnt lgkmcnt(" #n ")" ::: "memory")
#define PG8_BAR __builtin_amdgcn_s_barrier()
#define PG8_SCHED __builtin_amdgcn_sched_barrier(0)
#define PG8_APTR(u) ((const char*)((u).br == 0 ? g.A0 : ((u).br == 1 ? g.A1 : g.A2)) + (size_t)(u).pm * tstepA)
#define PG8_BPTR(u) ((const char*)(g.B0 + (size_t)(u).br * g.bstride) + (size_t)(u).pn * tstepB)
    Unit cur, nxt; int ui = 0;
    if (!S.next(0, cur)) return;
    f32x4 acc[2][2][4][2];
#pragma unroll
    for (int a = 0; a < 2; ++a)
#pragma unroll
        for (int b = 0; b < 2; ++b)
#pragma unroll
            for (int m = 0; m < 4; ++m)
#pragma unroll
                for (int n = 0; n < 2; ++n) acc[a][b][m][n] = (f32x4){0.f, 0.f, 0.f, 0.f};
    bf16x8 At[4][2], B0[2][2], B1[2][2];
    const char* cA = PG8_APTR(cur); const char* cB = PG8_BPTR(cur);
    PG8_STAGE(PG8_SB(0, 0), cB, voffB); PG8_STAGE(PG8_SA(0, 0), cA, voffA); PG8_STAGE(PG8_SB(0, 1), cB + hstepB, voffB); PG8_STAGE(PG8_SA(0, 1), cA + hstepA, voffA);
    if (wr == 1) PG8_BAR;
    PG8_WAIT_V(4); PG8_BAR;
    PG8_STAGE(PG8_SB(1, 0), cB + kstep, voffB); PG8_STAGE(PG8_SA(1, 0), cA + kstep, voffA); PG8_STAGE(PG8_SB(1, 1), cB + hstepB + kstep, voffB);
    PG8_WAIT_V(6); PG8_BAR;
    for (;;) {
        const bool has_next = S.next(ui + 1, nxt);
        const char* nA = has_next ? PG8_APTR(nxt) : cA; const char* nB = has_next ? PG8_BPTR(nxt) : cB;
        for (int t = 0; t < nt; t += 2) {
            const bool last = (t == nt - 2);
            const char* a1 = cA + (size_t)(t + 1) * kstep;
            const char* a2 = last ? nA : cA + (size_t)(t + 2) * kstep; const char* b2 = last ? nB : cB + (size_t)(t + 2) * kstep;
            const char* a3 = a2 + kstep; const char* b3 = b2 + kstep;
            PG8_LDB(B0, 0, 0); PG8_SCHED; PG8_LDA(At, 0, 0); PG8_STAGE(PG8_SA(1, 1), a1 + hstepA, voffA);
            PG8_WAIT_L(8); PG8_BAR; PG8_WAIT_L(0); PG8_MMA(0, 0, At, B0); PG8_BAR; PG8_SCHED;
            PG8_LDB(B1, 0, 1); PG8_STAGE(PG8_SB(0, 0), b2, voffB);
            PG8_BAR; PG8_WAIT_L(0); PG8_MMA(0, 1, At, B1); PG8_BAR;
            PG8_LDA(At, 0, 1); PG8_STAGE(PG8_SA(0, 0), a2, voffA);
            PG8_BAR; PG8_WAIT_L(0); PG8_MMA(1, 0, At, B0); PG8_BAR; PG8_SCHED;
            PG8_STAGE(PG8_SB(0, 1), b2 + hstepB, voffB);
            PG8_WAIT_V(6); PG8_BAR; PG8_MMA(1, 1, At, B1); PG8_BAR;
            PG8_LDB(B0, 1, 0); PG8_SCHED; PG8_LDA(At, 1, 0); PG8_STAGE(PG8_SA(0, 1), a2 + hstepA, voffA);
            PG8_WAIT_L(8); PG8_BAR; PG8_WAIT_L(0); PG8_MMA(0, 0, At, B0); PG8_BAR; PG8_SCHED;
            PG8_LDB(B1, 1, 1); PG8_STAGE(PG8_SB(1, 0), b3, voffB);
            PG8_BAR; PG8_WAIT_L(0); PG8_MMA(0, 1, At, B1); PG8_BAR;
            PG8_LDA(At, 1, 1); PG8_STAGE(PG8_SA(1, 0), a3, voffA);
            PG8_BAR; PG8_WAIT_L(0); PG8_MMA(1, 0, At, B0); PG8_BAR; PG8_SCHED;
            PG8_STAGE(PG8_SB(1, 1), b3 + hstepB, voffB);
            PG8_WAIT_V(6); PG8_BAR; PG8_MMA(1, 1, At, B1); PG8_BAR;
        }
        E(acc, cur, wr, wc, fr, fq);
        if (!has_next) break;
#pragma unroll
        for (int a = 0; a < 2; ++a)
#pragma unroll
            for (int b = 0; b < 2; ++b)
#pragma unroll
                for (int m = 0; m < 4; ++m)
#pragma unroll
                    for (int n = 0; n < 2; ++n) acc[a][b][m][n] = (f32x4){0.f, 0.f, 0.f, 0.f};
        cur = nxt; cA = nA; cB = nB; ++ui;
    }
    PG8_WAIT_V(0);
    if (wr == 0) PG8_BAR;
    PG8_BAR;
#undef PG8_SA
#undef PG8_SB
#undef PG8_STAGE
#undef PG8_LDA
#undef PG8_LDB
#undef PG8_MMA
#undef PG8_WAIT_V
#undef PG8_WAIT_L
#undef PG8_BAR
#undef PG8_SCHED
#undef PG8_APTR
#undef PG8_BPTR
}

struct EpiUp {
    static constexpr bool PERM = false;
    bf16_t* hid; const float* ss;
    __device__ __forceinline__ void operator()(const f32x4 (&acc)[2][2][4][2], const Unit& u, int wr, int wc, int fr, int fq) const {
        const int row0 = u.pm * BM + wr * 64 + fr;
#pragma unroll
        for (int ai = 0; ai < 2; ++ai)
#pragma unroll
            for (int m = 0; m < 4; ++m) {
                const int row = row0 + ai * HALF + m * 16;
                const float r = rsqrtf(ss[row] * (1.0f / 1024.0f) + 1e-6f);
#pragma unroll
                for (int bj = 0; bj < 2; ++bj) {
                    const f32x4 gt = acc[ai][bj][m][0] * r, up = acc[ai][bj][m][1] * r;
                    float h[4];
#pragma unroll
                    for (int j = 0; j < 4; ++j) h[j] = siluf_(gt[j]) * up[j];
                    const int col = 16 * (8 * u.pn + 4 * bj + wc) + 4 * fq;
                    u32x2 w; w.x = pk2(h[0], h[1]); w.y = pk2(h[2], h[3]);
                    *(u32x2*)(hid + (size_t)row * FH + col) = w;
                }
            }
    }
};
struct EpiRes {
    static constexpr bool PERM = false;
    float* x; bf16_t* xb; float* ssn; float scale;
    __device__ __forceinline__ void operator()(const f32x4 (&acc)[2][2][4][2], const Unit& u, int wr, int wc, int fr, int fq) const {
        const int row0 = u.pm * BM + wr * 64 + fr, col0 = u.pn * BM + wc * 32 + 4 * fq;
#pragma unroll
        for (int ai = 0; ai < 2; ++ai)
#pragma unroll
            for (int m = 0; m < 4; ++m) {
                const int row = row0 + ai * HALF + m * 16;
                float s = 0.f;
#pragma unroll
                for (int bj = 0; bj < 2; ++bj)
#pragma unroll
                    for (int n = 0; n < 2; ++n) {
                        const int col = col0 + bj * HALF + n * 16;
                        f32x4* px = (f32x4*)(x + (size_t)row * DM + col);
                        f32x4 v = *px + acc[ai][bj][m][n] * scale;
                        *px = v;
                        u32x2 w; w.x = pk2(v[0], v[1]); w.y = pk2(v[2], v[3]);
                        *(u32x2*)(xb + (size_t)row * DM + col) = w;
                        s += v[0] * v[0] + v[1] * v[1] + v[2] * v[2] + v[3] * v[3];
                    }
                s += __shfl_xor(s, 16); s += __shfl_xor(s, 32);
                if (fq == 0) atomicAdd(ssn + row, s);
            }
    }
};
struct EpiWin {
    static constexpr bool PERM = true;
    bf16_t* z; const float* ss;
    __device__ __forceinline__ void operator()(const f32x4 (&acc)[2][2][4][2], const Unit& u, int wr, int wc, int fr, int fq) const {
        const int row0 = u.pm * BM + wr * 64 + fr, col0 = u.pn * BM + wc * 32 + 8 * fq;
#pragma unroll
        for (int ai = 0; ai < 2; ++ai)
#pragma unroll
            for (int m = 0; m < 4; ++m) {
                const int row = row0 + ai * HALF + m * 16;
                const float r = rsqrtf(ss[row] * (1.0f / 1024.0f) + 1e-6f);
#pragma unroll
                for (int bj = 0; bj < 2; ++bj) {
                    const f32x4 v0 = acc[ai][bj][m][0] * r, v1 = acc[ai][bj][m][1] * r;
                    u32x4 w; w.x = pk2(v0[0], v0[1]); w.y = pk2(v0[2], v0[3]); w.z = pk2(v1[0], v1[1]); w.w = pk2(v1[2], v1[3]);
                    *(u32x4*)(z + (size_t)row * NZ + col0 + bj * HALF) = w;
                }
            }
    }
};
struct EpiBranch {
    static constexpr bool PERM = true;
    bf16_t* z; const float* mbias;
    __device__ __forceinline__ void operator()(const f32x4 (&acc)[2][2][4][2], const Unit& u, int wr, int wc, int fr, int fq) const {
        const int row0 = u.pm * BM + wr * 64 + fr, col0 = u.pn * BM + wc * 32 + 8 * fq;
        const int br = u.br;
#pragma unroll
        for (int bj = 0; bj < 2; ++bj) {
            const int col = col0 + bj * HALF;
            const f32x4 b0 = *(const f32x4*)(mbias + br * DM + col), b1 = *(const f32x4*)(mbias + br * DM + col + 4);
#pragma unroll
            for (int ai = 0; ai < 2; ++ai)
#pragma unroll
                for (int m = 0; m < 4; ++m) {
                    const int row = row0 + ai * HALF + m * 16;
                    bf16_t* zr = z + (size_t)row * NZ;
                    const u32x4 gw = *(const u32x4*)(zr + ZC_GATE + br * DM + col);
                    float o[8];
                    const f32x4 a0 = acc[ai][bj][m][0], a1 = acc[ai][bj][m][1];
                    o[0] = sigmoidf_(lo2f(gw.x) + b0[0]) * a0[0]; o[1] = sigmoidf_(hi2f(gw.x) + b0[1]) * a0[1];
                    o[2] = sigmoidf_(lo2f(gw.y) + b0[2]) * a0[2]; o[3] = sigmoidf_(hi2f(gw.y) + b0[3]) * a0[3];
                    o[4] = sigmoidf_(lo2f(gw.z) + b1[0]) * a1[0]; o[5] = sigmoidf_(hi2f(gw.z) + b1[1]) * a1[1];
                    o[6] = sigmoidf_(lo2f(gw.w) + b1[2]) * a1[2]; o[7] = sigmoidf_(hi2f(gw.w) + b1[3]) * a1[3];
                    if (br > 0) {
                        const u32x4 pw = *(const u32x4*)(zr + col);
                        o[0] += lo2f(pw.x); o[1] += hi2f(pw.x); o[2] += lo2f(pw.y); o[3] += hi2f(pw.y);
                        o[4] += lo2f(pw.z); o[5] += hi2f(pw.z); o[6] += lo2f(pw.w); o[7] += hi2f(pw.w);
                    }
                    u32x4 w; w.x = pk2(o[0], o[1]); w.y = pk2(o[2], o[3]); w.z = pk2(o[4], o[5]); w.w = pk2(o[6], o[7]);
                    *(u32x4*)(zr + col) = w;
                }
        }
    }
};
}

__device__ __forceinline__ void conv_tile(const float* __restrict__ src, int ldn, int k0, int n0, bf16_t* __restrict__ dst, int K, const float* __restrict__ gain, int mode, LAS float* tile) {
    const int tid = threadIdx.x;
#pragma unroll
    for (int i = 0; i < 8; ++i) {
        const int kk = i * 8 + (tid >> 6), nn = tid & 63;
        float v = src[(size_t)(k0 + kk) * ldn + n0 + nn];
        if (gain) v *= gain[k0 + kk];
        tile[kk * 65 + nn] = v;
    }
    __syncthreads();
    {
        const int nn = tid >> 3, ks = (tid & 7) * 8;
        float v[8];
#pragma unroll
        for (int j = 0; j < 8; ++j) v[j] = tile[(ks + j) * 65 + nn];
        const int n = n0 + nn;
        const int row = (mode == 0) ? n : (32 * (n >> 4) + (mode == 2 ? 16 : 0) + (n & 15));
        u32x4 w; w.x = pk2(v[0], v[1]); w.y = pk2(v[2], v[3]); w.z = pk2(v[4], v[5]); w.w = pk2(v[6], v[7]);
        *(u32x4*)(dst + (size_t)row * K + k0 + ks) = w;
    }
    __syncthreads();
}

__device__ void phase0(const Params& p, LAS unsigned char* lds) {
    int tid = threadIdx.x; asm volatile("" : "+v"(tid));
    const int bid = blockIdx.x, nb = gridDim.x;
    bf16_t* wb = (bf16_t*)(p.ws + WS_W);
    LAS float* tile = (LAS float*)lds;
    for (int ti = bid; ti < 2 * 8320; ti += nb) {
        const int l = ti / 8320; int r = ti % 8320;
        bf16_t* wl = wb + (size_t)l * W_LAYER;
        const float* src; int Ks, Ns; bf16_t* dst; const float* gain = nullptr; int mode = 0;
        if (r < 704) { src = p.in[7] + (size_t)l * DM * FH; Ks = DM; Ns = FH; dst = wl + OFF_GU1; gain = p.in[6] + l * DM; mode = 1; }
        else if ((r -= 704) < 704) { src = p.in[8] + (size_t)l * DM * FH; Ks = DM; Ns = FH; dst = wl + OFF_GU1; gain = p.in[6] + l * DM; mode = 2; }
        else if ((r -= 704) < 704) { src = p.in[9] + (size_t)l * DM * FH; Ks = FH; Ns = DM; dst = wl + OFF_D1; }
        else if ((r -= 704) < 3072) { src = p.in[11] + (size_t)l * DM * NZ; Ks = DM; Ns = NZ; dst = wl + OFF_WIN; gain = p.in[10] + l * DM; }
        else if ((r -= 3072) < 256) { src = p.in[13] + (size_t)l * DM * DM; Ks = DM; Ns = DM; dst = wl + OFF_RO; }
        else if ((r -= 256) < 256) { src = p.in[16] + (size_t)l * DM * DM; Ks = DM; Ns = DM; dst = wl + OFF_HO; }
        else if ((r -= 256) < 256) { src = p.in[24] + (size_t)l * DM * DM; Ks = DM; Ns = DM; dst = wl + OFF_LO; }
        else if ((r -= 256) < 256) { src = p.in[25] + (size_t)l * DM * DM; Ks = DM; Ns = DM; dst = wl + OFF_MO; }
        else if ((r -= 256) < 704) { src = p.in[27] + (size_t)l * DM * FH; Ks = DM; Ns = FH; dst = wl + OFF_GU2; gain = p.in[26] + l * DM; mode = 1; }
        else if ((r -= 704) < 704) { src = p.in[28] + (size_t)l * DM * FH; Ks = DM; Ns = FH; dst = wl + OFF_GU2; gain = p.in[26] + l * DM; mode = 2; }
        else { r -= 704; src = p.in[29] + (size_t)l * DM * FH; Ks = FH; Ns = DM; dst = wl + OFF_D2; }
        const int nkt = Ks / 64;
        const int kt = r % nkt, ntile = r / nkt;
        conv_tile(src, Ns, kt * 64, ntile * 64, dst, Ks, gain, mode, tile);
    }
    float* x = p.out; bf16_t* xb = (bf16_t*)(p.ws + WS_XB); float* ss = (float*)(p.ws + WS_SS);
    const int wid = tid >> 6, lane = tid & 63;
    for (int row = bid * 8 + wid; row < T_ALL; row += nb * 8) {
        const float* srow = (row < T_P) ? (p.in[0] + (size_t)row * DM) : (p.in[1] + (size_t)(row - T_P) * DM);
        float s = 0.f;
#pragma unroll
        for (int i = 0; i < 4; ++i) {
            const int c = i * 256 + lane * 4;
            const f32x4 v = *(const f32x4*)(srow + c);
            *(f32x4*)(x + (size_t)row * DM + c) = v;
            u32x2 w; w.x = pk2(v[0], v[1]); w.y = pk2(v[2], v[3]);
            *(u32x2*)(xb + (size_t)row * DM + c) = w;
            s += v[0] * v[0] + v[1] * v[1] + v[2] * v[2] + v[3] * v[3];
        }
#pragma unroll
        for (int o = 32; o >= 1; o >>= 1) s += __shfl_xor(s, o);
        if (lane == 0) { ss[row] = s;
#pragma unroll
            for (int k = 1; k < 8; ++k) ss[(size_t)k * T_ALL + row] = 0.f; }
    }
    float2* rope = (float2*)(p.ws + WS_ROPE);
    for (int e = bid * 512 + tid; e < 2052 * 64; e += nb * 512) {
        const int idx = e >> 6, i = e & 63;
        const int pos = idx < 2048 ? idx : (16384 + idx - 2048);
        double inv = 1.0;
        for (int k = 0; k < i; ++k) inv *= 0.8659643233600653;
        double rev = (double)pos * inv * 0.15915494309189535;
        rev -= (double)(long long)rev;
        const float rf = (float)rev;
        rope[e] = make_float2(__builtin_amdgcn_cosf(rf), __builtin_amdgcn_sinf(rf));
    }
    if (bid == 0 && tid < 64) ((unsigned*)(p.ws + WS_CTR))[tid] = 0u;
}

__device__ __forceinline__ bf16x8 ldfrag(const LAS bf16_t* M, int ld, int r0, int k0, int fr, int fq) { return *(const LAS bf16x8*)(M + (r0 + fr) * ld + k0 + fq * 8); }
__device__ __forceinline__ bf16x8 ldfrag_tr(const LAS bf16_t* M, int ld, int i0, int k0, int fr, int fq) {
    const LAS bf16_t* q = M + (k0 + fq * 8 + (fr >> 2)) * ld + i0 + (fr & 3) * 4;
    const s16x4 a = __builtin_amdgcn_ds_read_tr16_b64_v4i16((LAS s16x4*)q);
    const s16x4 b = __builtin_amdgcn_ds_read_tr16_b64_v4i16((LAS s16x4*)(q + 4 * ld));
    return (bf16x8){a[0], a[1], a[2], a[3], b[0], b[1], b[2], b[3]};
}
#define MMA16(acc, bfr, afr) acc = __builtin_amdgcn_mfma_f32_16x16x32_bf16(bfr, afr, acc, 0, 0, 0)

template <bool HG>
__device__ void linattn_prompt(const Params& p, int l, int b, int h, LAS unsigned char* lds) {
    constexpr int DV = HG ? 128 : 256, NVT = DV / 16, NV = DV / 32, LQ = 136, LV = DV + 8, LP = 72;
    int tid = threadIdx.x; asm volatile("" : "+v"(tid));
    const int wid = __builtin_amdgcn_readfirstlane(tid >> 6), lane = tid & 63, fr = lane & 15, fq = lane >> 4;
    LAS bf16_t* Q = (LAS bf16_t*)lds;
    LAS bf16_t* Kn = Q + 64 * LQ;
    LAS bf16_t* P = Kn;
    LAS bf16_t* KH = Kn + 64 * LQ;
    LAS bf16_t* V = KH + 64 * LQ;
    LAS bf16_t* ST = V + 64 * LV;
    LAS float* red = (LAS float*)(ST + DV * LQ);
    LAS float* eL = red + 128;
    LAS float* eR = eL + 128;
    LAS float* segs = eR + 128;
    bf16_t* zb = (bf16_t*)(p.ws + WS_Z);
    const float2* rope = (const float2*)(p.ws + WS_ROPE);
    const int qcol = HG ? ZC_QH + h * 128 : ZC_QR + h * 128;
    const int kcol = HG ? ZC_FH + h * 128 : ZC_KR + h * 128;
    const int vcol = HG ? ZC_IH + h * 128 : ZC_VR + h * 256;
    const int gcol = HG ? ZC_GH + h * 128 : ZC_GR + h * 256;
    const float log_g = HG ? 0.f : logf(1.0f - exp2f(-5.0f - (float)h));
    float lb = 0.f;
    if (HG && l == 1) { const int c = h * 128 + (tid & 127); lb = sigmoidf_(p.in[14][1024 + c] - p.in[14][c]); }
    f32x4 st[NVT];
#pragma unroll
    for (int i = 0; i < NVT; ++i) st[i] = (f32x4){0.f, 0.f, 0.f, 0.f};

    for (int c = 0; c < 32; ++c) {
        const int row0 = b * 2048 + c * 64;
        if (!HG) {
            const int t = tid >> 3, g = tid & 7;
            const bf16_t* zr = zb + (size_t)(row0 + t) * NZ;
            const u32x4 q1 = *(const u32x4*)(zr + qcol + 8 * g), q2 = *(const u32x4*)(zr + qcol + 64 + 8 * g);
            const u32x4 k1 = *(const u32x4*)(zr + kcol + 8 * g), k2 = *(const u32x4*)(zr + kcol + 64 + 8 * g);
            const float2* rp = rope + (size_t)(c * 64 + t) * 64 + 8 * g;
            const float kd = __expf((float)(63 - t) * log_g) * 0.08838834764831845f;
            unsigned qa[4], qb[4], ka[4], kb[4], ha[4], hb[4];
#pragma unroll
            for (int j = 0; j < 4; ++j) {
                const float2 cs0 = rp[2 * j], cs1 = rp[2 * j + 1];
                const unsigned w1 = j == 0 ? q1.x : j == 1 ? q1.y : j == 2 ? q1.z : q1.w, w2 = j == 0 ? q2.x : j == 1 ? q2.y : j == 2 ? q2.z : q2.w;
                const unsigned v1 = j == 0 ? k1.x : j == 1 ? k1.y : j == 2 ? k1.z : k1.w, v2 = j == 0 ? k2.x : j == 1 ? k2.y : j == 2 ? k2.z : k2.w;
                const float x1a = lo2f(w1), x1b = hi2f(w1), x2a = lo2f(w2), x2b = hi2f(w2);
                const float y1a = lo2f(v1), y1b = hi2f(v1), y2a = lo2f(v2), y2b = hi2f(v2);
                const float qo1a = x1a * cs0.x - x2a * cs0.y, qo2a = x1a * cs0.y + x2a * cs0.x;
                const float qo1b = x1b * cs1.x - x2b * cs1.y, qo2b = x1b * cs1.y + x2b * cs1.x;
                const float ko1a = y1a * cs0.x - y2a * cs0.y, ko2a = y1a * cs0.y + y2a * cs0.x;
                const float ko1b = y1b * cs1.x - y2b * cs1.y, ko2b = y1b * cs1.y + y2b * cs1.x;
                qa[j] = pk2(qo1a, qo1b); qb[j] = pk2(qo2a, qo2b);
                ka[j] = pk2(ko1a, ko1b); kb[j] = pk2(ko2a, ko2b);
                ha[j] = pk2(ko1a * kd, ko1b * kd); hb[j] = pk2(ko2a * kd, ko2b * kd);
            }
            *(LAS u32x4*)(Q + t * LQ + 8 * g) = (u32x4){qa[0], qa[1], qa[2], qa[3]};
            *(LAS u32x4*)(Q + t * LQ + 64 + 8 * g) = (u32x4){qb[0], qb[1], qb[2], qb[3]};
            *(LAS u32x4*)(Kn + t * LQ + 8 * g) = (u32x4){ka[0], ka[1], ka[2], ka[3]};
            *(LAS u32x4*)(Kn + t * LQ + 64 + 8 * g) = (u32x4){kb[0], kb[1], kb[2], kb[3]};
            *(LAS u32x4*)(KH + t * LQ + 8 * g) = (u32x4){ha[0], ha[1], ha[2], ha[3]};
            *(LAS u32x4*)(KH + t * LQ + 64 + 8 * g) = (u32x4){hb[0], hb[1], hb[2], hb[3]};
#pragma unroll
            for (int i = 0; i < 4; ++i) {
                const int id = tid + 512 * i, tt = id >> 5, gv = id & 31;
                *(LAS u32x4*)(V + tt * LV + 8 * gv) = *(const u32x4*)(zb + (size_t)(row0 + tt) * NZ + vcol + 8 * gv);
            }
        } else {
            const int d = tid & 127, seg = tid >> 7;
            float lf[16], kv[16], qv[16];
            float run = 0.f;
#pragma unroll
            for (int j = 0; j < 16; ++j) {
                const bf16_t* zr = zb + (size_t)(row0 + seg * 16 + j) * NZ;
                const float f = bf2f(zr[kcol + d]), q = bf2f(zr[qcol + d]);
                const float ls = fminf(f, 0.f) - log1pf(__expf(-fabsf(f)));
                const float lfv = (lb == 0.f) ? ls : __logf(lb + (1.0f - lb) * __expf(ls));
                run += lfv; lf[j] = run;
                kv[j] = (1.0f - lb) * __expf(ls - f);
                qv[j] = siluf_(q);
            }
            segs[seg * 128 + d] = run;
            __syncthreads();
            const float s0 = segs[d], s1 = segs[128 + d], s2 = segs[256 + d], s3 = segs[384 + d];
            const float pre = (seg > 0 ? s0 : 0.f) + (seg > 1 ? s1 : 0.f) + (seg > 2 ? s2 : 0.f);
            const float bref = s0 + s1, bL = bref + s2 + s3;
#pragma unroll
            for (int j = 0; j < 16; ++j) {
                const int t = seg * 16 + j;
                const float bb = pre + lf[j];
                Q[t * LQ + d] = f2bf(qv[j] * __expf(bb - bref));
                Kn[t * LQ + d] = f2bf(kv[j] * __expf(bref - bb));
                KH[t * LQ + d] = f2bf(kv[j] * __expf(bL - bb));
            }
            if (seg == 0) { eL[d] = __expf(bL); eR[d] = __expf(bref); }
#pragma unroll
            for (int i = 0; i < 2; ++i) {
                const int id = tid + 512 * i, tt = id >> 4, gv = id & 15;
                *(LAS u32x4*)(V + tt * LV + 8 * gv) = *(const u32x4*)(zb + (size_t)(row0 + tt) * NZ + vcol + 8 * gv);
            }
        }
        __syncthreads();
        {
            float e0 = 1.f, e1 = 1.f, e2 = 1.f, e3 = 1.f;
            if (HG) { const f32x4 ev = *(const LAS f32x4*)(eR + 16 * wid + 4 * fq); e0 = ev[0]; e1 = ev[1]; e2 = ev[2]; e3 = ev[3]; }
#pragma unroll
            for (int vt = 0; vt < NVT; ++vt) {
                u32x2 w; w.x = pk2(st[vt][0] * e0, st[vt][1] * e1); w.y = pk2(st[vt][2] * e2, st[vt][3] * e3);
                *(LAS u32x2*)(ST + (16 * vt + fr) * LQ + 16 * wid + 4 * fq) = w;
            }
        }
        f32x4 sc[2];
        sc[0] = (f32x4){0.f, 0.f, 0.f, 0.f}; sc[1] = sc[0];
        {
            const int tt = wid >> 1, s0t = (wid & 1) * 2;
#pragma unroll
            for (int ks = 0; ks < 4; ++ks) {
                const bf16x8 afr = ldfrag(Q, LQ, 16 * tt, 32 * ks, fr, fq);
#pragma unroll
                for (int si = 0; si < 2; ++si) { const bf16x8 bfr = ldfrag(Kn, LQ, 16 * (s0t + si), 32 * ks, fr, fq); MMA16(sc[si], bfr, afr); }
            }
            const int t = 16 * tt + fr;
#pragma unroll
            for (int si = 0; si < 2; ++si)
#pragma unroll
                for (int j = 0; j < 4; ++j) {
                    const int s = 16 * (s0t + si) + 4 * fq + j;
                    float v = sc[si][j];
                    if (!HG) v *= 0.08838834764831845f * __expf((float)(t - s) * log_g);
                    sc[si][j] = (s <= t) ? v : 0.f;
                }
        }
        __syncthreads();
        {
            const int tt = wid >> 1, s0t = (wid & 1) * 2, t = 16 * tt + fr;
#pragma unroll
            for (int si = 0; si < 2; ++si) { u32x2 w; w.x = pk2(sc[si][0], sc[si][1]); w.y = pk2(sc[si][2], sc[si][3]);
                *(LAS u32x2*)(P + t * LP + 16 * (s0t + si) + 4 * fq) = w; }
        }
        __syncthreads();
        {
            const int tt = wid & 3, vg = wid >> 2, t = 16 * tt + fr;
            f32x4 oa[NV];
#pragma unroll
            for (int i = 0; i < NV; ++i) oa[i] = (f32x4){0.f, 0.f, 0.f, 0.f};
#pragma unroll
            for (int ks = 0; ks < 4; ++ks) {
                const bf16x8 afr = ldfrag(Q, LQ, 16 * tt, 32 * ks, fr, fq);
#pragma unroll
                for (int i = 0; i < NV; ++i) { const bf16x8 bfr = ldfrag(ST, LQ, 16 * (vg * NV + i), 32 * ks, fr, fq); MMA16(oa[i], bfr, afr); }
            }
            if (!HG) { const float qd = __expf((float)(t + 1) * log_g);
#pragma unroll
                for (int i = 0; i < NV; ++i) oa[i] *= qd; }
#pragma unroll
            for (int ks = 0; ks < 2; ++ks) {
                const bf16x8 afr = ldfrag(P, LP, 16 * tt, 32 * ks, fr, fq);
#pragma unroll
                for (int i = 0; i < NV; ++i) { const bf16x8 bfr = ldfrag_tr(V, LV, 16 * (vg * NV + i), 32 * ks, fr, fq); MMA16(oa[i], bfr, afr); }
            }
            float s = 0.f;
#pragma unroll
            for (int i = 0; i < NV; ++i) s += oa[i][0] * oa[i][0] + oa[i][1] * oa[i][1] + oa[i][2] * oa[i][2] + oa[i][3] * oa[i][3];
            s += __shfl_xor(s, 16); s += __shfl_xor(s, 32);
            if (fq == 0) red[vg * 64 + t] = s;
            __syncthreads();
            const float rs = rsqrtf((red[t] + red[64 + t]) * (1.0f / (float)DV) + 1e-6f);
            bf16_t* zr = zb + (size_t)(row0 + t) * NZ + gcol;
#pragma unroll
            for (int i = 0; i < NV; ++i) {
                const int v = 16 * (vg * NV + i) + 4 * fq;
                const u32x2 gw = *(const u32x2*)(zr + v);
                float n0 = rs, n1 = rs, n2 = rs, n3 = rs;
                if (HG) { const f32x4 hn = *(const f32x4*)(p.in[15] + l * 1024 + h * 128 + v); n0 *= hn[0]; n1 *= hn[1]; n2 *= hn[2]; n3 *= hn[3]; }
                u32x2 w;
                w.x = pk2(oa[i][0] * n0 * siluf_(lo2f(gw.x)), oa[i][1] * n1 * siluf_(hi2f(gw.x)));
                w.y = pk2(oa[i][2] * n2 * siluf_(lo2f(gw.y)), oa[i][3] * n3 * siluf_(hi2f(gw.y)));
                *(u32x2*)(zr + v) = w;
            }
        }
        {
            if (HG) { const f32x4 ev = *(const LAS f32x4*)(eL + 16 * wid + 4 * fq);
#pragma unroll
                for (int vt = 0; vt < NVT; ++vt) st[vt] *= ev; }
            else { const float sd = __expf(64.0f * log_g);
#pragma unroll
                for (int vt = 0; vt < NVT; ++vt) st[vt] *= sd; }
#pragma unroll
            for (int ks = 0; ks < 2; ++ks) {
                const bf16x8 bfr = ldfrag_tr(KH, LQ, 16 * wid, 32 * ks, fr, fq);
#pragma unroll
                for (int vt = 0; vt < NVT; ++vt) { const bf16x8 afr = ldfrag_tr(V, LV, 16 * vt, 32 * ks, fr, fq); MMA16(st[vt], bfr, afr); }
            }
        }
        __syncthreads();
    }
    float* so = p.out + (HG ? O_HGP : O_RETP) + ((size_t)((l * 8 + b) * (HG ? 8 : 4) + h)) * 128 * DV;
#pragma unroll
    for (int vt = 0; vt < NVT; ++vt)
#pragma unroll
        for (int j = 0; j < 4; ++j) so[(size_t)(16 * wid + 4 * fq + j) * DV + 16 * vt + fr] = st[vt][j];
}

__device__ void lru_prompt(const Params& p, int l, int b, int n, LAS unsigned char* lds) {
    int tid = threadIdx.x; asm volatile("" : "+v"(tid));
    const int wid = __builtin_amdgcn_readfirstlane(tid >> 6), lane = tid & 63, fr = lane & 15, fq = lane >> 4;
    LAS float* XL = (LAS float*)lds;
    LAS bf16_t* XC = (LAS bf16_t*)(lds + 34304);
    LAS float* XCF = (LAS float*)(lds + 51712);
    LAS float* AA = (LAS float*)(lds + 84480);
    LAS float* UU = (LAS float*)(lds + 117248);
    LAS float* segA = (LAS float*)(lds + 150016);
    LAS float* segH = segA + 512;
    LAS float* hc = segH + 512;
    bf16_t* zb = (bf16_t*)(p.ws + WS_Z);
    const int e = tid & 127, seg = tid >> 7, ch = n * 128 + e;
    const float cw0 = p.in[17][(l * 4 + 0) * 1024 + ch], cw1 = p.in[17][(l * 4 + 1) * 1024 + ch], cw2 = p.in[17][(l * 4 + 2) * 1024 + ch], cw3 = p.in[17][(l * 4 + 3) * 1024 + ch];
    const float cb = p.in[18][l * 1024 + ch];
    bf16x8 Ba[4], Bx[4];
    {
        const float* wa = p.in[19] + ((size_t)(l * 8 + n)) * 16384;
        const float* wx = p.in[21] + ((size_t)(l * 8 + n)) * 16384;
#pragma unroll
        for (int ks = 0; ks < 4; ++ks)
#pragma unroll
            for (int j = 0; j < 8; ++j) {
                const int d = 32 * ks + 8 * fq + j;
                Ba[ks][j] = (short)f2bf(wa[d * 128 + 16 * wid + fr]);
                Bx[ks][j] = (short)f2bf(wx[d * 128 + 16 * wid + fr]);
            }
    }
    float ba[4], bx[4], sp[4];
#pragma unroll
    for (int j = 0; j < 4; ++j) {
        const int c2 = n * 128 + 16 * wid + 4 * fq + j;
        ba[j] = p.in[20][l * 1024 + c2]; bx[j] = p.in[22][l * 1024 + c2];
        const float lam = p.in[23][l * 1024 + c2];
        sp[j] = fmaxf(-lam, 0.f) + log1pf(__expf(-fabsf(lam)));
    }
    if (tid < 384) XL[tid] = 0.f;
    if (tid < 128) hc[tid] = 0.f;
    __syncthreads();
    for (int c = 0; c < 32; ++c) {
        const int row0 = b * 2048 + c * 64;
#pragma unroll
        for (int i = 0; i < 2; ++i) {
            const int id = tid + 512 * i, tt = id >> 4, g = id & 15;
            const u32x4 w = *(const u32x4*)(zb + (size_t)(row0 + tt) * NZ + ZC_XL + n * 128 + 8 * g);
            LAS float* dst = XL + (3 + tt) * 128 + 8 * g;
            *(LAS f32x4*)dst = (f32x4){lo2f(w.x), hi2f(w.x), lo2f(w.y), hi2f(w.y)};
            *(LAS f32x4*)(dst + 4) = (f32x4){lo2f(w.z), hi2f(w.z), lo2f(w.w), hi2f(w.w)};
        }
        __syncthreads();
#pragma unroll
        for (int j = 0; j < 16; ++j) {
            const int t = seg * 16 + j;
            const float xc = cb + XL[t * 128 + e] * cw0 + XL[(t + 1) * 128 + e] * cw1 + XL[(t + 2) * 128 + e] * cw2 + XL[(t + 3) * 128 + e] * cw3;
            XCF[t * 128 + e] = xc; XC[t * 136 + e] = f2bf(xc);
        }
        __syncthreads();
#pragma unroll
        for (int tt = 0; tt < 4; ++tt) {
            f32x4 ga = (f32x4){0.f, 0.f, 0.f, 0.f}, gx = ga;
#pragma unroll
            for (int ks = 0; ks < 4; ++ks) { const bf16x8 afr = ldfrag(XC, 136, 16 * tt, 32 * ks, fr, fq); MMA16(ga, Ba[ks], afr); MMA16(gx, Bx[ks], afr); }
            const int t = 16 * tt + fr, e4 = 16 * wid + 4 * fq;
            const f32x4 xv = *(const LAS f32x4*)(XCF + t * 128 + e4);
            f32x4 av, uv;
#pragma unroll
            for (int j = 0; j < 4; ++j) {
                const float r = sigmoidf_(ga[j] + ba[j]), ii = sigmoidf_(gx[j] + bx[j]);
                const float la = -8.0f * r * sp[j];
                av[j] = __expf(la);
                uv[j] = sqrtf(-expm1f(2.0f * la)) * ii * xv[j];
            }
            *(LAS f32x4*)(AA + t * 128 + e4) = av; *(LAS f32x4*)(UU + t * 128 + e4) = uv;
        }
        __syncthreads();
        {
            float A = 1.f, H = 0.f;
#pragma unroll
            for (int j = 0; j < 16; ++j) { const int t = seg * 16 + j; const float a = AA[t * 128 + e]; H = a * H + UU[t * 128 + e]; A *= a; }
            segA[seg * 128 + e] = A; segH[seg * 128 + e] = H;
        }
        __syncthreads();
        float hh = hc[e];
        for (int s = 0; s < seg; ++s) hh = segA[s * 128 + e] * hh + segH[s * 128 + e];
#pragma unroll
        for (int j = 0; j < 16; ++j) {
            const int t = seg * 16 + j;
            hh = AA[t * 128 + e] * hh + UU[t * 128 + e];
            bf16_t* zp = zb + (size_t)(row0 + t) * NZ + ZC_GL + ch;
            *zp = f2bf(hh * geluf_(bf2f(*zp)));
        }
        __syncthreads();
        if (seg == 3) hc[e] = hh;
        if (seg == 0) { XL[e] = XL[64 * 128 + e]; XL[128 + e] = XL[65 * 128 + e]; XL[256 + e] = XL[66 * 128 + e]; }
        __syncthreads();
    }
    if (seg == 0) {
        p.out[O_LRUP + (size_t)(l * 8 + b) * 1024 + ch] = hc[e];
#pragma unroll
        for (int i = 0; i < 3; ++i) p.out[O_CVP + ((size_t)(l * 8 + b) * 3 + i) * 1024 + ch] = XL[i * 128 + e];
    }
    __syncthreads();
}

template <bool HG>
__device__ void linattn_sample(const Params& p, int l, int b, int h, LAS unsigned char* lds) {
    constexpr int DV = HG ? 128 : 256, NPART = 512 / DV, DPP = 128 / NPART;
    int tid = threadIdx.x; asm volatile("" : "+v"(tid));
    LAS float* qs = (LAS float*)lds;
    LAS float* ks = qs + 512;
    LAS float* fs = ks + 512;
    LAS float* vs = fs + 512;
    LAS float* op = vs + 4 * DV;
    LAS float* red = op + NPART * 4 * DV;
    bf16_t* zb = (bf16_t*)(p.ws + WS_Z);
    const int rowb = T_P + 4 * b;
    const float log_g = HG ? 0.f : logf(1.0f - exp2f(-5.0f - (float)h));
    const float gam = HG ? 1.f : (1.0f - exp2f(-5.0f - (float)h));
    if (!HG) {
        if (tid < 256) {
            const int t = tid >> 6, i = tid & 63;
            const bf16_t* zr = zb + (size_t)(rowb + t) * NZ;
            const float2 cs = ((const float2*)(p.ws + WS_ROPE))[(size_t)(2048 + t) * 64 + i];
            const float q1 = bf2f(zr[ZC_QR + h * 128 + i]), q2 = bf2f(zr[ZC_QR + h * 128 + 64 + i]);
            const float k1 = bf2f(zr[ZC_KR + h * 128 + i]), k2 = bf2f(zr[ZC_KR + h * 128 + 64 + i]);
            qs[t * 128 + i] = q1 * cs.x - q2 * cs.y; qs[t * 128 + 64 + i] = q1 * cs.y + q2 * cs.x;
            ks[t * 128 + i] = (k1 * cs.x - k2 * cs.y) * 0.08838834764831845f; ks[t * 128 + 64 + i] = (k1 * cs.y + k2 * cs.x) * 0.08838834764831845f;
        }
#pragma unroll
        for (int i = 0; i < 2; ++i) { const int id = tid + 512 * i, t = id >> 8, v = id & 255; vs[t * 256 + v] = bf2f(zb[(size_t)(rowb + t) * NZ + ZC_VR + h * 256 + v]); }
    } else {
        const int t = tid >> 7, d = tid & 127;
        const bf16_t* zr = zb + (size_t)(rowb + t) * NZ;
        float lb = 0.f;
        if (l == 1) { const int c = h * 128 + d; lb = sigmoidf_(p.in[14][1024 + c] - p.in[14][c]); }
        const float f = bf2f(zr[ZC_FH + h * 128 + d]), q = bf2f(zr[ZC_QH + h * 128 + d]);
        const float ls = fminf(f, 0.f) - log1pf(__expf(-fabsf(f)));
        const float sg = __expf(ls);
        fs[t * 128 + d] = lb + (1.0f - lb) * sg;
        ks[t * 128 + d] = (1.0f - lb) * __expf(ls - f);
        qs[t * 128 + d] = siluf_(q);
        vs[t * 128 + d] = bf2f(zr[ZC_IH + h * 128 + d]);
    }
    __syncthreads();
    {
        const int v = tid % DV, part = tid / DV;
        const float v0 = vs[v], v1 = vs[DV + v], v2 = vs[2 * DV + v], v3 = vs[3 * DV + v];
        const size_t sbase = ((size_t)((l * 128 + b) * (HG ? 8 : 4) + h)) * 128 * DV;
        const float* Sin = (HG ? p.in[3] : p.in[2]) + sbase;
        float* Sout = p.out + (HG ? O_HGS : O_RETS) + sbase;
        float o0 = 0.f, o1 = 0.f, o2 = 0.f, o3 = 0.f;
#pragma unroll 8
        for (int dd = 0; dd < DPP; ++dd) {
            const int d = part * DPP + dd;
            float S = Sin[(size_t)d * DV + v];
            const float f0 = HG ? fs[d] : gam, f1 = HG ? fs[128 + d] : gam, f2 = HG ? fs[256 + d] : gam, f3 = HG ? fs[384 + d] : gam;
            S = f0 * S + ks[d] * v0; o0 += qs[d] * S;
            S = f1 * S + ks[128 + d] * v1; o1 += qs[128 + d] * S;
            S = f2 * S + ks[256 + d] * v2; o2 += qs[256 + d] * S;
            S = f3 * S + ks[384 + d] * v3; o3 += qs[384 + d] * S;
            Sout[(size_t)d * DV + v] = S;
        }
        op[(part * 4 + 0) * DV + v] = o0; op[(part * 4 + 1) * DV + v] = o1; op[(part * 4 + 2) * DV + v] = o2; op[(part * 4 + 3) * DV + v] = o3;
    }
    __syncthreads();
    {
        const int t = tid >> 7, vv = tid & 127;
        constexpr int NPT = DV / 128;
        float o[NPT]; float s = 0.f;
#pragma unroll
        for (int i = 0; i < NPT; ++i) { const int v = vv + 128 * i; float a = 0.f;
#pragma unroll
            for (int q = 0; q < NPART; ++q) a += op[(q * 4 + t) * DV + v];
            o[i] = a; s += a * a; }
#pragma unroll
        for (int off = 32; off >= 1; off >>= 1) s += __shfl_xor(s, off);
        if ((tid & 63) == 0) red[tid >> 6] = s;
        __syncthreads();
        const float rs = rsqrtf((red[2 * t] + red[2 * t + 1]) * (1.0f / (float)DV) + 1e-6f);
        const int gcol = HG ? ZC_GH + h * 128 : ZC_GR + h * 256;
        bf16_t* zr = zb + (size_t)(rowb + t) * NZ + gcol;
#pragma unroll
        for (int i = 0; i < NPT; ++i) { const int v = vv + 128 * i;
            float nrm = rs; if (HG) nrm *= p.in[15][l * 1024 + h * 128 + v];
            zr[v] = f2bf(o[i] * nrm * siluf_(bf2f(zr[v]))); }
    }
    __syncthreads();
}

__device__ void lru_sample(const Params& p, int l, int item, LAS unsigned char* lds) {
    int tid = threadIdx.x; asm volatile("" : "+v"(tid));
    LAS float* XX = (LAS float*)lds;
    LAS float* XC = XX + 2 * 7 * 1024;
    bf16_t* zb = (bf16_t*)(p.ws + WS_Z);
    const int b0 = item * 2;
    for (int i = tid; i < 2 * 7 * 1024; i += 512) {
        const int sq = i / 7168, r = (i % 7168) >> 10, ch = i & 1023, b = b0 + sq;
        float v;
        if (r < 3) v = p.in[5][((size_t)(l * 128 + b) * 3 + r) * 1024 + ch];
        else v = bf2f(zb[(size_t)(T_P + 4 * b + (r - 3)) * NZ + ZC_XL + ch]);
        XX[i] = v;
    }
    __syncthreads();
    for (int i = tid; i < 8 * 1024; i += 512) {
        const int tok = i >> 10, ch = i & 1023, sq = tok >> 2, t = tok & 3;
        const LAS float* xx = XX + sq * 7168 + ch;
        float xc = p.in[18][l * 1024 + ch];
#pragma unroll
        for (int k = 0; k < 4; ++k) xc += xx[(t + k) * 1024] * p.in[17][(l * 4 + k) * 1024 + ch];
        XC[i] = xc;
    }
    __syncthreads();
#pragma unroll 1
    for (int cc = 0; cc < 2; ++cc) {
        const int ch = tid + 512 * cc, n = ch >> 7, e = ch & 127;
        const float* wa = p.in[19] + ((size_t)(l * 8 + n)) * 16384 + e;
        const float* wx = p.in[21] + ((size_t)(l * 8 + n)) * 16384 + e;
        float ga[8], gx[8];
#pragma unroll
        for (int k = 0; k < 8; ++k) { ga[k] = 0.f; gx[k] = 0.f; }
#pragma unroll 4
        for (int d = 0; d < 128; ++d) {
            const float a = wa[d * 128], x = wx[d * 128];
#pragma unroll
            for (int k = 0; k < 8; ++k) { const float xv = XC[k * 1024 + n * 128 + d]; ga[k] += xv * a; gx[k] += xv * x; }
        }
        const float ba = p.in[20][l * 1024 + ch], bx = p.in[22][l * 1024 + ch], lam = p.in[23][l * 1024 + ch];
        const float sp = fmaxf(-lam, 0.f) + log1pf(__expf(-fabsf(lam)));
#pragma unroll
        for (int sq = 0; sq < 2; ++sq) {
            const int b = b0 + sq;
            float hh = p.in[4][(size_t)(l * 128 + b) * 1024 + ch];
#pragma unroll
            for (int t = 0; t < 4; ++t) {
                const int k = sq * 4 + t;
                const float r = sigmoidf_(ga[k] + ba), ii = sigmoidf_(gx[k] + bx);
                const float la = -8.0f * r * sp;
                const float a = __expf(la), u = sqrtf(-expm1f(2.0f * la)) * ii * XC[k * 1024 + ch];
                hh = a * hh + u;
                bf16_t* zp = zb + (size_t)(T_P + 4 * b + t) * NZ + ZC_GL + ch;
                *zp = f2bf(hh * geluf_(bf2f(*zp)));
            }
            p.out[O_LRUS + (size_t)(l * 128 + b) * 1024 + ch] = hh;
#pragma unroll
            for (int r = 0; r < 3; ++r) p.out[O_CVS + ((size_t)(l * 128 + b) * 3 + r) * 1024 + ch] = XX[sq * 7168 + (4 + r) * 1024 + ch];
        }
    }
    __syncthreads();
}

__device__ void recur_phase(const Params& p, int l, LAS unsigned char* lds) {
    const int bid = blockIdx.x;
    if (bid < 32) linattn_prompt<false>(p, l, bid >> 2, bid & 3, lds);
    else if (bid < 96) linattn_prompt<true>(p, l, (bid - 32) >> 3, (bid - 32) & 7, lds);
    else if (bid < 160) lru_prompt(p, l, (bid - 96) >> 3, (bid - 96) & 7, lds);
    unsigned* ctr = (unsigned*)(p.ws + WS_CTR) + l;
    LAS unsigned* slot = (LAS unsigned*)(lds + LDS_BYTES - 16);
    for (;;) {
        __syncthreads();
        if (threadIdx.x == 0) *slot = atomicAdd(ctr, 1u);
        __syncthreads();
        const unsigned it = *slot;
        if (it >= 1600u) break;
        if (it < 512u) linattn_sample<false>(p, l, it >> 2, it & 3, lds);
        else if (it < 1536u) linattn_sample<true>(p, l, (it - 512) >> 3, (it - 512) & 7, lds);
        else lru_sample(p, l, it - 1536, lds);
    }
}

__global__ void __launch_bounds__(512) fwd_megakernel(Params p) {
    extern __shared__ __attribute__((aligned(16))) unsigned char smem_raw[];
    LAS unsigned char* lds = (LAS unsigned char*)smem_raw;
    cg::grid_group grid = cg::this_grid();
    using namespace pg8;
    const int G = gridDim.x, c = blockIdx.x;
    bf16_t* wb = (bf16_t*)(p.ws + WS_W);
    bf16_t* xb = (bf16_t*)(p.ws + WS_XB);
    bf16_t* zb = (bf16_t*)(p.ws + WS_Z);
    bf16_t* hid = zb;
    float* ss = (float*)(p.ws + WS_SS);
    float* x = p.out;

    phase0(p, lds);
    grid.sync();
#pragma unroll 1
    for (int l = 0; l < 2; ++l) {
        bf16_t* wl = wb + (size_t)l * W_LAYER;
#pragma unroll 1
        for (int f = 0; f < 2; ++f) {
            if (f == 1) {
                { Gemm g{xb, xb, xb, wl + OFF_WIN, 0, DM, DM}; StaticOrder so; so.init(T_ALL, NZ, G, c); EpiWin e{zb, ss + (size_t)(3 * l + 1) * T_ALL}; gemm_phase(lds, g, so, e); }
                grid.sync();
                recur_phase(p, l, lds);
                grid.sync();
                { Gemm g{zb + ZC_GR, zb + ZC_GH, zb + ZC_GL, wl + OFF_RO, (size_t)DM * DM, NZ, DM}; BranchOrder bo; bo.so.init(T_ALL, DM, G, c); EpiBranch e{zb, p.in[12] + l * 3 * DM}; gemm_phase(lds, g, bo, e); }
                grid.sync();
                { Gemm g{zb, zb, zb, wl + OFF_MO, 0, NZ, DM}; StaticOrder so; so.init(T_ALL, DM, G, c); EpiRes e{x, xb, ss + (size_t)(3 * l + 2) * T_ALL, 1.0f}; gemm_phase(lds, g, so, e); }
                grid.sync();
            }
            { Gemm g{xb, xb, xb, wl + (f == 0 ? OFF_GU1 : OFF_GU2), 0, DM, DM}; StaticOrder so; so.init(T_ALL, 2 * FH, G, c); EpiUp e{hid, ss + (size_t)(3 * l + 2 * f) * T_ALL}; gemm_phase(lds, g, so, e); }
            grid.sync();
            { Gemm g{hid, hid, hid, wl + (f == 0 ? OFF_D1 : OFF_D2), 0, FH, FH}; StaticOrder so; so.init(T_ALL, DM, G, c); EpiRes e{x, xb, ss + (size_t)(3 * l + 2 * f + 1) * T_ALL, 0.5f}; gemm_phase(lds, g, so, e); }
            grid.sync();
        }
    }
    {
        const float* ssf = ss + (size_t)6 * T_ALL;
        const int wid = threadIdx.x >> 6, lane = threadIdx.x & 63;
        for (int row = c * 8 + wid; row < T_ALL; row += G * 8) {
            const float r = rsqrtf(ssf[row] * (1.0f / 1024.0f) + 1e-6f);
#pragma unroll
            for (int i = 0; i < 4; ++i) {
                const int col = i * 256 + lane * 4;
                f32x4 v = *(f32x4*)(x + (size_t)row * DM + col);
                const f32x4 gn = *(const f32x4*)(p.in[30] + col);
                v = v * r * gn;
                *(f32x4*)(x + (size_t)row * DM + col) = v;
            }
        }
    }
}

extern "C" void kernel_launch(void* const* d_in, const int* in_sizes, int n_in, void* d_out, int out_size, void* d_ws, size_t ws_size, hipStream_t stream) {
    static int grid = 0;
    if (grid == 0) {
        if (n_in != 31 || ws_size < WS_END) { fprintf(stderr, "kernel_launch: need 31 inputs and %zu bytes of workspace (got %d, %zu)\n", (size_t)WS_END, n_in, ws_size); grid = -1; return; }
        int dev = 0, cus = 0, per_cu = 0;
        hipGetDevice(&dev);
        hipDeviceGetAttribute(&cus, hipDeviceAttributeMultiprocessorCount, dev);
        if (hipFuncSetAttribute((const void*)fwd_megakernel, hipFuncAttributeMaxDynamicSharedMemorySize, LDS_BYTES) != hipSuccess) { fprintf(stderr, "kernel_launch: hipFuncSetAttribute failed\n"); grid = -1; return; }
        hipOccupancyMaxActiveBlocksPerMultiprocessor(&per_cu, (const void*)fwd_megakernel, 512, LDS_BYTES);
        if (per_cu < 1) { fprintf(stderr, "kernel_launch: occupancy query says %d blocks per CU\n", per_cu); per_cu = 1; }
        (void)hipGetLastError();
        grid = cus;
    }
    if (grid < 0) return;
    Params p{};
    for (int i = 0; i < 31; ++i) p.in[i] = (const float*)d_in[i];
    p.out = (float*)d_out; p.ws = (unsigned char*)d_ws;
    void* args[] = {&p};
    hipError_t e = hipLaunchCooperativeKernel((const void*)fwd_megakernel, dim3(grid), dim3(512), args, LDS_BYTES, stream);
    if (e != hipSuccess) fprintf(stderr, "cooperative launch failed: %s (grid %d)\n", hipGetErrorString(e), grid);
}
```

```cpp
#include <hip/hip_runtime.h>
#include <hip/hip_cooperative_groups.h>
#include <cstdio>
namespace cg = cooperative_groups;
#ifndef DBL_MASK
#define DBL_MASK 0
#endif

#define LAS __attribute__((address_space(3)))
typedef unsigned short bf16_t;
typedef short bf16x8 __attribute__((ext_vector_type(8)));
typedef short s16x4 __attribute__((ext_vector_type(4)));
typedef float f32x4 __attribute__((ext_vector_type(4)));
typedef unsigned u32x4 __attribute__((ext_vector_type(4)));
typedef unsigned u32x2 __attribute__((ext_vector_type(2)));

constexpr int T_ALL = 16896, T_P = 16384, DM = 1024, FH = 2816, NZ = 12288;
constexpr int LDS_BYTES = 163840;
constexpr size_t OFF_GU1 = 0, OFF_D1 = 5767168, OFF_WIN = 8650752, OFF_RO = 21233664, OFF_HO = 22282240, OFF_LO = 23330816,
                 OFF_MO = 24379392, OFF_GU2 = 25427968, OFF_D2 = 31195136, W_LAYER = 34078720;
constexpr size_t WS_W = 0, WS_XB = 2 * W_LAYER * 2, WS_Z = WS_XB + (size_t)T_ALL * DM * 2, WS_SS = WS_Z + (size_t)T_ALL * NZ * 2,
                 WS_ROPE = WS_SS + (size_t)8 * T_ALL * 4, WS_CTR = WS_ROPE + (size_t)2052 * 64 * 8, WS_BAR = WS_CTR + 256, WS_END = WS_BAR + 256;
constexpr int ZC_QR = 0, ZC_KR = 512, ZC_VR = 1024, ZC_GR = 2048, ZC_QH = 3072, ZC_FH = 4096, ZC_IH = 5120, ZC_GH = 6144, ZC_XL = 7168, ZC_GL = 8192, ZC_GATE = 9216;
constexpr size_t O_RETP = 17301504, O_RETS = 19398656, O_HGP = 52953088, O_HGS = 55050240, O_LRUP = 88604672, O_LRUS = 88621056, O_CVP = 88883200, O_CVS = 88932352;

struct Params { const float* in[31]; float* out; unsigned char* ws; };

__device__ __forceinline__ float bf2f(bf16_t b) { return __uint_as_float(((unsigned)b) << 16); }
__device__ __forceinline__ unsigned pk2(float lo, float hi) { unsigned r; asm("v_cvt_pk_bf16_f32 %0, %1, %2" : "=v"(r) : "v"(lo), "v"(hi)); return r; }
__device__ __forceinline__ bf16_t f2bf(float f) { return (bf16_t)(pk2(f, f) & 0xffffu); }
__device__ __forceinline__ float lo2f(unsigned w) { return __uint_as_float(w << 16); }
__device__ __forceinline__ float hi2f(unsigned w) { return __uint_as_float(w & 0xffff0000u); }
__device__ __forceinline__ float fexp(float x) { return __builtin_amdgcn_exp2f(x * 1.4426950408889634f); }
__device__ __forceinline__ float flog(float x) { return __builtin_amdgcn_logf(x) * 0.6931471805599453f; }
__device__ __forceinline__ float sigmoidf_(float x) { return __builtin_amdgcn_rcpf(1.0f + fexp(-x)); }
__device__ __forceinline__ float siluf_(float x) { return x * __builtin_amdgcn_rcpf(1.0f + fexp(-x)); }
__device__ __forceinline__ float geluf_(float x) { const float y = 0.7978845608028654f * (x + 0.044715f * x * x * x); const float e = fexp(2.0f * y); const float th = 1.0f - 2.0f * __builtin_amdgcn_rcpf(e + 1.0f); return 0.5f * x * (1.0f + th); }
__device__ __forceinline__ float frsq(float x) { return __builtin_amdgcn_rsqf(x); }

namespace pg8 {
constexpr int BM = 256, BK = 64, HALF = 128, HTB = HALF * BK * 2, NXCD = 8, WGM = 8;
__device__ __forceinline__ int lds_byte(int r, int c) { const int st = (r >> 4) * 2 + (c >> 5), rr = r & 15, cc = c & 31, ob = rr * 64 + cc * 2; return st * 1024 + (ob ^ (((ob >> 9) & 1) << 5)); }
__device__ __forceinline__ void stage_rc(int b, int& R, int& C) { const int st = b / 1024, sb = b % 1024, swz = sb ^ (((sb >> 9) & 1) << 5); R = (st >> 1) * 16 + swz / 64; C = (st & 1) * 32 + (swz % 64) / 2; }
__device__ __forceinline__ int perm32(int rho) { const int n = rho >> 4, i = rho & 15; return 8 * (i >> 2) + 4 * n + (i & 3); }

struct Unit { int pm, pn, br; };
struct Gemm { const bf16_t* A0; const bf16_t* A1; const bf16_t* A2; const bf16_t* B0; size_t bstride; int lda, K; };

struct StaticOrder {
    int nM, nN, nwg, G, c;
    __device__ void init(int M, int N, int G_, int c_) { nM = M / BM; nN = N / BM; nwg = nM * nN; G = G_; c = c_; }
    __device__ bool next(int i, Unit& u) const {
        const long L = (long)i * G + c; if (L >= nwg) return false;
        int wgid = (int)L; { const int q = nwg / NXCD, r = nwg % NXCD, xcd = wgid % NXCD, off = wgid / NXCD; wgid = (xcd < r ? xcd * (q + 1) : r * (q + 1) + (xcd - r) * q) + off; }
        const int nig = WGM * nN, gid = wgid / nig, fm = gid * WGM, gsz = (nM - fm) < WGM ? (nM - fm) : WGM;
        u.pm = fm + ((wgid % nig) % gsz); u.pn = (wgid % nig) / gsz; u.br = 0; return true;
    }
};
struct BranchOrder {
    StaticOrder so;
    __device__ bool next(int i, Unit& u) const { if (!so.next(i / 3, u)) return false; u.br = i % 3; return true; }
};

template <class Epi, class Sched>
__device__ __forceinline__ void gemm_phase(LAS unsigned char* lds, const Gemm g, const Sched& S, const Epi& E) {
    int tid = threadIdx.x; asm volatile("" : "+v"(tid));
    const int wid = __builtin_amdgcn_readfirstlane(tid >> 6), lane = tid & 63, wr = wid >> 2, wc = wid & 3, fr = lane & 15, fq = lane >> 4;
    const int K = g.K, nt = K / BK, lda = g.lda;
    unsigned voffA[2], voffB[2];
#pragma unroll
    for (int i = 0; i < 2; ++i) { int R, C; stage_rc(tid * 16 + i * 8192, R, C); const int Rb = Epi::PERM ? ((R & ~31) + perm32(R & 31)) : R;
        voffA[i] = (unsigned)(R * lda + C) * 2u; voffB[i] = (unsigned)(Rb * K + C) * 2u; }
    const size_t kstep = (size_t)(BK * 2);
    const size_t hstepA = (size_t)HALF * lda * 2, hstepB = (size_t)HALF * K * 2;
    const size_t tstepA = 2 * hstepA, tstepB = 2 * hstepB;
    const unsigned ldsw = (unsigned)wid * 1024u;
    const int aoff = lds_byte(wr * 64 + fr, fq * 8), boff = lds_byte(wc * 32 + fr, fq * 8);
#define PG8_SA(b, h) (((b) * 2 + (h)) * HTB)
#define PG8_SB(b, h) ((4 + (b) * 2 + (h)) * HTB)
#define PG8_STAGE(bufoff, gbase, voff) do { _Pragma("unroll") for (int _i = 0; _i < 2; ++_i) \
        __builtin_amdgcn_global_load_lds((const unsigned*)((const char*)(gbase) + (voff)[_i]), (LAS unsigned*)(lds + (bufoff) + ldsw + _i * 8192), 16, 0, 0); } while (0)
#define PG8_LDA(dst, b, h) do { _Pragma("unroll") for (int m = 0; m < 4; ++m) _Pragma("unroll") for (int k = 0; k < 2; ++k) dst[m][k] = *(const LAS bf16x8*)(lds + PG8_SA(b, h) + aoff + m * 2048 + k * 1024); } while (0)
#define PG8_LDB(dst, b, h) do { _Pragma("unroll") for (int n = 0; n < 2; ++n) _Pragma("unroll") for (int k = 0; k < 2; ++k) dst[n][k] = *(const LAS bf16x8*)(lds + PG8_SB(b, h) + boff + n * 2048 + k * 1024); } while (0)
#define PG8_MMA(ai, bj, At, Bt) do { __builtin_amdgcn_s_setprio(1); _Pragma("unroll") for (int m = 0; m < 4; ++m) _Pragma("unroll") for (int n = 0; n < 2; ++n) _Pragma("unroll") for (int k = 0; k < 2; ++k) \
        acc[ai][bj][m][n] = __builtin_amdgcn_mfma_f32_16x16x32_bf16(Bt[n][k], At[m][k], acc[ai][bj][m][n], 0, 0, 0); __builtin_amdgcn_s_setprio(0); } while (0)
#define PG8_WAIT_V(n) asm volatile("s_waitcnt vmcnt(" #n ")" ::: "memory")
#define PG8_WAIT_L(n) asm volatile("s_waitcnt lgkmcnt(" #n ")" ::: "memory")
#define PG8_BAR __builtin_amdgcn_s_barrier()
#define PG8_SCHED __builtin_amdgcn_sched_barrier(0)
#define PG8_APTR(u) ((const char*)((u).br == 0 ? g.A0 : ((u).br == 1 ? g.A1 : g.A2)) + (size_t)(u).pm * tstepA)
#define PG8_BPTR(u) ((const char*)(g.B0 + (size_t)(u).br * g.bstride) + (size_t)(u).pn * tstepB)
    Unit cur, nxt; int ui = 0;
    if (!S.next(0, cur)) return;
    f32x4 acc[2][2][4][2];
#pragma unroll
    for (int a = 0; a < 2; ++a)
#pragma unroll
        for (int b = 0; b < 2; ++b)
#pragma unroll
            for (int m = 0; m < 4; ++m)
#pragma unroll
                for (int n = 0; n < 2; ++n) acc[a][b][m][n] = (f32x4){0.f, 0.f, 0.f, 0.f};
    bf16x8 At[4][2], B0[2][2], B1[2][2];
    const char* cA = PG8_APTR(cur); const char* cB = PG8_BPTR(cur);
    PG8_STAGE(PG8_SB(0, 0), cB, voffB); PG8_STAGE(PG8_SA(0, 0), cA, voffA); PG8_STAGE(PG8_SB(0, 1), cB + hstepB, voffB); PG8_STAGE(PG8_SA(0, 1), cA + hstepA, voffA);
    if (wr == 1) PG8_BAR;
    PG8_WAIT_V(4); PG8_BAR;
    PG8_STAGE(PG8_SB(1, 0), cB + kstep, voffB); PG8_STAGE(PG8_SA(1, 0), cA + kstep, voffA); PG8_STAGE(PG8_SB(1, 1), cB + hstepB + kstep, voffB);
    PG8_WAIT_V(6); PG8_BAR;
    for (;;) {
        const bool has_next = S.next(ui + 1, nxt);
        const char* nA = has_next ? PG8_APTR(nxt) : cA; const char* nB = has_next ? PG8_BPTR(nxt) : cB;
        for (int t = 0; t < nt; t += 2) {
            const bool last = (t == nt - 2);
            const char* a1 = cA + (size_t)(t + 1) * kstep;
            const char* a2 = last ? nA : cA + (size_t)(t + 2) * kstep; const char* b2 = last ? nB : cB + (size_t)(t + 2) * kstep;
            const char* a3 = a2 + kstep; const char* b3 = b2 + kstep;
            PG8_LDB(B0, 0, 0); PG8_SCHED; PG8_LDA(At, 0, 0); PG8_STAGE(PG8_SA(1, 1), a1 + hstepA, voffA);
            PG8_WAIT_L(8); PG8_BAR; PG8_WAIT_L(0); PG8_MMA(0, 0, At, B0); PG8_BAR; PG8_SCHED;
            PG8_LDB(B1, 0, 1); PG8_STAGE(PG8_SB(0, 0), b2, voffB);
            PG8_BAR; PG8_WAIT_L(0); PG8_MMA(0, 1, At, B1); PG8_BAR;
            PG8_LDA(At, 0, 1); PG8_STAGE(PG8_SA(0, 0), a2, voffA);
            PG8_BAR; PG8_WAIT_L(0); PG8_MMA(1, 0, At, B0); PG8_BAR; PG8_SCHED;
            PG8_STAGE(PG8_SB(0, 1), b2 + hstepB, voffB);
            PG8_WAIT_V(6); PG8_BAR; PG8_MMA(1, 1, At, B1); PG8_BAR;
            PG8_LDB(B0, 1, 0); PG8_SCHED; PG8_LDA(At, 1, 0); PG8_STAGE(PG8_SA(0, 1), a2 + hstepA, voffA);
            PG8_WAIT_L(8); PG8_BAR; PG8_WAIT_L(0); PG8_MMA(0, 0, At, B0); PG8_BAR; PG8_SCHED;
            PG8_LDB(B1, 1, 1); PG8_STAGE(PG8_SB(1, 0), b3, voffB);
            PG8_BAR; PG8_WAIT_L(0); PG8_MMA(0, 1, At, B1); PG8_BAR;
            PG8_LDA(At, 1, 1); PG8_STAGE(PG8_SA(1, 0), a3, voffA);
            PG8_BAR; PG8_WAIT_L(0); PG8_MMA(1, 0, At, B0); PG8_BAR; PG8_SCHED;
            PG8_STAGE(PG8_SB(1, 1), b3 + hstepB, voffB);
            PG8_WAIT_V(6); PG8_BAR; PG8_MMA(1, 1, At, B1); PG8_BAR;
        }
        E(acc, cur, wr, wc, fr, fq);
        if (!has_next) break;
#pragma unroll
        for (int a = 0; a < 2; ++a)
#pragma unroll
            for (int b = 0; b < 2; ++b)
#pragma unroll
                for (int m = 0; m < 4; ++m)
#pragma unroll
                    for (int n = 0; n < 2; ++n) acc[a][b][m][n] = (f32x4){0.f, 0.f, 0.f, 0.f};
        cur = nxt; cA = nA; cB = nB; ++ui;
    }
    PG8_WAIT_V(0);
    if (wr == 0) PG8_BAR;
    PG8_BAR;
#undef PG8_SA
#undef PG8_SB
#undef PG8_STAGE
#undef PG8_LDA
#undef PG8_LDB
#undef PG8_MMA
#undef PG8_WAIT_V
#undef PG8_WAIT_L
#undef PG8_BAR
#undef PG8_SCHED
#undef PG8_APTR
#undef PG8_BPTR
}

struct EpiUp {
    static constexpr bool PERM = false;
    bf16_t* hid; const float* ss;
    __device__ __forceinline__ void operator()(const f32x4 (&acc)[2][2][4][2], const Unit& u, int wr, int wc, int fr, int fq) const {
        const int row0 = u.pm * BM + wr * 64 + fr;
        float rr[2][4];
#pragma unroll
        for (int ai = 0; ai < 2; ++ai)
#pragma unroll
            for (int m = 0; m < 4; ++m) rr[ai][m] = ss[row0 + ai * HALF + m * 16];
#pragma unroll
        for (int ai = 0; ai < 2; ++ai)
#pragma unroll
            for (int m = 0; m < 4; ++m) {
                const int row = row0 + ai * HALF + m * 16;
                const float r = frsq(rr[ai][m] * (1.0f / 1024.0f) + 1e-6f);
#pragma unroll
                for (int bj = 0; bj < 2; ++bj) {
                    const f32x4 gt = acc[ai][bj][m][0] * r, up = acc[ai][bj][m][1] * r;
                    float h[4];
#pragma unroll
                    for (int j = 0; j < 4; ++j) h[j] = siluf_(gt[j]) * up[j];
                    const int col = 16 * (8 * u.pn + 4 * bj + wc) + 4 * fq;
                    u32x2 w; w.x = pk2(h[0], h[1]); w.y = pk2(h[2], h[3]);
                    *(u32x2*)(hid + (size_t)row * FH + col) = w;
                }
            }
    }
};
struct EpiRes {
    static constexpr bool PERM = false;
    float* x; bf16_t* xb; float* ssn; float scale; int dry;
    __device__ __forceinline__ void operator()(const f32x4 (&acc)[2][2][4][2], const Unit& u, int wr, int wc, int fr, int fq) const {
        const int row0 = u.pm * BM + wr * 64 + fr, col0 = u.pn * BM + wc * 32 + 4 * fq;
        f32x4 cur[2][2], nxt[2][2];
#pragma unroll
        for (int bj = 0; bj < 2; ++bj)
#pragma unroll
            for (int n = 0; n < 2; ++n) cur[bj][n] = *(const f32x4*)(x + (size_t)row0 * DM + col0 + bj * HALF + n * 16);
#pragma unroll
        for (int gi = 0; gi < 8; ++gi) {
            const int ai = gi >> 2, m = gi & 3;
            const int row = row0 + ai * HALF + m * 16;
            if (gi < 7) { const int rown = row0 + ((gi + 1) >> 2) * HALF + ((gi + 1) & 3) * 16;
#pragma unroll
                for (int bj = 0; bj < 2; ++bj)
#pragma unroll
                    for (int n = 0; n < 2; ++n) nxt[bj][n] = *(const f32x4*)(x + (size_t)rown * DM + col0 + bj * HALF + n * 16); }
            float s = 0.f;
#pragma unroll
            for (int bj = 0; bj < 2; ++bj)
#pragma unroll
                for (int n = 0; n < 2; ++n) {
                    const int col = col0 + bj * HALF + n * 16;
                    const f32x4 v = cur[bj][n] + acc[ai][bj][m][n] * scale;
                    u32x2 w; w.x = pk2(v[0], v[1]); w.y = pk2(v[2], v[3]);
                    if (!dry) { *(f32x4*)(x + (size_t)row * DM + col) = v; *(u32x2*)(xb + (size_t)row * DM + col) = w; }
                    s += v[0] * v[0] + v[1] * v[1] + v[2] * v[2] + v[3] * v[3];
                }
            s += __shfl_xor(s, 16); s += __shfl_xor(s, 32);
            if (fq == 0 && !dry) atomicAdd(ssn + row, s);
#pragma unroll
            for (int bj = 0; bj < 2; ++bj)
#pragma unroll
                for (int n = 0; n < 2; ++n) cur[bj][n] = nxt[bj][n];
        }
    }
};
struct EpiWin {
    static constexpr bool PERM = true;
    bf16_t* z; const float* ss;
    __device__ __forceinline__ void operator()(const f32x4 (&acc)[2][2][4][2], const Unit& u, int wr, int wc, int fr, int fq) const {
        const int row0 = u.pm * BM + wr * 64 + fr, col0 = u.pn * BM + wc * 32 + 8 * fq;
        float rr[2][4];
#pragma unroll
        for (int ai = 0; ai < 2; ++ai)
#pragma unroll
            for (int m = 0; m < 4; ++m) rr[ai][m] = ss[row0 + ai * HALF + m * 16];
#pragma unroll
        for (int ai = 0; ai < 2; ++ai)
#pragma unroll
            for (int m = 0; m < 4; ++m) {
                const int row = row0 + ai * HALF + m * 16;
                const float r = frsq(rr[ai][m] * (1.0f / 1024.0f) + 1e-6f);
#pragma unroll
                for (int bj = 0; bj < 2; ++bj) {
                    const f32x4 v0 = acc[ai][bj][m][0] * r, v1 = acc[ai][bj][m][1] * r;
                    u32x4 w; w.x = pk2(v0[0], v0[1]); w.y = pk2(v0[2], v0[3]); w.z = pk2(v1[0], v1[1]); w.w = pk2(v1[2], v1[3]);
                    *(u32x4*)(z + (size_t)row * NZ + col0 + bj * HALF) = w;
                }
            }
    }
};
struct EpiBranch {
    static constexpr bool PERM = true;
    bf16_t* z; const float* mbias; int dry;
    __device__ __forceinline__ void operator()(const f32x4 (&acc)[2][2][4][2], const Unit& u, int wr, int wc, int fr, int fq) const {
        const int row0 = u.pm * BM + wr * 64 + fr, col0 = u.pn * BM + wc * 32 + 8 * fq;
        const int br = u.br;
#pragma unroll
        for (int bj = 0; bj < 2; ++bj) {
            const int col = col0 + bj * HALF;
            const f32x4 b0 = *(const f32x4*)(mbias + br * DM + col), b1 = *(const f32x4*)(mbias + br * DM + col + 4);
#pragma unroll
            for (int am = 0; am < 4; ++am) {
                const int ai = am >> 1, mb = (am & 1) * 2;
                u32x4 gw[2], pw[2];
#pragma unroll
                for (int mm = 0; mm < 2; ++mm) {
                    const bf16_t* zr = z + (size_t)(row0 + ai * HALF + (mb + mm) * 16) * NZ;
                    gw[mm] = *(const u32x4*)(zr + ZC_GATE + br * DM + col);
                    pw[mm] = (u32x4){0u, 0u, 0u, 0u};
                    if (br > 0) pw[mm] = *(const u32x4*)(zr + col);
                }
#pragma unroll
                for (int mm = 0; mm < 2; ++mm) {
                    const int m = mb + mm;
                    bf16_t* zr = z + (size_t)(row0 + ai * HALF + m * 16) * NZ;
                    float o[8];
                    const f32x4 a0 = acc[ai][bj][m][0], a1 = acc[ai][bj][m][1];
                    o[0] = sigmoidf_(lo2f(gw[mm].x) + b0[0]) * a0[0] + lo2f(pw[mm].x); o[1] = sigmoidf_(hi2f(gw[mm].x) + b0[1]) * a0[1] + hi2f(pw[mm].x);
                    o[2] = sigmoidf_(lo2f(gw[mm].y) + b0[2]) * a0[2] + lo2f(pw[mm].y); o[3] = sigmoidf_(hi2f(gw[mm].y) + b0[3]) * a0[3] + hi2f(pw[mm].y);
                    o[4] = sigmoidf_(lo2f(gw[mm].z) + b1[0]) * a1[0] + lo2f(pw[mm].z); o[5] = sigmoidf_(hi2f(gw[mm].z) + b1[1]) * a1[1] + hi2f(pw[mm].z);
                    o[6] = sigmoidf_(lo2f(gw[mm].w) + b1[2]) * a1[2] + lo2f(pw[mm].w); o[7] = sigmoidf_(hi2f(gw[mm].w) + b1[3]) * a1[3] + hi2f(pw[mm].w);
                    u32x4 w; w.x = pk2(o[0], o[1]); w.y = pk2(o[2], o[3]); w.z = pk2(o[4], o[5]); w.w = pk2(o[6], o[7]);
                    if (!dry) *(u32x4*)(zr + col) = w;
                }
            }
        }
    }
};
}

__device__ __forceinline__ void conv_tile(const float* __restrict__ src, int ldn, int k0, int n0, bf16_t* __restrict__ dst, int K, const float* __restrict__ gain, int mode, LAS float* tile) {
    const int tid = threadIdx.x;
    float v[32];
#pragma unroll
    for (int i = 0; i < 32; ++i) v[i] = src[(size_t)(k0 + i * 2 + (tid >> 8)) * ldn + n0 + (tid & 255)];
    if (gain) {
#pragma unroll
        for (int i = 0; i < 32; ++i) v[i] *= gain[k0 + i * 2 + (tid >> 8)];
    }
#pragma unroll
    for (int i = 0; i < 32; ++i) tile[(i * 2 + (tid >> 8)) * 257 + (tid & 255)] = v[i];
    __syncthreads();
#pragma unroll
    for (int i = 0; i < 4; ++i) {
        const int id = tid + 512 * i, nn = id >> 3, ks = (id & 7) * 8;
        float t[8];
#pragma unroll
        for (int j = 0; j < 8; ++j) t[j] = tile[(ks + j) * 257 + nn];
        const int n = n0 + nn;
        const int row = (mode == 0) ? n : (32 * (n >> 4) + (mode == 2 ? 16 : 0) + (n & 15));
        u32x4 w; w.x = pk2(t[0], t[1]); w.y = pk2(t[2], t[3]); w.z = pk2(t[4], t[5]); w.w = pk2(t[6], t[7]);
        *(u32x4*)(dst + (size_t)row * K + k0 + ks) = w;
    }
    __syncthreads();
}

__device__ void phase0(const Params& p, LAS unsigned char* lds) {
    int tid = threadIdx.x; asm volatile("" : "+v"(tid));
    const int bid = blockIdx.x, nb = gridDim.x;
    bf16_t* wb = (bf16_t*)(p.ws + WS_W);
    LAS float* tile = (LAS float*)lds;
    for (int ti = bid; ti < 2 * 2080; ti += nb) {
        const int l = ti / 2080; int r = ti % 2080;
        bf16_t* wl = wb + (size_t)l * W_LAYER;
        const float* src; int Ks, Ns; bf16_t* dst; const float* gain = nullptr; int mode = 0;
        if (r < 176) { src = p.in[7] + (size_t)l * DM * FH; Ks = DM; Ns = FH; dst = wl + OFF_GU1; gain = p.in[6] + l * DM; mode = 1; }
        else if ((r -= 176) < 176) { src = p.in[8] + (size_t)l * DM * FH; Ks = DM; Ns = FH; dst = wl + OFF_GU1; gain = p.in[6] + l * DM; mode = 2; }
        else if ((r -= 176) < 176) { src = p.in[9] + (size_t)l * DM * FH; Ks = FH; Ns = DM; dst = wl + OFF_D1; }
        else if ((r -= 176) < 768) { src = p.in[11] + (size_t)l * DM * NZ; Ks = DM; Ns = NZ; dst = wl + OFF_WIN; gain = p.in[10] + l * DM; }
        else if ((r -= 768) < 64) { src = p.in[13] + (size_t)l * DM * DM; Ks = DM; Ns = DM; dst = wl + OFF_RO; }
        else if ((r -= 64) < 64) { src = p.in[16] + (size_t)l * DM * DM; Ks = DM; Ns = DM; dst = wl + OFF_HO; }
        else if ((r -= 64) < 64) { src = p.in[24] + (size_t)l * DM * DM; Ks = DM; Ns = DM; dst = wl + OFF_LO; }
        else if ((r -= 64) < 64) { src = p.in[25] + (size_t)l * DM * DM; Ks = DM; Ns = DM; dst = wl + OFF_MO; }
        else if ((r -= 64) < 176) { src = p.in[27] + (size_t)l * DM * FH; Ks = DM; Ns = FH; dst = wl + OFF_GU2; gain = p.in[26] + l * DM; mode = 1; }
        else if ((r -= 176) < 176) { src = p.in[28] + (size_t)l * DM * FH; Ks = DM; Ns = FH; dst = wl + OFF_GU2; gain = p.in[26] + l * DM; mode = 2; }
        else { r -= 176; src = p.in[29] + (size_t)l * DM * FH; Ks = FH; Ns = DM; dst = wl + OFF_D2; }
        const int nkt = Ks / 64;
        const int kt = r % nkt, ntile = r / nkt;
        conv_tile(src, Ns, kt * 64, ntile * 256, dst, Ks, gain, mode, tile);
    }
    float* x = p.out; bf16_t* xb = (bf16_t*)(p.ws + WS_XB); float* ss = (float*)(p.ws + WS_SS);
    const int wid = tid >> 6, lane = tid & 63;
    for (int row = bid * 8 + wid; row < T_ALL; row += nb * 8) {
        const float* srow = (row < T_P) ? (p.in[0] + (size_t)row * DM) : (p.in[1] + (size_t)(row - T_P) * DM);
        float s = 0.f;
#pragma unroll
        for (int i = 0; i < 4; ++i) {
            const int c = i * 256 + lane * 4;
            const f32x4 v = *(const f32x4*)(srow + c);
            *(f32x4*)(x + (size_t)row * DM + c) = v;
            u32x2 w; w.x = pk2(v[0], v[1]); w.y = pk2(v[2], v[3]);
            *(u32x2*)(xb + (size_t)row * DM + c) = w;
            s += v[0] * v[0] + v[1] * v[1] + v[2] * v[2] + v[3] * v[3];
        }
#pragma unroll
        for (int o = 32; o >= 1; o >>= 1) s += __shfl_xor(s, o);
        if (lane == 0) { ss[row] = s;
#pragma unroll
            for (int k = 1; k < 8; ++k) ss[(size_t)k * T_ALL + row] = 0.f; }
    }
    float2* rope = (float2*)(p.ws + WS_ROPE);
    for (int e = bid * 512 + tid; e < 2052 * 64; e += nb * 512) {
        const int idx = e >> 6, i = e & 63;
        const int pos = idx < 2048 ? idx : (16384 + idx - 2048);
        double inv = 1.0;
        for (int k = 0; k < i; ++k) inv *= 0.8659643233600653;
        double rev = (double)pos * inv * 0.15915494309189535;
        rev -= (double)(long long)rev;
        const float rf = (float)rev;
        rope[e] = make_float2(__builtin_amdgcn_cosf(rf), __builtin_amdgcn_sinf(rf));
    }
    if (bid == 0 && tid < 64) ((unsigned*)(p.ws + WS_CTR))[tid] = 0u;
}

__device__ __forceinline__ bf16x8 ldfrag(const LAS bf16_t* M, int ld, int r0, int k0, int fr, int fq) { return *(const LAS bf16x8*)(M + (r0 + fr) * ld + k0 + fq * 8); }
__device__ __forceinline__ bf16x8 ldfrag_tr(const LAS bf16_t* M, int ld, int i0, int k0, int fr, int fq) {
    const LAS bf16_t* q = M + (k0 + fq * 8 + (fr >> 2)) * ld + i0 + (fr & 3) * 4;
    const s16x4 a = __builtin_amdgcn_ds_read_tr16_b64_v4i16((LAS s16x4*)q);
    const s16x4 b = __builtin_amdgcn_ds_read_tr16_b64_v4i16((LAS s16x4*)(q + 4 * ld));
    return (bf16x8){a[0], a[1], a[2], a[3], b[0], b[1], b[2], b[3]};
}
#define MMA16(acc, bfr, afr) acc = __builtin_amdgcn_mfma_f32_16x16x32_bf16(bfr, afr, acc, 0, 0, 0)

template <bool HG>
__device__ void linattn_prompt(const Params& p, int l, int b, int h, LAS unsigned char* lds, int dry) {
    constexpr int DV = HG ? 128 : 256, NVT = DV / 16, NV = DV / 32, LQ = 136, LV = DV + 8, LP = 72;
    int tid = threadIdx.x; asm volatile("" : "+v"(tid));
    const int wid = __builtin_amdgcn_readfirstlane(tid >> 6), lane = tid & 63, fr = lane & 15, fq = lane >> 4;
    LAS bf16_t* Q = (LAS bf16_t*)lds;
    LAS bf16_t* Kn = Q + 64 * LQ;
    LAS bf16_t* P = Kn;
    LAS bf16_t* KH = Kn + 64 * LQ;
    LAS bf16_t* V = KH + 64 * LQ;
    LAS bf16_t* ST = V + 64 * LV;
    LAS float* red = (LAS float*)(ST + DV * LQ);
    LAS float* eL = red + 128;
    LAS float* eR = eL + 128;
    LAS float* segs = eR + 128;
    bf16_t* zb = (bf16_t*)(p.ws + WS_Z);
    const float2* rope = (const float2*)(p.ws + WS_ROPE);
    const int qcol = HG ? ZC_QH + h * 128 : ZC_QR + h * 128;
    const int kcol = HG ? ZC_FH + h * 128 : ZC_KR + h * 128;
    const int vcol = HG ? ZC_IH + h * 128 : ZC_VR + h * 256;
    const int gcol = HG ? ZC_GH + h * 128 : ZC_GR + h * 256;
    const float log_g = HG ? 0.f : logf(1.0f - exp2f(-5.0f - (float)h));
    float lb = 0.f;
    if (HG && l == 1) { const int c = h * 128 + (tid & 127); lb = sigmoidf_(p.in[14][1024 + c] - p.in[14][c]); }
    f32x4 st[NVT];
#pragma unroll
    for (int i = 0; i < NVT; ++i) st[i] = (f32x4){0.f, 0.f, 0.f, 0.f};

    for (int c = 0; c < 32; ++c) {
        const int row0 = b * 2048 + c * 64;
        if (!HG) {
            const int t = tid >> 3, g = tid & 7;
            const bf16_t* zr = zb + (size_t)(row0 + t) * NZ;
            const u32x4 q1 = *(const u32x4*)(zr + qcol + 8 * g), q2 = *(const u32x4*)(zr + qcol + 64 + 8 * g);
            const u32x4 k1 = *(const u32x4*)(zr + kcol + 8 * g), k2 = *(const u32x4*)(zr + kcol + 64 + 8 * g);
            const float2* rp = rope + (size_t)(c * 64 + t) * 64 + 8 * g;
            const float kd = fexp((float)(63 - t) * log_g) * 0.08838834764831845f;
            unsigned qa[4], qb[4], ka[4], kb[4], ha[4], hb[4];
#pragma unroll
            for (int j = 0; j < 4; ++j) {
                const float2 cs0 = rp[2 * j], cs1 = rp[2 * j + 1];
                const unsigned w1 = j == 0 ? q1.x : j == 1 ? q1.y : j == 2 ? q1.z : q1.w, w2 = j == 0 ? q2.x : j == 1 ? q2.y : j == 2 ? q2.z : q2.w;
                const unsigned v1 = j == 0 ? k1.x : j == 1 ? k1.y : j == 2 ? k1.z : k1.w, v2 = j == 0 ? k2.x : j == 1 ? k2.y : j == 2 ? k2.z : k2.w;
                const float x1a = lo2f(w1), x1b = hi2f(w1), x2a = lo2f(w2), x2b = hi2f(w2);
                const float y1a = lo2f(v1), y1b = hi2f(v1), y2a = lo2f(v2), y2b = hi2f(v2);
                const float qo1a = x1a * cs0.x - x2a * cs0.y, qo2a = x1a * cs0.y + x2a * cs0.x;
                const float qo1b = x1b * cs1.x - x2b * cs1.y, qo2b = x1b * cs1.y + x2b * cs1.x;
                const float ko1a = y1a * cs0.x - y2a * cs0.y, ko2a = y1a * cs0.y + y2a * cs0.x;
                const float ko1b = y1b * cs1.x - y2b * cs1.y, ko2b = y1b * cs1.y + y2b * cs1.x;
                qa[j] = pk2(qo1a, qo1b); qb[j] = pk2(qo2a, qo2b);
                ka[j] = pk2(ko1a, ko1b); kb[j] = pk2(ko2a, ko2b);
                ha[j] = pk2(ko1a * kd, ko1b * kd); hb[j] = pk2(ko2a * kd, ko2b * kd);
            }
            *(LAS u32x4*)(Q + t * LQ + 8 * g) = (u32x4){qa[0], qa[1], qa[2], qa[3]};
            *(LAS u32x4*)(Q + t * LQ + 64 + 8 * g) = (u32x4){qb[0], qb[1], qb[2], qb[3]};
            *(LAS u32x4*)(Kn + t * LQ + 8 * g) = (u32x4){ka[0], ka[1], ka[2], ka[3]};
            *(LAS u32x4*)(Kn + t * LQ + 64 + 8 * g) = (u32x4){kb[0], kb[1], kb[2], kb[3]};
            *(LAS u32x4*)(KH + t * LQ + 8 * g) = (u32x4){ha[0], ha[1], ha[2], ha[3]};
            *(LAS u32x4*)(KH + t * LQ + 64 + 8 * g) = (u32x4){hb[0], hb[1], hb[2], hb[3]};
#pragma unroll
            for (int i = 0; i < 4; ++i) {
                const int id = tid + 512 * i, tt = id >> 5, gv = id & 31;
                *(LAS u32x4*)(V + tt * LV + 8 * gv) = *(const u32x4*)(zb + (size_t)(row0 + tt) * NZ + vcol + 8 * gv);
            }
        } else {
            const int d = tid & 127, seg = tid >> 7;
            float lf[16], kv[16], qv[16];
            float run = 0.f;
#pragma unroll
            for (int j = 0; j < 16; ++j) {
                const bf16_t* zr = zb + (size_t)(row0 + seg * 16 + j) * NZ;
                const float f = bf2f(zr[kcol + d]), q = bf2f(zr[qcol + d]);
                const float ls = fminf(f, 0.f) - flog(1.0f + fexp(-fabsf(f)));
                const float lfv = (lb == 0.f) ? ls : flog(lb + (1.0f - lb) * fexp(ls));
                run += lfv; lf[j] = run;
                kv[j] = (1.0f - lb) * fexp(ls - f);
                qv[j] = siluf_(q);
            }
            segs[seg * 128 + d] = run;
            __syncthreads();
            const float s0 = segs[d], s1 = segs[128 + d], s2 = segs[256 + d], s3 = segs[384 + d];
            const float pre = (seg > 0 ? s0 : 0.f) + (seg > 1 ? s1 : 0.f) + (seg > 2 ? s2 : 0.f);
            const float bref = s0 + s1, bL = bref + s2 + s3;
#pragma unroll
            for (int j = 0; j < 16; ++j) {
                const int t = seg * 16 + j;
                const float bb = pre + lf[j];
                Q[t * LQ + d] = f2bf(qv[j] * fexp(bb - bref));
                Kn[t * LQ + d] = f2bf(kv[j] * fexp(bref - bb));
                KH[t * LQ + d] = f2bf(kv[j] * fexp(bL - bb));
            }
            if (seg == 0) { eL[d] = fexp(bL); eR[d] = fexp(bref); }
#pragma unroll
            for (int i = 0; i < 2; ++i) {
                const int id = tid + 512 * i, tt = id >> 4, gv = id & 15;
                *(LAS u32x4*)(V + tt * LV + 8 * gv) = *(const u32x4*)(zb + (size_t)(row0 + tt) * NZ + vcol + 8 * gv);
            }
        }
        __syncthreads();
        {
            float e0 = 1.f, e1 = 1.f, e2 = 1.f, e3 = 1.f;
            if (HG) { const f32x4 ev = *(const LAS f32x4*)(eR + 16 * wid + 4 * fq); e0 = ev[0]; e1 = ev[1]; e2 = ev[2]; e3 = ev[3]; }
#pragma unroll
            for (int vt = 0; vt < NVT; ++vt) {
                u32x2 w; w.x = pk2(st[vt][0] * e0, st[vt][1] * e1); w.y = pk2(st[vt][2] * e2, st[vt][3] * e3);
                *(LAS u32x2*)(ST + (16 * vt + fr) * LQ + 16 * wid + 4 * fq) = w;
            }
        }
        f32x4 sc[2];
        sc[0] = (f32x4){0.f, 0.f, 0.f, 0.f}; sc[1] = sc[0];
        {
            const int tt = wid >> 1, s0t = (wid & 1) * 2;
#pragma unroll
            for (int ks = 0; ks < 4; ++ks) {
                const bf16x8 afr = ldfrag(Q, LQ, 16 * tt, 32 * ks, fr, fq);
#pragma unroll
                for (int si = 0; si < 2; ++si) { const bf16x8 bfr = ldfrag(Kn, LQ, 16 * (s0t + si), 32 * ks, fr, fq); MMA16(sc[si], bfr, afr); }
            }
            const int t = 16 * tt + fr;
#pragma unroll
            for (int si = 0; si < 2; ++si)
#pragma unroll
                for (int j = 0; j < 4; ++j) {
                    const int s = 16 * (s0t + si) + 4 * fq + j;
                    float v = sc[si][j];
                    if (!HG) v *= 0.08838834764831845f * fexp((float)(t - s) * log_g);
                    sc[si][j] = (s <= t) ? v : 0.f;
                }
        }
        __syncthreads();
        {
            const int tt = wid >> 1, s0t = (wid & 1) * 2, t = 16 * tt + fr;
#pragma unroll
            for (int si = 0; si < 2; ++si) { u32x2 w; w.x = pk2(sc[si][0], sc[si][1]); w.y = pk2(sc[si][2], sc[si][3]);
                *(LAS u32x2*)(P + t * LP + 16 * (s0t + si) + 4 * fq) = w; }
        }
        __syncthreads();
        {
            const int tt = wid & 3, vg = wid >> 2, t = 16 * tt + fr;
            bf16_t* zr = zb + (size_t)(row0 + t) * NZ + gcol;
            u32x2 gwv[NV];
#pragma unroll
            for (int i = 0; i < NV; ++i) gwv[i] = *(const u32x2*)(zr + 16 * (vg * NV + i) + 4 * fq);
            f32x4 oa[NV];
#pragma unroll
            for (int i = 0; i < NV; ++i) oa[i] = (f32x4){0.f, 0.f, 0.f, 0.f};
#pragma unroll
            for (int ks = 0; ks < 4; ++ks) {
                const bf16x8 afr = ldfrag(Q, LQ, 16 * tt, 32 * ks, fr, fq);
#pragma unroll
                for (int i = 0; i < NV; ++i) { const bf16x8 bfr = ldfrag(ST, LQ, 16 * (vg * NV + i), 32 * ks, fr, fq); MMA16(oa[i], bfr, afr); }
            }
            if (!HG) { const float qd = fexp((float)(t + 1) * log_g);
#pragma unroll
                for (int i = 0; i < NV; ++i) oa[i] *= qd; }
#pragma unroll
            for (int ks = 0; ks < 2; ++ks) {
                const bf16x8 afr = ldfrag(P, LP, 16 * tt, 32 * ks, fr, fq);
#pragma unroll
                for (int i = 0; i < NV; ++i) { const bf16x8 bfr = ldfrag_tr(V, LV, 16 * (vg * NV + i), 32 * ks, fr, fq); MMA16(oa[i], bfr, afr); }
            }
            float s = 0.f;
#pragma unroll
            for (int i = 0; i < NV; ++i) s += oa[i][0] * oa[i][0] + oa[i][1] * oa[i][1] + oa[i][2] * oa[i][2] + oa[i][3] * oa[i][3];
            s += __shfl_xor(s, 16); s += __shfl_xor(s, 32);
            if (fq == 0) red[vg * 64 + t] = s;
            __syncthreads();
            const float rs = frsq((red[t] + red[64 + t]) * (1.0f / (float)DV) + 1e-6f);
#pragma unroll
            for (int i = 0; i < NV; ++i) {
                const int v = 16 * (vg * NV + i) + 4 * fq;
                const u32x2 gw = gwv[i];
                float n0 = rs, n1 = rs, n2 = rs, n3 = rs;
                if (HG) { const f32x4 hn = *(const f32x4*)(p.in[15] + l * 1024 + h * 128 + v); n0 *= hn[0]; n1 *= hn[1]; n2 *= hn[2]; n3 *= hn[3]; }
                u32x2 w;
                w.x = pk2(oa[i][0] * n0 * siluf_(lo2f(gw.x)), oa[i][1] * n1 * siluf_(hi2f(gw.x)));
                w.y = pk2(oa[i][2] * n2 * siluf_(lo2f(gw.y)), oa[i][3] * n3 * siluf_(hi2f(gw.y)));
                if (!dry) *(u32x2*)(zr + v) = w;
            }
        }
        {
            if (HG) { const f32x4 ev = *(const LAS f32x4*)(eL + 16 * wid + 4 * fq);
#pragma unroll
                for (int vt = 0; vt < NVT; ++vt) st[vt] *= ev; }
            else { const float sd = fexp(64.0f * log_g);
#pragma unroll
                for (int vt = 0; vt < NVT; ++vt) st[vt] *= sd; }
#pragma unroll
            for (int ks = 0; ks < 2; ++ks) {
                const bf16x8 bfr = ldfrag_tr(KH, LQ, 16 * wid, 32 * ks, fr, fq);
#pragma unroll
                for (int vt = 0; vt < NVT; ++vt) { const bf16x8 afr = ldfrag_tr(V, LV, 16 * vt, 32 * ks, fr, fq); MMA16(st[vt], bfr, afr); }
            }
        }
        __syncthreads();
    }
    float* so = p.out + (HG ? O_HGP : O_RETP) + ((size_t)((l * 8 + b) * (HG ? 8 : 4) + h)) * 128 * DV;
#pragma unroll
    for (int vt = 0; vt < NVT; ++vt)
#pragma unroll
        for (int j = 0; j < 4; ++j) so[(size_t)(16 * wid + 4 * fq + j) * DV + 16 * vt + fr] = st[vt][j];
}

__device__ void lru_prompt(const Params& p, int l, int b, int n, LAS unsigned char* lds, int dry) {
    int tid = threadIdx.x; asm volatile("" : "+v"(tid));
    const int wid = __builtin_amdgcn_readfirstlane(tid >> 6), lane = tid & 63, fr = lane & 15, fq = lane >> 4;
    LAS float* XL = (LAS float*)lds;
    LAS bf16_t* XC = (LAS bf16_t*)(lds + 34304);
    LAS float* XCF = (LAS float*)(lds + 51712);
    LAS float* AA = (LAS float*)(lds + 84480);
    LAS float* UU = (LAS float*)(lds + 117248);
    LAS float* segA = (LAS float*)(lds + 150016);
    LAS float* segH = segA + 512;
    LAS float* hc = segH + 512;
    bf16_t* zb = (bf16_t*)(p.ws + WS_Z);
    const int e = tid & 127, seg = tid >> 7, ch = n * 128 + e;
    const float cw0 = p.in[17][(l * 4 + 0) * 1024 + ch], cw1 = p.in[17][(l * 4 + 1) * 1024 + ch], cw2 = p.in[17][(l * 4 + 2) * 1024 + ch], cw3 = p.in[17][(l * 4 + 3) * 1024 + ch];
    const float cb = p.in[18][l * 1024 + ch];
    bf16x8 Ba[4], Bx[4];
    {
        const float* wa = p.in[19] + ((size_t)(l * 8 + n)) * 16384;
        const float* wx = p.in[21] + ((size_t)(l * 8 + n)) * 16384;
#pragma unroll
        for (int ks = 0; ks < 4; ++ks)
#pragma unroll
            for (int j = 0; j < 8; ++j) {
                const int d = 32 * ks + 8 * fq + j;
                Ba[ks][j] = (short)f2bf(wa[d * 128 + 16 * wid + fr]);
                Bx[ks][j] = (short)f2bf(wx[d * 128 + 16 * wid + fr]);
            }
    }
    float ba[4], bx[4], sp[4];
#pragma unroll
    for (int j = 0; j < 4; ++j) {
        const int c2 = n * 128 + 16 * wid + 4 * fq + j;
        ba[j] = p.in[20][l * 1024 + c2]; bx[j] = p.in[22][l * 1024 + c2];
        const float lam = p.in[23][l * 1024 + c2];
        sp[j] = fmaxf(-lam, 0.f) + flog(1.0f + fexp(-fabsf(lam)));
    }
    if (tid < 384) XL[tid] = 0.f;
    if (tid < 128) hc[tid] = 0.f;
    __syncthreads();
    for (int c = 0; c < 32; ++c) {
        const int row0 = b * 2048 + c * 64;
        bf16_t glv[16];
#pragma unroll
        for (int j = 0; j < 16; ++j) glv[j] = zb[(size_t)(row0 + seg * 16 + j) * NZ + ZC_GL + ch];
#pragma unroll
        for (int i = 0; i < 2; ++i) {
            const int id = tid + 512 * i, tt = id >> 4, g = id & 15;
            const u32x4 w = *(const u32x4*)(zb + (size_t)(row0 + tt) * NZ + ZC_XL + n * 128 + 8 * g);
            LAS float* dst = XL + (3 + tt) * 128 + 8 * g;
            *(LAS f32x4*)dst = (f32x4){lo2f(w.x), hi2f(w.x), lo2f(w.y), hi2f(w.y)};
            *(LAS f32x4*)(dst + 4) = (f32x4){lo2f(w.z), hi2f(w.z), lo2f(w.w), hi2f(w.w)};
        }
        __syncthreads();
#pragma unroll 4
        for (int j = 0; j < 16; ++j) {
            const int t = seg * 16 + j;
            const float xc = cb + XL[t * 128 + e] * cw0 + XL[(t + 1) * 128 + e] * cw1 + XL[(t + 2) * 128 + e] * cw2 + XL[(t + 3) * 128 + e] * cw3;
            XCF[t * 128 + e] = xc; XC[t * 136 + e] = f2bf(xc);
        }
        __syncthreads();
#pragma unroll
        for (int tt = 0; tt < 4; ++tt) {
            f32x4 ga = (f32x4){0.f, 0.f, 0.f, 0.f}, gx = ga;
#pragma unroll
            for (int ks = 0; ks < 4; ++ks) { const bf16x8 afr = ldfrag(XC, 136, 16 * tt, 32 * ks, fr, fq); MMA16(ga, Ba[ks], afr); MMA16(gx, Bx[ks], afr); }
            const int t = 16 * tt + fr, e4 = 16 * wid + 4 * fq;
            const f32x4 xv = *(const LAS f32x4*)(XCF + t * 128 + e4);
            f32x4 av, uv;
#pragma unroll
            for (int j = 0; j < 4; ++j) {
                const float r = sigmoidf_(ga[j] + ba[j]), ii = sigmoidf_(gx[j] + bx[j]);
                const float la = -8.0f * r * sp[j];
                av[j] = fexp(la);
                uv[j] = __builtin_amdgcn_sqrtf(1.0f - fexp(2.0f * la)) * ii * xv[j];
            }
            *(LAS f32x4*)(AA + t * 128 + e4) = av; *(LAS f32x4*)(UU + t * 128 + e4) = uv;
        }
        __syncthreads();
        {
            float A = 1.f, H = 0.f;
#pragma unroll 4
            for (int j = 0; j < 16; ++j) { const int t = seg * 16 + j; const float a = AA[t * 128 + e]; H = a * H + UU[t * 128 + e]; A *= a; }
            segA[seg * 128 + e] = A; segH[seg * 128 + e] = H;
        }
        __syncthreads();
        float hh = hc[e];
        for (int s = 0; s < seg; ++s) hh = segA[s * 128 + e] * hh + segH[s * 128 + e];
#pragma unroll
        for (int j = 0; j < 16; ++j) {
            const int t = seg * 16 + j;
            hh = AA[t * 128 + e] * hh + UU[t * 128 + e];
            bf16_t* zp = zb + (size_t)(row0 + t) * NZ + ZC_GL + ch;
            if (!dry) *zp = f2bf(hh * geluf_(bf2f(glv[j])));
        }
        __syncthreads();
        if (seg == 3) hc[e] = hh;
        if (seg == 0) { XL[e] = XL[64 * 128 + e]; XL[128 + e] = XL[65 * 128 + e]; XL[256 + e] = XL[66 * 128 + e]; }
        __syncthreads();
    }
    if (seg == 0) {
        p.out[O_LRUP + (size_t)(l * 8 + b) * 1024 + ch] = hc[e];
#pragma unroll
        for (int i = 0; i < 3; ++i) p.out[O_CVP + ((size_t)(l * 8 + b) * 3 + i) * 1024 + ch] = XL[i * 128 + e];
    }
    __syncthreads();
}

template <bool HG>
__device__ void linattn_sample(const Params& p, int l, int b, int h, LAS unsigned char* lds, int dry) {
    constexpr int DV = HG ? 128 : 256, NPART = 512 / DV, DPP = 128 / NPART;
    int tid = threadIdx.x; asm volatile("" : "+v"(tid));
    LAS float* qs = (LAS float*)lds;
    LAS float* ks = qs + 512;
    LAS float* fs = ks + 512;
    LAS float* vs = fs + 512;
    LAS float* op = vs + 4 * DV;
    LAS float* red = op + NPART * 4 * DV;
    bf16_t* zb = (bf16_t*)(p.ws + WS_Z);
    const int rowb = T_P + 4 * b;
    const float log_g = HG ? 0.f : logf(1.0f - exp2f(-5.0f - (float)h));
    const float gam = HG ? 1.f : (1.0f - exp2f(-5.0f - (float)h));
    if (!HG) {
        if (tid < 256) {
            const int t = tid >> 6, i = tid & 63;
            const bf16_t* zr = zb + (size_t)(rowb + t) * NZ;
            const float2 cs = ((const float2*)(p.ws + WS_ROPE))[(size_t)(2048 + t) * 64 + i];
            const float q1 = bf2f(zr[ZC_QR + h * 128 + i]), q2 = bf2f(zr[ZC_QR + h * 128 + 64 + i]);
            const float k1 = bf2f(zr[ZC_KR + h * 128 + i]), k2 = bf2f(zr[ZC_KR + h * 128 + 64 + i]);
            qs[t * 128 + i] = q1 * cs.x - q2 * cs.y; qs[t * 128 + 64 + i] = q1 * cs.y + q2 * cs.x;
            ks[t * 128 + i] = (k1 * cs.x - k2 * cs.y) * 0.08838834764831845f; ks[t * 128 + 64 + i] = (k1 * cs.y + k2 * cs.x) * 0.08838834764831845f;
        }
#pragma unroll
        for (int i = 0; i < 2; ++i) { const int id = tid + 512 * i, t = id >> 8, v = id & 255; vs[t * 256 + v] = bf2f(zb[(size_t)(rowb + t) * NZ + ZC_VR + h * 256 + v]); }
    } else {
        const int t = tid >> 7, d = tid & 127;
        const bf16_t* zr = zb + (size_t)(rowb + t) * NZ;
        float lb = 0.f;
        if (l == 1) { const int c = h * 128 + d; lb = sigmoidf_(p.in[14][1024 + c] - p.in[14][c]); }
        const float f = bf2f(zr[ZC_FH + h * 128 + d]), q = bf2f(zr[ZC_QH + h * 128 + d]);
        const float ls = fminf(f, 0.f) - flog(1.0f + fexp(-fabsf(f)));
        const float sg = fexp(ls);
        fs[t * 128 + d] = lb + (1.0f - lb) * sg;
        ks[t * 128 + d] = (1.0f - lb) * fexp(ls - f);
        qs[t * 128 + d] = siluf_(q);
        vs[t * 128 + d] = bf2f(zr[ZC_IH + h * 128 + d]);
    }
    __syncthreads();
    {
        const int v = tid % DV, part = tid / DV;
        const float v0 = vs[v], v1 = vs[DV + v], v2 = vs[2 * DV + v], v3 = vs[3 * DV + v];
        const size_t sbase = ((size_t)((l * 128 + b) * (HG ? 8 : 4) + h)) * 128 * DV;
        const float* Sin = (HG ? p.in[3] : p.in[2]) + sbase;
        float* Sout = p.out + (HG ? O_HGS : O_RETS) + sbase;
        float o0 = 0.f, o1 = 0.f, o2 = 0.f, o3 = 0.f;
#pragma unroll 1
        for (int d0 = 0; d0 < DPP; d0 += 16) {
            float S[16];
#pragma unroll
            for (int i = 0; i < 16; ++i) S[i] = __builtin_nontemporal_load(Sin + (size_t)(part * DPP + d0 + i) * DV + v);
#pragma unroll
            for (int i = 0; i < 16; ++i) {
                const int d = part * DPP + d0 + i;
                const float f0 = HG ? fs[d] : gam, f1 = HG ? fs[128 + d] : gam, f2 = HG ? fs[256 + d] : gam, f3 = HG ? fs[384 + d] : gam;
                float Sv = S[i];
                Sv = f0 * Sv + ks[d] * v0; o0 += qs[d] * Sv;
                Sv = f1 * Sv + ks[128 + d] * v1; o1 += qs[128 + d] * Sv;
                Sv = f2 * Sv + ks[256 + d] * v2; o2 += qs[256 + d] * Sv;
                Sv = f3 * Sv + ks[384 + d] * v3; o3 += qs[384 + d] * Sv;
                S[i] = Sv;
                if ((i & 3) == 3) asm volatile("" ::: "memory");
            }
#pragma unroll
            for (int i = 0; i < 16; ++i) __builtin_nontemporal_store(S[i], Sout + (size_t)(part * DPP + d0 + i) * DV + v);
        }
        op[(part * 4 + 0) * DV + v] = o0; op[(part * 4 + 1) * DV + v] = o1; op[(part * 4 + 2) * DV + v] = o2; op[(part * 4 + 3) * DV + v] = o3;
    }
    __syncthreads();
    {
        const int t = tid >> 7, vv = tid & 127;
        constexpr int NPT = DV / 128;
        float o[NPT]; float s = 0.f;
#pragma unroll
        for (int i = 0; i < NPT; ++i) { const int v = vv + 128 * i; float a = 0.f;
#pragma unroll
            for (int q = 0; q < NPART; ++q) a += op[(q * 4 + t) * DV + v];
            o[i] = a; s += a * a; }
#pragma unroll
        for (int off = 32; off >= 1; off >>= 1) s += __shfl_xor(s, off);
        if ((tid & 63) == 0) red[tid >> 6] = s;
        __syncthreads();
        const float rs = frsq((red[2 * t] + red[2 * t + 1]) * (1.0f / (float)DV) + 1e-6f);
        const int gcol = HG ? ZC_GH + h * 128 : ZC_GR + h * 256;
        bf16_t* zr = zb + (size_t)(rowb + t) * NZ + gcol;
#pragma unroll
        for (int i = 0; i < NPT; ++i) { const int v = vv + 128 * i;
            float nrm = rs; if (HG) nrm *= p.in[15][l * 1024 + h * 128 + v];
            const bf16_t ov = f2bf(o[i] * nrm * siluf_(bf2f(zr[v]))); if (!dry) zr[v] = ov; }
    }
    __syncthreads();
}

__device__ void lru_sample(const Params& p, int l, int item, LAS unsigned char* lds, int dry) {
    int tid = threadIdx.x; asm volatile("" : "+v"(tid));
    LAS float* XX = (LAS float*)lds;
    LAS float* XC = XX + 2 * 7 * 1024;
    bf16_t* zb = (bf16_t*)(p.ws + WS_Z);
    const int b0 = item * 2;
    for (int i = tid; i < 2 * 7 * 1024; i += 512) {
        const int sq = i / 7168, r = (i % 7168) >> 10, ch = i & 1023, b = b0 + sq;
        float v;
        if (r < 3) v = p.in[5][((size_t)(l * 128 + b) * 3 + r) * 1024 + ch];
        else v = bf2f(zb[(size_t)(T_P + 4 * b + (r - 3)) * NZ + ZC_XL + ch]);
        XX[i] = v;
    }
    __syncthreads();
    for (int i = tid; i < 8 * 1024; i += 512) {
        const int tok = i >> 10, ch = i & 1023, sq = tok >> 2, t = tok & 3;
        const LAS float* xx = XX + sq * 7168 + ch;
        float xc = p.in[18][l * 1024 + ch];
#pragma unroll
        for (int k = 0; k < 4; ++k) xc += xx[(t + k) * 1024] * p.in[17][(l * 4 + k) * 1024 + ch];
        XC[i] = xc;
    }
    __syncthreads();
#pragma unroll 1
    for (int cc = 0; cc < 2; ++cc) {
        const int ch = tid + 512 * cc, n = ch >> 7, e = ch & 127;
        const float* wa = p.in[19] + ((size_t)(l * 8 + n)) * 16384 + e;
        const float* wx = p.in[21] + ((size_t)(l * 8 + n)) * 16384 + e;
        float ga[8], gx[8];
#pragma unroll
        for (int k = 0; k < 8; ++k) { ga[k] = 0.f; gx[k] = 0.f; }
#pragma unroll 4
        for (int d = 0; d < 128; ++d) {
            const float a = wa[d * 128], x = wx[d * 128];
#pragma unroll
            for (int k = 0; k < 8; ++k) { const float xv = XC[k * 1024 + n * 128 + d]; ga[k] += xv * a; gx[k] += xv * x; }
        }
        const float ba = p.in[20][l * 1024 + ch], bx = p.in[22][l * 1024 + ch], lam = p.in[23][l * 1024 + ch];
        const float sp = fmaxf(-lam, 0.f) + flog(1.0f + fexp(-fabsf(lam)));
        bf16_t glv[8];
#pragma unroll
        for (int k = 0; k < 8; ++k) glv[k] = zb[(size_t)(T_P + 4 * (b0 + (k >> 2)) + (k & 3)) * NZ + ZC_GL + ch];
        float h0v[2];
#pragma unroll
        for (int sq = 0; sq < 2; ++sq) h0v[sq] = p.in[4][(size_t)(l * 128 + b0 + sq) * 1024 + ch];
#pragma unroll
        for (int sq = 0; sq < 2; ++sq) {
            const int b = b0 + sq;
            float hh = h0v[sq];
#pragma unroll
            for (int t = 0; t < 4; ++t) {
                const int k = sq * 4 + t;
                const float r = sigmoidf_(ga[k] + ba), ii = sigmoidf_(gx[k] + bx);
                const float la = -8.0f * r * sp;
                const float a = fexp(la), u = __builtin_amdgcn_sqrtf(1.0f - fexp(2.0f * la)) * ii * XC[k * 1024 + ch];
                hh = a * hh + u;
                bf16_t* zp = zb + (size_t)(T_P + 4 * b + t) * NZ + ZC_GL + ch;
                if (!dry) *zp = f2bf(hh * geluf_(bf2f(glv[k])));
            }
            p.out[O_LRUS + (size_t)(l * 128 + b) * 1024 + ch] = hh;
#pragma unroll
            for (int r = 0; r < 3; ++r) p.out[O_CVS + ((size_t)(l * 128 + b) * 3 + r) * 1024 + ch] = XX[sq * 7168 + (4 + r) * 1024 + ch];
        }
    }
    __syncthreads();
}

__device__ void recur_phase(const Params& p, int l, LAS unsigned char* lds, int dry, int ctr_idx) {
    int bid = blockIdx.x; asm volatile("" : "+s"(bid));
#pragma unroll 1
    for (int pp = 0; pp < ((DBL_MASK & 16) ? 2 : 1); ++pp) {
        const int dry2 = ((DBL_MASK & 16) && pp == 0) ? 1 : dry;
        if (bid < 32) linattn_prompt<false>(p, l, bid >> 2, bid & 3, lds, dry2);
        else if (bid < 96) linattn_prompt<true>(p, l, (bid - 32) >> 3, (bid - 32) & 7, lds, dry2);
        else if (bid < 160) lru_prompt(p, l, (bid - 96) >> 3, (bid - 96) & 7, lds, dry2);
    }
    unsigned* ctr = (unsigned*)(p.ws + WS_CTR) + ctr_idx;
    LAS unsigned* slot = (LAS unsigned*)(lds + LDS_BYTES - 16);
    for (;;) {
        __syncthreads();
        if (threadIdx.x == 0) *slot = atomicAdd(ctr, 1u);
        __syncthreads();
        const unsigned it = (unsigned)__builtin_amdgcn_readfirstlane((int)*slot);
        if (it >= 1600u) break;
        if (it < 512u) linattn_sample<false>(p, l, it >> 2, it & 3, lds, dry);
        else if (it < 1536u) linattn_sample<true>(p, l, (it - 512) >> 3, (it - 512) & 7, lds, dry);
        else lru_sample(p, l, it - 1536, lds, dry);
    }
}

__device__ __forceinline__ void gbar(unsigned* bar, unsigned& gen, unsigned nblk) {
    asm volatile("s_waitcnt vmcnt(0)" ::: "memory");
    __syncthreads();
    if (threadIdx.x == 0) {
        __builtin_amdgcn_fence(__ATOMIC_RELEASE, "agent");
        asm volatile("s_waitcnt vmcnt(0)" ::: "memory");
        const unsigned target = (gen + 1u) * nblk;
        __hip_atomic_fetch_add(bar, 1u, __ATOMIC_RELAXED, __HIP_MEMORY_SCOPE_AGENT);
        while (__hip_atomic_load(bar, __ATOMIC_RELAXED, __HIP_MEMORY_SCOPE_AGENT) < target) __builtin_amdgcn_s_sleep(1);
        __builtin_amdgcn_fence(__ATOMIC_ACQUIRE, "agent");
        asm volatile("s_waitcnt vmcnt(0)" ::: "memory");
    }
    gen += 1u;
    __syncthreads();
}

__global__ void __launch_bounds__(512) fwd_megakernel(Params p) {
    extern __shared__ __attribute__((aligned(16))) unsigned char smem_raw[];
    LAS unsigned char* lds = (LAS unsigned char*)smem_raw;
    cg::grid_group grid = cg::this_grid();
    using namespace pg8;
    const int G = gridDim.x, c = blockIdx.x;
    bf16_t* wb = (bf16_t*)(p.ws + WS_W);
    bf16_t* xb = (bf16_t*)(p.ws + WS_XB);
    bf16_t* zb = (bf16_t*)(p.ws + WS_Z);
    bf16_t* hid = zb;
    float* ss = (float*)(p.ws + WS_SS);
    float* x = p.out;

    int one = 1;
#if DBL_MASK
    asm volatile("" : "+s"(one));
#endif
    unsigned* gbar_w = (unsigned*)(p.ws + WS_BAR); unsigned bgen = 0u;
#define GSYNC() do { gbar(gbar_w, bgen, (unsigned)G); if (DBL_MASK & 4) gbar(gbar_w, bgen, (unsigned)G); } while (0)
#define LAUNDER() int cl = c, Gl = G; asm volatile("" : "+s"(cl), "+s"(Gl))
#define NPASS(bit) ((DBL_MASK & (bit)) ? 2 : 1)
#pragma unroll 1
    for (int ps = 0; ps < NPASS(8); ++ps) { phase0(p, lds); grid.sync(); }
#pragma unroll 1
    for (int l = 0; l < 2; ++l) {
        bf16_t* wl = wb + (size_t)l * W_LAYER;
#pragma unroll 1
        for (int f = 0; f < 2; ++f) {
            if (f == 1) {
#pragma unroll 1
                for (int ps = 0; ps < NPASS(1); ++ps) { LAUNDER(); Gemm g{xb, xb, xb, wl + OFF_WIN, 0, DM, DM}; StaticOrder so; so.init(T_ALL, NZ, Gl, cl); EpiWin e{zb, ss + (size_t)(3 * l + 1) * T_ALL}; gemm_phase(lds, g, so, e); }
                GSYNC();
#pragma unroll 1
                for (int ps = 0; ps < NPASS(2); ++ps) { const int dry = (ps + 1 < NPASS(2)) ? one : 0; recur_phase(p, l, lds, dry, l + 2 * ps); }
                GSYNC();
#pragma unroll 1
                for (int ps = 0; ps < NPASS(1); ++ps) { const int dry = (ps + 1 < NPASS(1)) ? one : 0; LAUNDER(); Gemm g{zb + ZC_GR, zb + ZC_GH, zb + ZC_GL, wl + OFF_RO, (size_t)DM * DM, NZ, DM}; BranchOrder bo; bo.so.init(T_ALL, DM, Gl, cl); EpiBranch e{zb, p.in[12] + l * 3 * DM, dry}; gemm_phase(lds, g, bo, e); }
                GSYNC();
#pragma unroll 1
                for (int ps = 0; ps < NPASS(1); ++ps) { const int dry = (ps + 1 < NPASS(1)) ? one : 0; LAUNDER(); Gemm g{zb, zb, zb, wl + OFF_MO, 0, NZ, DM}; StaticOrder so; so.init(T_ALL, DM, Gl, cl); EpiRes e{x, xb, ss + (size_t)(3 * l + 2) * T_ALL, 1.0f, dry}; gemm_phase(lds, g, so, e); }
                GSYNC();
            }
#pragma unroll 1
            for (int ps = 0; ps < NPASS(1); ++ps) { LAUNDER(); Gemm g{xb, xb, xb, wl + (f == 0 ? OFF_GU1 : OFF_GU2), 0, DM, DM}; StaticOrder so; so.init(T_ALL, 2 * FH, Gl, cl); EpiUp e{hid, ss + (size_t)(3 * l + 2 * f) * T_ALL}; gemm_phase(lds, g, so, e); }
            GSYNC();
#pragma unroll 1
            for (int ps = 0; ps < NPASS(1); ++ps) { const int dry = (ps + 1 < NPASS(1)) ? one : 0; LAUNDER(); Gemm g{hid, hid, hid, wl + (f == 0 ? OFF_D1 : OFF_D2), 0, FH, FH}; StaticOrder so; so.init(T_ALL, DM, Gl, cl); EpiRes e{x, xb, ss + (size_t)(3 * l + 2 * f + 1) * T_ALL, 0.5f, dry}; gemm_phase(lds, g, so, e); }
            GSYNC();
        }
    }
    {
        const float* ssf = ss + (size_t)6 * T_ALL;
        const int wid = threadIdx.x >> 6, lane = threadIdx.x & 63;
        for (int row = c * 8 + wid; row < T_ALL; row += G * 8) {
            const float r = frsq(ssf[row] * (1.0f / 1024.0f) + 1e-6f);
#pragma unroll
            for (int i = 0; i < 4; ++i) {
                const int col = i * 256 + lane * 4;
                f32x4 v = *(f32x4*)(x + (size_t)row * DM + col);
                const f32x4 gn = *(const f32x4*)(p.in[30] + col);
                v = v * r * gn;
                *(f32x4*)(x + (size_t)row * DM + col) = v;
            }
        }
    }
}

extern "C" void kernel_launch(void* const* d_in, const int* in_sizes, int n_in, void* d_out, int out_size, void* d_ws, size_t ws_size, hipStream_t stream) {
    static int grid = 0;
    if (grid == 0) {
        if (n_in != 31 || ws_size < WS_END) { fprintf(stderr, "kernel_launch: need 31 inputs and %zu bytes of workspace (got %d, %zu)\n", (size_t)WS_END, n_in, ws_size); grid = -1; return; }
        int dev = 0, cus = 0, per_cu = 0;
        hipGetDevice(&dev);
        hipDeviceGetAttribute(&cus, hipDeviceAttributeMultiprocessorCount, dev);
        if (hipFuncSetAttribute((const void*)fwd_megakernel, hipFuncAttributeMaxDynamicSharedMemorySize, LDS_BYTES) != hipSuccess) { fprintf(stderr, "kernel_launch: hipFuncSetAttribute failed\n"); grid = -1; return; }
        hipOccupancyMaxActiveBlocksPerMultiprocessor(&per_cu, (const void*)fwd_megakernel, 512, LDS_BYTES);
        if (per_cu < 1) { fprintf(stderr, "kernel_launch: occupancy query says %d blocks per CU\n", per_cu); per_cu = 1; }
        (void)hipGetLastError();
        grid = cus;
    }
    if (grid < 0) return;
    if (hipMemsetAsync((char*)d_ws + WS_BAR, 0, 256, stream) != hipSuccess) { fprintf(stderr, "kernel_launch: memset failed\n"); return; }
    Params p{};
    for (int i = 0; i < 31; ++i) p.in[i] = (const float*)d_in[i];
    p.out = (float*)d_out; p.ws = (unsigned char*)d_ws;
    void* args[] = {&p};
    hipError_t e = hipLaunchCooperativeKernel((const void*)fwd_megakernel, dim3(grid), dim3(512), args, LDS_BYTES, stream);
    if (e != hipSuccess) fprintf(stderr, "cooperative launch failed: %s (grid %d)\n", hipGetErrorString(e), grid);
}
```

```cpp
#include <hip/hip_runtime.h>
#include <hip/hip_cooperative_groups.h>
#include <cstdio>
namespace cg = cooperative_groups;
#ifndef DBL_MASK
#define DBL_MASK 0
#endif

#define LAS __attribute__((address_space(3)))
typedef unsigned short bf16_t;
typedef short bf16x8 __attribute__((ext_vector_type(8)));
typedef short s16x4 __attribute__((ext_vector_type(4)));
typedef float f32x4 __attribute__((ext_vector_type(4)));
typedef unsigned u32x4 __attribute__((ext_vector_type(4)));
typedef unsigned u32x2 __attribute__((ext_vector_type(2)));

constexpr int T_ALL = 16896, T_P = 16384, DM = 1024, FH = 2816, NZ = 12288;
constexpr int LDS_BYTES = 163840;
constexpr size_t OFF_GU1 = 0, OFF_D1 = 5767168, OFF_WIN = 8650752, OFF_RO = 21233664, OFF_HO = 22282240, OFF_LO = 23330816,
                 OFF_MO = 24379392, OFF_GU2 = 25427968, OFF_D2 = 31195136, W_LAYER = 34078720;
constexpr size_t WS_W = 0, WS_XB = 2 * W_LAYER * 2, WS_Z = WS_XB + (size_t)T_ALL * DM * 2, WS_SS = WS_Z + (size_t)T_ALL * NZ * 2,
                 WS_ROPE = WS_SS + (size_t)8 * T_ALL * 4, WS_CTR = WS_ROPE + (size_t)2052 * 64 * 8, WS_BAR = WS_CTR + 256, WS_LB = WS_BAR + 512, WS_HIDS = WS_LB + 4096, WS_MF = WS_HIDS + (size_t)512 * FH * 2, WS_END = WS_MF + (size_t)3 * 512 * DM * 4;
constexpr int ZC_QR = 0, ZC_KR = 512, ZC_VR = 1024, ZC_GR = 2048, ZC_QH = 3072, ZC_FH = 4096, ZC_IH = 5120, ZC_GH = 6144, ZC_XL = 7168, ZC_GL = 8192, ZC_GATE = 9216;
constexpr size_t O_RETP = 17301504, O_RETS = 19398656, O_HGP = 52953088, O_HGS = 55050240, O_LRUP = 88604672, O_LRUS = 88621056, O_CVP = 88883200, O_CVS = 88932352;

struct Params { const float* in[31]; float* out; unsigned char* ws; };

__device__ __forceinline__ float bf2f(bf16_t b) { return __uint_as_float(((unsigned)b) << 16); }
__device__ __forceinline__ unsigned pk2(float lo, float hi) { unsigned r; asm("v_cvt_pk_bf16_f32 %0, %1, %2" : "=v"(r) : "v"(lo), "v"(hi)); return r; }
__device__ __forceinline__ bf16_t f2bf(float f) { return (bf16_t)(pk2(f, f) & 0xffffu); }
__device__ __forceinline__ float lo2f(unsigned w) { return __uint_as_float(w << 16); }
__device__ __forceinline__ float hi2f(unsigned w) { return __uint_as_float(w & 0xffff0000u); }
__device__ __forceinline__ float fexp(float x) { return __builtin_amdgcn_exp2f(x * 1.4426950408889634f); }
__device__ __forceinline__ float flog(float x) { return __builtin_amdgcn_logf(x) * 0.6931471805599453f; }
__device__ __forceinline__ float sigmoidf_(float x) { return __builtin_amdgcn_rcpf(1.0f + fexp(-x)); }
__device__ __forceinline__ float siluf_(float x) { return x * __builtin_amdgcn_rcpf(1.0f + fexp(-x)); }
__device__ __forceinline__ float geluf_(float x) { const float y = 0.7978845608028654f * (x + 0.044715f * x * x * x); const float e = fexp(2.0f * y); const float th = 1.0f - 2.0f * __builtin_amdgcn_rcpf(e + 1.0f); return 0.5f * x * (1.0f + th); }
__device__ __forceinline__ float frsq(float x) { return __builtin_amdgcn_rsqf(x); }

namespace pg8 {
constexpr int BM = 256, BK = 64, HALF = 128, HTB = HALF * BK * 2, NXCD = 8, WGM = 8;
__device__ __forceinline__ int lds_byte(int r, int c) { const int st = (r >> 4) * 2 + (c >> 5), rr = r & 15, cc = c & 31, ob = rr * 64 + cc * 2; return st * 1024 + (ob ^ (((ob >> 9) & 1) << 5)); }
__device__ __forceinline__ void stage_rc(int b, int& R, int& C) { const int st = b / 1024, sb = b % 1024, swz = sb ^ (((sb >> 9) & 1) << 5); R = (st >> 1) * 16 + swz / 64; C = (st & 1) * 32 + (swz % 64) / 2; }
__device__ __forceinline__ int perm32(int rho) { const int n = rho >> 4, i = rho & 15; return 8 * (i >> 2) + 4 * n + (i & 3); }

struct Unit { int pm, pn, br, kofs; };
struct Gemm { const bf16_t* A0; const bf16_t* A1; const bf16_t* A2; const bf16_t* B0; size_t bstride; int lda, ldb, K; };

struct StaticOrder {
    int nM, nN, nwg, G, c, pm0;
    __device__ void init(int M, int N, int G_, int c_, int pm0_) { nM = M / BM; nN = N / BM; nwg = nM * nN; G = G_; c = c_; pm0 = pm0_; }
    __device__ bool next(int i, Unit& u) const {
        const long L = (long)i * G + c; if (L >= nwg) return false;
        int wgid = (int)L; { const int q = nwg / NXCD, r = nwg % NXCD, xcd = wgid % NXCD, off = wgid / NXCD; wgid = (xcd < r ? xcd * (q + 1) : r * (q + 1) + (xcd - r) * q) + off; }
        const int nig = WGM * nN, gid = wgid / nig, fm = gid * WGM, gsz = (nM - fm) < WGM ? (nM - fm) : WGM;
        u.pm = pm0 + fm + ((wgid % nig) % gsz); u.pn = (wgid % nig) / gsz; u.br = 0; u.kofs = 0; return true;
    }
};
struct SplitOrder {
    int nM, nN, nbr, nsplit, klen, G, c, pm0;
    __device__ bool next(int i, Unit& u) const {
        const int L = i * G + c; if (L >= nM * nN * nbr * nsplit) return false;
        const int ks = L % nsplit, r = L / nsplit; u.br = r % nbr; const int t = r / nbr; u.pm = pm0 + t % nM; u.pn = t / nM; u.kofs = ks * klen; return true;
    }
};
struct BranchOrder {
    StaticOrder so;
    __device__ bool next(int i, Unit& u) const { if (!so.next(i / 3, u)) return false; u.br = i % 3; return true; }
};

template <class Epi, class Sched>
__device__ __forceinline__ void gemm_phase(LAS unsigned char* lds, const Gemm g, const Sched& S, const Epi& E) {
    int tid = threadIdx.x; asm volatile("" : "+v"(tid));
    const int wid = __builtin_amdgcn_readfirstlane(tid >> 6), lane = tid & 63, wr = wid >> 2, wc = wid & 3, fr = lane & 15, fq = lane >> 4;
    const int K = g.ldb, nt = g.K / BK, lda = g.lda;
    unsigned voffA[2], voffB[2];
#pragma unroll
    for (int i = 0; i < 2; ++i) { int R, C; stage_rc(tid * 16 + i * 8192, R, C); const int Rb = Epi::PERM ? ((R & ~31) + perm32(R & 31)) : R;
        voffA[i] = (unsigned)(R * lda + C) * 2u; voffB[i] = (unsigned)(Rb * K + C) * 2u; }
    const size_t kstep = (size_t)(BK * 2);
    const size_t hstepA = (size_t)HALF * lda * 2, hstepB = (size_t)HALF * K * 2;
    const size_t tstepA = 2 * hstepA, tstepB = 2 * hstepB;
    const unsigned ldsw = (unsigned)wid * 1024u;
    const int aoff = lds_byte(wr * 64 + fr, fq * 8), boff = lds_byte(wc * 32 + fr, fq * 8);
#define PG8_SA(b, h) (((b) * 2 + (h)) * HTB)
#define PG8_SB(b, h) ((4 + (b) * 2 + (h)) * HTB)
#define PG8_STAGE(bufoff, gbase, voff) do { _Pragma("unroll") for (int _i = 0; _i < 2; ++_i) \
        __builtin_amdgcn_global_load_lds((const unsigned*)((const char*)(gbase) + (voff)[_i]), (LAS unsigned*)(lds + (bufoff) + ldsw + _i * 8192), 16, 0, 0); } while (0)
#define PG8_LDA(dst, b, h) do { _Pragma("unroll") for (int m = 0; m < 4; ++m) _Pragma("unroll") for (int k = 0; k < 2; ++k) dst[m][k] = *(const LAS bf16x8*)(lds + PG8_SA(b, h) + aoff + m * 2048 + k * 1024); } while (0)
#define PG8_LDB(dst, b, h) do { _Pragma("unroll") for (int n = 0; n < 2; ++n) _Pragma("unroll") for (int k = 0; k < 2; ++k) dst[n][k] = *(const LAS bf16x8*)(lds + PG8_SB(b, h) + boff + n * 2048 + k * 1024); } while (0)
#define PG8_MMA(ai, bj, At, Bt) do { __builtin_amdgcn_s_setprio(1); _Pragma("unroll") for (int m = 0; m < 4; ++m) _Pragma("unroll") for (int n = 0; n < 2; ++n) _Pragma("unroll") for (int k = 0; k < 2; ++k) \
        acc[ai][bj][m][n] = __builtin_amdgcn_mfma_f32_16x16x32_bf16(Bt[n][k], At[m][k], acc[ai][bj][m][n], 0, 0, 0); __builtin_amdgcn_s_setprio(0); } while (0)
#define PG8_WAIT_V(n) asm volatile("s_waitcnt vmcnt(" #n ")" ::: "memory")
#define PG8_WAIT_L(n) asm volatile("s_waitcnt lgkmcnt(" #n ")" ::: "memory")
#define PG8_BAR __builtin_amdgcn_s_barrier()
#define PG8_SCHED __builtin_amdgcn_sched_barrier(0)
#define PG8_APTR(u) ((const char*)((u).br == 0 ? g.A0 : ((u).br == 1 ? g.A1 : g.A2)) + (size_t)(u).pm * tstepA + (size_t)(u).kofs * 2)
#define PG8_BPTR(u) ((const char*)(g.B0 + (size_t)(u).br * g.bstride) + (size_t)(u).pn * tstepB + (size_t)(u).kofs * 2)
    Unit cur, nxt; int ui = 0;
    if (!S.next(0, cur)) return;
    f32x4 acc[2][2][4][2];
#pragma unroll
    for (int a = 0; a < 2; ++a)
#pragma unroll
        for (int b = 0; b < 2; ++b)
#pragma unroll
            for (int m = 0; m < 4; ++m)
#pragma unroll
                for (int n = 0; n < 2; ++n) acc[a][b][m][n] = (f32x4){0.f, 0.f, 0.f, 0.f};
    bf16x8 At[4][2], B0[2][2], B1[2][2];
    const char* cA = PG8_APTR(cur); const char* cB = PG8_BPTR(cur);
    PG8_STAGE(PG8_SB(0, 0), cB, voffB); PG8_STAGE(PG8_SA(0, 0), cA, voffA); PG8_STAGE(PG8_SB(0, 1), cB + hstepB, voffB); PG8_STAGE(PG8_SA(0, 1), cA + hstepA, voffA);
    if (wr == 1) PG8_BAR;
    PG8_WAIT_V(4); PG8_BAR;
    PG8_STAGE(PG8_SB(1, 0), cB + kstep, voffB); PG8_STAGE(PG8_SA(1, 0), cA + kstep, voffA); PG8_STAGE(PG8_SB(1, 1), cB + hstepB + kstep, voffB);
    PG8_WAIT_V(6); PG8_BAR;
    for (;;) {
        const bool has_next = S.next(ui + 1, nxt);
        const char* nA = has_next ? PG8_APTR(nxt) : cA; const char* nB = has_next ? PG8_BPTR(nxt) : cB;
        for (int t = 0; t < nt; t += 2) {
            const bool last = (t == nt - 2);
            const char* a1 = cA + (size_t)(t + 1) * kstep;
            const char* a2 = last ? nA : cA + (size_t)(t + 2) * kstep; const char* b2 = last ? nB : cB + (size_t)(t + 2) * kstep;
            const char* a3 = a2 + kstep; const char* b3 = b2 + kstep;
            PG8_LDB(B0, 0, 0); PG8_SCHED; PG8_LDA(At, 0, 0); PG8_STAGE(PG8_SA(1, 1), a1 + hstepA, voffA);
            PG8_WAIT_L(8); PG8_BAR; PG8_WAIT_L(0); PG8_MMA(0, 0, At, B0); PG8_BAR; PG8_SCHED;
            PG8_LDB(B1, 0, 1); PG8_STAGE(PG8_SB(0, 0), b2, voffB);
            PG8_BAR; PG8_WAIT_L(0); PG8_MMA(0, 1, At, B1); PG8_BAR;
            PG8_LDA(At, 0, 1); PG8_STAGE(PG8_SA(0, 0), a2, voffA);
            PG8_BAR; PG8_WAIT_L(0); PG8_MMA(1, 0, At, B0); PG8_BAR; PG8_SCHED;
            PG8_STAGE(PG8_SB(0, 1), b2 + hstepB, voffB);
            PG8_WAIT_V(6); PG8_BAR; PG8_MMA(1, 1, At, B1); PG8_BAR;
            PG8_LDB(B0, 1, 0); PG8_SCHED; PG8_LDA(At, 1, 0); PG8_STAGE(PG8_SA(0, 1), a2 + hstepA, voffA);
            PG8_WAIT_L(8); PG8_BAR; PG8_WAIT_L(0); PG8_MMA(0, 0, At, B0); PG8_BAR; PG8_SCHED;
            PG8_LDB(B1, 1, 1); PG8_STAGE(PG8_SB(1, 0), b3, voffB);
            PG8_BAR; PG8_WAIT_L(0); PG8_MMA(0, 1, At, B1); PG8_BAR;
            PG8_LDA(At, 1, 1); PG8_STAGE(PG8_SA(1, 0), a3, voffA);
            PG8_BAR; PG8_WAIT_L(0); PG8_MMA(1, 0, At, B0); PG8_BAR; PG8_SCHED;
            PG8_STAGE(PG8_SB(1, 1), b3 + hstepB, voffB);
            PG8_WAIT_V(6); PG8_BAR; PG8_MMA(1, 1, At, B1); PG8_BAR;
        }
        E(acc, cur, wr, wc, fr, fq);
        if (!has_next) break;
#pragma unroll
        for (int a = 0; a < 2; ++a)
#pragma unroll
            for (int b = 0; b < 2; ++b)
#pragma unroll
                for (int m = 0; m < 4; ++m)
#pragma unroll
                    for (int n = 0; n < 2; ++n) acc[a][b][m][n] = (f32x4){0.f, 0.f, 0.f, 0.f};
        cur = nxt; cA = nA; cB = nB; ++ui;
    }
    PG8_WAIT_V(0);
    if (wr == 0) PG8_BAR;
    PG8_BAR;
#undef PG8_SA
#undef PG8_SB
#undef PG8_STAGE
#undef PG8_LDA
#undef PG8_LDB
#undef PG8_MMA
#undef PG8_WAIT_V
#undef PG8_WAIT_L
#undef PG8_BAR
#undef PG8_SCHED
#undef PG8_APTR
#undef PG8_BPTR
}

struct EpiUp {
    static constexpr bool PERM = false;
    bf16_t* hid; const float* ss;
    __device__ __forceinline__ void operator()(const f32x4 (&acc)[2][2][4][2], const Unit& u, int wr, int wc, int fr, int fq) const {
        const int row0 = u.pm * BM + wr * 64 + fr;
        float rr[2][4];
#pragma unroll
        for (int ai = 0; ai < 2; ++ai)
#pragma unroll
            for (int m = 0; m < 4; ++m) rr[ai][m] = ss[row0 + ai * HALF + m * 16];
#pragma unroll
        for (int ai = 0; ai < 2; ++ai)
#pragma unroll
            for (int m = 0; m < 4; ++m) {
                const int row = row0 + ai * HALF + m * 16;
                const float r = frsq(rr[ai][m] * (1.0f / 1024.0f) + 1e-6f);
#pragma unroll
                for (int bj = 0; bj < 2; ++bj) {
                    const f32x4 gt = acc[ai][bj][m][0] * r, up = acc[ai][bj][m][1] * r;
                    float h[4];
#pragma unroll
                    for (int j = 0; j < 4; ++j) h[j] = siluf_(gt[j]) * up[j];
                    const int col = 16 * (8 * u.pn + 4 * bj + wc) + 4 * fq;
                    u32x2 w; w.x = pk2(h[0], h[1]); w.y = pk2(h[2], h[3]);
                    *(u32x2*)(hid + (size_t)row * FH + col) = w;
                }
            }
    }
};
struct EpiRes {
    static constexpr bool PERM = false;
    float* x; bf16_t* xb; float* ssn; float scale; int dry;
    __device__ __forceinline__ void operator()(const f32x4 (&acc)[2][2][4][2], const Unit& u, int wr, int wc, int fr, int fq) const {
        const int row0 = u.pm * BM + wr * 64 + fr, col0 = u.pn * BM + wc * 32 + 4 * fq;
        f32x4 cur[2][2], nxt[2][2];
#pragma unroll
        for (int bj = 0; bj < 2; ++bj)
#pragma unroll
            for (int n = 0; n < 2; ++n) cur[bj][n] = *(const f32x4*)(x + (size_t)row0 * DM + col0 + bj * HALF + n * 16);
#pragma unroll
        for (int gi = 0; gi < 8; ++gi) {
            const int ai = gi >> 2, m = gi & 3;
            const int row = row0 + ai * HALF + m * 16;
            if (gi < 7) { const int rown = row0 + ((gi + 1) >> 2) * HALF + ((gi + 1) & 3) * 16;
#pragma unroll
                for (int bj = 0; bj < 2; ++bj)
#pragma unroll
                    for (int n = 0; n < 2; ++n) nxt[bj][n] = *(const f32x4*)(x + (size_t)rown * DM + col0 + bj * HALF + n * 16); }
            float s = 0.f;
#pragma unroll
            for (int bj = 0; bj < 2; ++bj)
#pragma unroll
                for (int n = 0; n < 2; ++n) {
                    const int col = col0 + bj * HALF + n * 16;
                    const f32x4 v = cur[bj][n] + acc[ai][bj][m][n] * scale;
                    u32x2 w; w.x = pk2(v[0], v[1]); w.y = pk2(v[2], v[3]);
                    if (!dry) { *(f32x4*)(x + (size_t)row * DM + col) = v; *(u32x2*)(xb + (size_t)row * DM + col) = w; }
                    s += v[0] * v[0] + v[1] * v[1] + v[2] * v[2] + v[3] * v[3];
                }
            s += __shfl_xor(s, 16); s += __shfl_xor(s, 32);
            if (fq == 0 && !dry) atomicAdd(ssn + row, s);
#pragma unroll
            for (int bj = 0; bj < 2; ++bj)
#pragma unroll
                for (int n = 0; n < 2; ++n) cur[bj][n] = nxt[bj][n];
        }
    }
};
__device__ __forceinline__ unsigned pkh2(float lo, float hi) { const _Float16 a = (_Float16)lo, b = (_Float16)hi; return (unsigned)__builtin_bit_cast(unsigned short, a) | ((unsigned)__builtin_bit_cast(unsigned short, b) << 16); }
__device__ __forceinline__ float h2f_lo(unsigned w) { return (float)__builtin_bit_cast(_Float16, (unsigned short)(w & 0xffffu)); }
__device__ __forceinline__ float h2f_hi(unsigned w) { return (float)__builtin_bit_cast(_Float16, (unsigned short)(w >> 16)); }
__device__ __forceinline__ float hg_logf(float v, float lb) {
    const float ls = fminf(v, 0.f) - flog(1.0f + fexp(-fabsf(v)));
    return (lb == 0.f) ? ls : flog(lb + (1.0f - lb) * fexp(ls));
}
struct EpiWin {
    static constexpr bool PERM = true;
    bf16_t* z; const float* ss; const float* lbv;
    __device__ __forceinline__ void operator()(const f32x4 (&acc)[2][2][4][2], const Unit& u, int wr, int wc, int fr, int fq) const {
        const int row0 = u.pm * BM + wr * 64 + fr, col0 = u.pn * BM + wc * 32 + 8 * fq;
        const int ctile = u.pn * BM;
        const int mode = (ctile >= ZC_QH && ctile < ZC_FH) ? 1 : ((ctile >= ZC_FH && ctile < ZC_IH) ? 2 : 0);
        float rr[2][4];
#pragma unroll
        for (int ai = 0; ai < 2; ++ai)
#pragma unroll
            for (int m = 0; m < 4; ++m) rr[ai][m] = ss[row0 + ai * HALF + m * 16];
        if (mode == 0) {
#pragma unroll
            for (int ai = 0; ai < 2; ++ai)
#pragma unroll
                for (int m = 0; m < 4; ++m) {
                    const int row = row0 + ai * HALF + m * 16;
                    const float r = frsq(rr[ai][m] * (1.0f / 1024.0f) + 1e-6f);
#pragma unroll
                    for (int bj = 0; bj < 2; ++bj) {
                        const f32x4 v0 = acc[ai][bj][m][0] * r, v1 = acc[ai][bj][m][1] * r;
                        u32x4 w; w.x = pk2(v0[0], v0[1]); w.y = pk2(v0[2], v0[3]); w.z = pk2(v1[0], v1[1]); w.w = pk2(v1[2], v1[3]);
                        *(u32x4*)(z + (size_t)row * NZ + col0 + bj * HALF) = w;
                    }
                }
        } else if (mode == 1) {
#pragma unroll
            for (int ai = 0; ai < 2; ++ai)
#pragma unroll
                for (int m = 0; m < 4; ++m) {
                    const int row = row0 + ai * HALF + m * 16;
                    const float r = frsq(rr[ai][m] * (1.0f / 1024.0f) + 1e-6f);
#pragma unroll
                    for (int bj = 0; bj < 2; ++bj) {
                        const f32x4 v0 = acc[ai][bj][m][0] * r, v1 = acc[ai][bj][m][1] * r;
                        u32x4 w; w.x = pk2(siluf_(v0[0]), siluf_(v0[1])); w.y = pk2(siluf_(v0[2]), siluf_(v0[3])); w.z = pk2(siluf_(v1[0]), siluf_(v1[1])); w.w = pk2(siluf_(v1[2]), siluf_(v1[3]));
                        *(u32x4*)(z + (size_t)row * NZ + col0 + bj * HALF) = w;
                    }
                }
        } else {
#pragma unroll
            for (int bj = 0; bj < 2; ++bj) {
                f32x4 l0 = (f32x4){0.f, 0.f, 0.f, 0.f}, l1 = l0;
                if (lbv) { l0 = *(const f32x4*)(lbv + col0 + bj * HALF - ZC_FH); l1 = *(const f32x4*)(lbv + col0 + bj * HALF - ZC_FH + 4); }
#pragma unroll
                for (int ai = 0; ai < 2; ++ai)
#pragma unroll
                    for (int m = 0; m < 4; ++m) {
                        const int row = row0 + ai * HALF + m * 16;
                        const float r = frsq(rr[ai][m] * (1.0f / 1024.0f) + 1e-6f);
                        const f32x4 v0 = acc[ai][bj][m][0] * r, v1 = acc[ai][bj][m][1] * r;
                        u32x4 w;
                        w.x = pkh2(hg_logf(v0[0], l0[0]), hg_logf(v0[1], l0[1])); w.y = pkh2(hg_logf(v0[2], l0[2]), hg_logf(v0[3], l0[3]));
                        w.z = pkh2(hg_logf(v1[0], l1[0]), hg_logf(v1[1], l1[1])); w.w = pkh2(hg_logf(v1[2], l1[2]), hg_logf(v1[3], l1[3]));
                        *(u32x4*)(z + (size_t)row * NZ + col0 + bj * HALF) = w;
                    }
            }
        }
    }
};
struct EpiBranch {
    static constexpr bool PERM = true;
    bf16_t* z; const float* mbias; int dry;
    __device__ __forceinline__ void operator()(const f32x4 (&acc)[2][2][4][2], const Unit& u, int wr, int wc, int fr, int fq) const {
        const int row0 = u.pm * BM + wr * 64 + fr, col0 = u.pn * BM + wc * 32 + 8 * fq;
        const int br = u.br;
#pragma unroll
        for (int bj = 0; bj < 2; ++bj) {
            const int col = col0 + bj * HALF;
            const f32x4 b0 = *(const f32x4*)(mbias + br * DM + col), b1 = *(const f32x4*)(mbias + br * DM + col + 4);
#pragma unroll
            for (int am = 0; am < 4; ++am) {
                const int ai = am >> 1, mb = (am & 1) * 2;
                u32x4 gw[2], pw[2];
#pragma unroll
                for (int mm = 0; mm < 2; ++mm) {
                    const bf16_t* zr = z + (size_t)(row0 + ai * HALF + (mb + mm) * 16) * NZ;
                    gw[mm] = *(const u32x4*)(zr + ZC_GATE + br * DM + col);
                    pw[mm] = (u32x4){0u, 0u, 0u, 0u};
                    if (br > 0) pw[mm] = *(const u32x4*)(zr + col);
                }
#pragma unroll
                for (int mm = 0; mm < 2; ++mm) {
                    const int m = mb + mm;
                    bf16_t* zr = z + (size_t)(row0 + ai * HALF + m * 16) * NZ;
                    float o[8];
                    const f32x4 a0 = acc[ai][bj][m][0], a1 = acc[ai][bj][m][1];
                    o[0] = sigmoidf_(lo2f(gw[mm].x) + b0[0]) * a0[0] + lo2f(pw[mm].x); o[1] = sigmoidf_(hi2f(gw[mm].x) + b0[1]) * a0[1] + hi2f(pw[mm].x);
                    o[2] = sigmoidf_(lo2f(gw[mm].y) + b0[2]) * a0[2] + lo2f(pw[mm].y); o[3] = sigmoidf_(hi2f(gw[mm].y) + b0[3]) * a0[3] + hi2f(pw[mm].y);
                    o[4] = sigmoidf_(lo2f(gw[mm].z) + b1[0]) * a1[0] + lo2f(pw[mm].z); o[5] = sigmoidf_(hi2f(gw[mm].z) + b1[1]) * a1[1] + hi2f(pw[mm].z);
                    o[6] = sigmoidf_(lo2f(gw[mm].w) + b1[2]) * a1[2] + lo2f(pw[mm].w); o[7] = sigmoidf_(hi2f(gw[mm].w) + b1[3]) * a1[3] + hi2f(pw[mm].w);
                    u32x4 w; w.x = pk2(o[0], o[1]); w.y = pk2(o[2], o[3]); w.z = pk2(o[4], o[5]); w.w = pk2(o[6], o[7]);
                    if (!dry) *(u32x4*)(zr + col) = w;
                }
            }
        }
    }
};
struct EpiStoreP {
    static constexpr bool PERM = false;
    float* pbuf; int klen, nsplit;
    __device__ __forceinline__ void operator()(const f32x4 (&acc)[2][2][4][2], const Unit& u, int wr, int wc, int fr_, int fq_) const {
        int fr = fr_, fq = fq_; asm volatile("" : "+v"(fr), "+v"(fq));
        const int row0 = u.pm * BM - T_P + wr * 64 + fr, col0 = u.pn * BM + wc * 32 + 4 * fq;
        float* base = pbuf + (size_t)(u.br * nsplit + u.kofs / klen) * (512 * DM);
#pragma unroll
        for (int ai = 0; ai < 2; ++ai)
#pragma unroll
            for (int m = 0; m < 4; ++m)
#pragma unroll
                for (int bj = 0; bj < 2; ++bj)
#pragma unroll
                    for (int n = 0; n < 2; ++n)
                        *(f32x4*)(base + (size_t)(row0 + ai * HALF + m * 16) * DM + col0 + bj * HALF + n * 16) = acc[ai][bj][m][n];
    }
};
}

__device__ __forceinline__ void conv_tile(const float* __restrict__ src, int ldn, int k0, int n0, bf16_t* __restrict__ dst, int K, const float* __restrict__ gain, int mode, LAS float* tile) {
    const int tid = threadIdx.x;
    float v[32];
#pragma unroll
    for (int i = 0; i < 32; ++i) v[i] = src[(size_t)(k0 + i * 2 + (tid >> 8)) * ldn + n0 + (tid & 255)];
    if (gain) {
#pragma unroll
        for (int i = 0; i < 32; ++i) v[i] *= gain[k0 + i * 2 + (tid >> 8)];
    }
#pragma unroll
    for (int i = 0; i < 32; ++i) tile[(i * 2 + (tid >> 8)) * 257 + (tid & 255)] = v[i];
    __syncthreads();
#pragma unroll
    for (int i = 0; i < 4; ++i) {
        const int id = tid + 512 * i, nn = id >> 3, ks = (id & 7) * 8;
        float t[8];
#pragma unroll
        for (int j = 0; j < 8; ++j) t[j] = tile[(ks + j) * 257 + nn];
        const int n = n0 + nn;
        const int row = (mode == 0) ? n : (32 * (n >> 4) + (mode == 2 ? 16 : 0) + (n & 15));
        u32x4 w; w.x = pk2(t[0], t[1]); w.y = pk2(t[2], t[3]); w.z = pk2(t[4], t[5]); w.w = pk2(t[6], t[7]);
        *(u32x4*)(dst + (size_t)row * K + k0 + ks) = w;
    }
    __syncthreads();
}

__device__ void phase0(const Params& p, LAS unsigned char* lds) {
    int tid = threadIdx.x; asm volatile("" : "+v"(tid));
    const int bid = blockIdx.x, nb = gridDim.x;
    bf16_t* wb = (bf16_t*)(p.ws + WS_W);
    LAS float* tile = (LAS float*)lds;
    for (int ti = bid; ti < 2 * 2080; ti += nb) {
        const int l = ti / 2080; int r = ti % 2080;
        bf16_t* wl = wb + (size_t)l * W_LAYER;
        const float* src; int Ks, Ns; bf16_t* dst; const float* gain = nullptr; int mode = 0;
        if (r < 176) { src = p.in[7] + (size_t)l * DM * FH; Ks = DM; Ns = FH; dst = wl + OFF_GU1; gain = p.in[6] + l * DM; mode = 1; }
        else if ((r -= 176) < 176) { src = p.in[8] + (size_t)l * DM * FH; Ks = DM; Ns = FH; dst = wl + OFF_GU1; gain = p.in[6] + l * DM; mode = 2; }
        else if ((r -= 176) < 176) { src = p.in[9] + (size_t)l * DM * FH; Ks = FH; Ns = DM; dst = wl + OFF_D1; }
        else if ((r -= 176) < 768) { src = p.in[11] + (size_t)l * DM * NZ; Ks = DM; Ns = NZ; dst = wl + OFF_WIN; gain = p.in[10] + l * DM; }
        else if ((r -= 768) < 64) { src = p.in[13] + (size_t)l * DM * DM; Ks = DM; Ns = DM; dst = wl + OFF_RO; }
        else if ((r -= 64) < 64) { src = p.in[16] + (size_t)l * DM * DM; Ks = DM; Ns = DM; dst = wl + OFF_HO; }
        else if ((r -= 64) < 64) { src = p.in[24] + (size_t)l * DM * DM; Ks = DM; Ns = DM; dst = wl + OFF_LO; }
        else if ((r -= 64) < 64) { src = p.in[25] + (size_t)l * DM * DM; Ks = DM; Ns = DM; dst = wl + OFF_MO; }
        else if ((r -= 64) < 176) { src = p.in[27] + (size_t)l * DM * FH; Ks = DM; Ns = FH; dst = wl + OFF_GU2; gain = p.in[26] + l * DM; mode = 1; }
        else if ((r -= 176) < 176) { src = p.in[28] + (size_t)l * DM * FH; Ks = DM; Ns = FH; dst = wl + OFF_GU2; gain = p.in[26] + l * DM; mode = 2; }
        else { r -= 176; src = p.in[29] + (size_t)l * DM * FH; Ks = FH; Ns = DM; dst = wl + OFF_D2; }
        const int nkt = Ks / 64;
        const int kt = r % nkt, ntile = r / nkt;
        conv_tile(src, Ns, kt * 64, ntile * 256, dst, Ks, gain, mode, tile);
    }
    float* x = p.out; bf16_t* xb = (bf16_t*)(p.ws + WS_XB); float* ss = (float*)(p.ws + WS_SS);
    const int wid = tid >> 6, lane = tid & 63;
    for (int row = bid * 8 + wid; row < T_ALL; row += nb * 8) {
        const float* srow = (row < T_P) ? (p.in[0] + (size_t)row * DM) : (p.in[1] + (size_t)(row - T_P) * DM);
        float s = 0.f;
#pragma unroll
        for (int i = 0; i < 4; ++i) {
            const int c = i * 256 + lane * 4;
            const f32x4 v = *(const f32x4*)(srow + c);
            *(f32x4*)(x + (size_t)row * DM + c) = v;
            u32x2 w; w.x = pk2(v[0], v[1]); w.y = pk2(v[2], v[3]);
            *(u32x2*)(xb + (size_t)row * DM + c) = w;
            s += v[0] * v[0] + v[1] * v[1] + v[2] * v[2] + v[3] * v[3];
        }
#pragma unroll
        for (int o = 32; o >= 1; o >>= 1) s += __shfl_xor(s, o);
        if (lane == 0) { ss[row] = s;
#pragma unroll
            for (int k = 1; k < 8; ++k) ss[(size_t)k * T_ALL + row] = 0.f; }
    }
    float2* rope = (float2*)(p.ws + WS_ROPE);
    for (int e = bid * 512 + tid; e < 2052 * 64; e += nb * 512) {
        const int idx = e >> 6, i = e & 63;
        const int pos = idx < 2048 ? idx : (16384 + idx - 2048);
        double inv = 1.0;
        for (int k = 0; k < i; ++k) inv *= 0.8659643233600653;
        double rev = (double)pos * inv * 0.15915494309189535;
        rev -= (double)(long long)rev;
        const float rf = (float)rev;
        rope[e] = make_float2(__builtin_amdgcn_cosf(rf), __builtin_amdgcn_sinf(rf));
    }
    if (bid == 0 && tid < 64) ((unsigned*)(p.ws + WS_CTR))[tid] = 0u;
    if (bid == 1) { float* lbp = (float*)(p.ws + WS_LB); for (int i = tid; i < 1024; i += 512) lbp[i] = sigmoidf_(p.in[14][1024 + i] - p.in[14][i]); }
}

__device__ __forceinline__ bf16x8 ldfrag(const LAS bf16_t* M, int ld, int r0, int k0, int fr, int fq) { return *(const LAS bf16x8*)(M + (r0 + fr) * ld + k0 + fq * 8); }
__device__ __forceinline__ bf16x8 ldfrag_tr(const LAS bf16_t* M, int ld, int i0, int k0, int fr, int fq) {
    const LAS bf16_t* q = M + (k0 + fq * 8 + (fr >> 2)) * ld + i0 + (fr & 3) * 4;
    const s16x4 a = __builtin_amdgcn_ds_read_tr16_b64_v4i16((LAS s16x4*)q);
    const s16x4 b = __builtin_amdgcn_ds_read_tr16_b64_v4i16((LAS s16x4*)(q + 4 * ld));
    return (bf16x8){a[0], a[1], a[2], a[3], b[0], b[1], b[2], b[3]};
}
#define MMA16(acc, bfr, afr) acc = __builtin_amdgcn_mfma_f32_16x16x32_bf16(bfr, afr, acc, 0, 0, 0)

template <bool HG>
__device__ void linattn_prompt(const Params& p, int l, int b, int h, LAS unsigned char* lds, int dry) {
    constexpr int DV = HG ? 128 : 256, NVT = DV / 16, NV = DV / 32, LQ = 136, LV = DV + 8, LP = 72;
    int tid = threadIdx.x; asm volatile("" : "+v"(tid));
    const int wid = __builtin_amdgcn_readfirstlane(tid >> 6), lane = tid & 63, fr = lane & 15, fq = lane >> 4;
    LAS bf16_t* Q = (LAS bf16_t*)lds;
    LAS bf16_t* Kn = Q + 64 * LQ;
    LAS bf16_t* P = Kn;
    LAS bf16_t* KH = Kn + 64 * LQ;
    LAS bf16_t* V = KH + 64 * LQ;
    LAS bf16_t* ST = V + 64 * LV;
    LAS float* red = (LAS float*)(ST + DV * LQ);
    LAS float* eL = red + 128;
    LAS float* eR = eL + 128;
    LAS float* segs = eR + 128;
    bf16_t* zb = (bf16_t*)(p.ws + WS_Z);
    const float2* rope = (const float2*)(p.ws + WS_ROPE);
    const int qcol = HG ? ZC_QH + h * 128 : ZC_QR + h * 128;
    const int kcol = HG ? ZC_FH + h * 128 : ZC_KR + h * 128;
    const int vcol = HG ? ZC_IH + h * 128 : ZC_VR + h * 256;
    const int gcol = HG ? ZC_GH + h * 128 : ZC_GR + h * 256;
    const float log_g = HG ? 0.f : logf(1.0f - exp2f(-5.0f - (float)h));
    f32x4 st[NVT];
#pragma unroll
    for (int i = 0; i < NVT; ++i) st[i] = (f32x4){0.f, 0.f, 0.f, 0.f};

    for (int c = 0; c < 32; ++c) {
        const int row0 = b * 2048 + c * 64;
        if (!HG) {
            const int t = tid >> 3, g = tid & 7;
            const bf16_t* zr = zb + (size_t)(row0 + t) * NZ;
            const u32x4 q1 = *(const u32x4*)(zr + qcol + 8 * g), q2 = *(const u32x4*)(zr + qcol + 64 + 8 * g);
            const u32x4 k1 = *(const u32x4*)(zr + kcol + 8 * g), k2 = *(const u32x4*)(zr + kcol + 64 + 8 * g);
            const float2* rp = rope + (size_t)(c * 64 + t) * 64 + 8 * g;
            const float kd = fexp((float)(63 - t) * log_g) * 0.08838834764831845f;
            unsigned qa[4], qb[4], ka[4], kb[4], ha[4], hb[4];
#pragma unroll
            for (int j = 0; j < 4; ++j) {
                const float2 cs0 = rp[2 * j], cs1 = rp[2 * j + 1];
                const unsigned w1 = j == 0 ? q1.x : j == 1 ? q1.y : j == 2 ? q1.z : q1.w, w2 = j == 0 ? q2.x : j == 1 ? q2.y : j == 2 ? q2.z : q2.w;
                const unsigned v1 = j == 0 ? k1.x : j == 1 ? k1.y : j == 2 ? k1.z : k1.w, v2 = j == 0 ? k2.x : j == 1 ? k2.y : j == 2 ? k2.z : k2.w;
                const float x1a = lo2f(w1), x1b = hi2f(w1), x2a = lo2f(w2), x2b = hi2f(w2);
                const float y1a = lo2f(v1), y1b = hi2f(v1), y2a = lo2f(v2), y2b = hi2f(v2);
                const float qo1a = x1a * cs0.x - x2a * cs0.y, qo2a = x1a * cs0.y + x2a * cs0.x;
                const float qo1b = x1b * cs1.x - x2b * cs1.y, qo2b = x1b * cs1.y + x2b * cs1.x;
                const float ko1a = y1a * cs0.x - y2a * cs0.y, ko2a = y1a * cs0.y + y2a * cs0.x;
                const float ko1b = y1b * cs1.x - y2b * cs1.y, ko2b = y1b * cs1.y + y2b * cs1.x;
                qa[j] = pk2(qo1a, qo1b); qb[j] = pk2(qo2a, qo2b);
                ka[j] = pk2(ko1a, ko1b); kb[j] = pk2(ko2a, ko2b);
                ha[j] = pk2(ko1a * kd, ko1b * kd); hb[j] = pk2(ko2a * kd, ko2b * kd);
            }
            *(LAS u32x4*)(Q + t * LQ + 8 * g) = (u32x4){qa[0], qa[1], qa[2], qa[3]};
            *(LAS u32x4*)(Q + t * LQ + 64 + 8 * g) = (u32x4){qb[0], qb[1], qb[2], qb[3]};
            *(LAS u32x4*)(Kn + t * LQ + 8 * g) = (u32x4){ka[0], ka[1], ka[2], ka[3]};
            *(LAS u32x4*)(Kn + t * LQ + 64 + 8 * g) = (u32x4){kb[0], kb[1], kb[2], kb[3]};
            *(LAS u32x4*)(KH + t * LQ + 8 * g) = (u32x4){ha[0], ha[1], ha[2], ha[3]};
            *(LAS u32x4*)(KH + t * LQ + 64 + 8 * g) = (u32x4){hb[0], hb[1], hb[2], hb[3]};
#pragma unroll
            for (int i = 0; i < 4; ++i) {
                const int id = tid + 512 * i, tt = id >> 5, gv = id & 31;
                *(LAS u32x4*)(V + tt * LV + 8 * gv) = *(const u32x4*)(zb + (size_t)(row0 + tt) * NZ + vcol + 8 * gv);
            }
        } else {
            const int d = tid & 127, seg = tid >> 7;
            float lf[16], kv[16], qv[16];
            bf16_t rawf[16], rawq[16];
#pragma unroll
            for (int j = 0; j < 16; ++j) {
                const bf16_t* zr = zb + (size_t)(row0 + seg * 16 + j) * NZ;
                rawf[j] = zr[kcol + d]; rawq[j] = zr[qcol + d];
            }
            float run = 0.f;
#pragma unroll
            for (int j = 0; j < 16; ++j) {
                const float lfv = (float)__builtin_bit_cast(_Float16, rawf[j]);
                run += lfv; lf[j] = run;
                kv[j] = 1.0f - fexp(lfv);
                qv[j] = bf2f(rawq[j]);
            }
            segs[seg * 128 + d] = run;
            __syncthreads();
            const float s0 = segs[d], s1 = segs[128 + d], s2 = segs[256 + d], s3 = segs[384 + d];
            const float pre = (seg > 0 ? s0 : 0.f) + (seg > 1 ? s1 : 0.f) + (seg > 2 ? s2 : 0.f);
            const float bref = s0 + s1, bL = bref + s2 + s3;
#pragma unroll
            for (int j = 0; j < 16; ++j) {
                const int t = seg * 16 + j;
                const float bb = pre + lf[j];
                Q[t * LQ + d] = f2bf(qv[j] * fexp(bb - bref));
                Kn[t * LQ + d] = f2bf(kv[j] * fexp(bref - bb));
                KH[t * LQ + d] = f2bf(kv[j] * fexp(bL - bb));
            }
            if (seg == 0) { eL[d] = fexp(bL); eR[d] = fexp(bref); }
#pragma unroll
            for (int i = 0; i < 2; ++i) {
                const int id = tid + 512 * i, tt = id >> 4, gv = id & 15;
                *(LAS u32x4*)(V + tt * LV + 8 * gv) = *(const u32x4*)(zb + (size_t)(row0 + tt) * NZ + vcol + 8 * gv);
            }
        }
        __syncthreads();
        {
            float e0 = 1.f, e1 = 1.f, e2 = 1.f, e3 = 1.f;
            if (HG) { const f32x4 ev = *(const LAS f32x4*)(eR + 16 * wid + 4 * fq); e0 = ev[0]; e1 = ev[1]; e2 = ev[2]; e3 = ev[3]; }
#pragma unroll
            for (int vt = 0; vt < NVT; ++vt) {
                u32x2 w; w.x = pk2(st[vt][0] * e0, st[vt][1] * e1); w.y = pk2(st[vt][2] * e2, st[vt][3] * e3);
                *(LAS u32x2*)(ST + (16 * vt + fr) * LQ + 16 * wid + 4 * fq) = w;
            }
        }
        f32x4 sc[2];
        sc[0] = (f32x4){0.f, 0.f, 0.f, 0.f}; sc[1] = sc[0];
        {
            const int tt = wid >> 1, s0t = (wid & 1) * 2;
#pragma unroll
            for (int ks = 0; ks < 4; ++ks) {
                const bf16x8 afr = ldfrag(Q, LQ, 16 * tt, 32 * ks, fr, fq);
#pragma unroll
                for (int si = 0; si < 2; ++si) { const bf16x8 bfr = ldfrag(Kn, LQ, 16 * (s0t + si), 32 * ks, fr, fq); MMA16(sc[si], bfr, afr); }
            }
            const int t = 16 * tt + fr;
#pragma unroll
            for (int si = 0; si < 2; ++si)
#pragma unroll
                for (int j = 0; j < 4; ++j) {
                    const int s = 16 * (s0t + si) + 4 * fq + j;
                    float v = sc[si][j];
                    if (!HG) v *= 0.08838834764831845f * fexp((float)(t - s) * log_g);
                    sc[si][j] = (s <= t) ? v : 0.f;
                }
        }
        __syncthreads();
        {
            const int tt = wid >> 1, s0t = (wid & 1) * 2, t = 16 * tt + fr;
#pragma unroll
            for (int si = 0; si < 2; ++si) { u32x2 w; w.x = pk2(sc[si][0], sc[si][1]); w.y = pk2(sc[si][2], sc[si][3]);
                *(LAS u32x2*)(P + t * LP + 16 * (s0t + si) + 4 * fq) = w; }
        }
        __syncthreads();
        {
            const int tt = wid & 3, vg = wid >> 2, t = 16 * tt + fr;
            bf16_t* zr = zb + (size_t)(row0 + t) * NZ + gcol;
            u32x2 gwv[NV];
#pragma unroll
            for (int i = 0; i < NV; ++i) gwv[i] = *(const u32x2*)(zr + 16 * (vg * NV + i) + 4 * fq);
            f32x4 oa[NV];
#pragma unroll
            for (int i = 0; i < NV; ++i) oa[i] = (f32x4){0.f, 0.f, 0.f, 0.f};
#pragma unroll
            for (int ks = 0; ks < 4; ++ks) {
                const bf16x8 afr = ldfrag(Q, LQ, 16 * tt, 32 * ks, fr, fq);
#pragma unroll
                for (int i = 0; i < NV; ++i) { const bf16x8 bfr = ldfrag(ST, LQ, 16 * (vg * NV + i), 32 * ks, fr, fq); MMA16(oa[i], bfr, afr); }
            }
            if (!HG) { const float qd = fexp((float)(t + 1) * log_g);
#pragma unroll
                for (int i = 0; i < NV; ++i) oa[i] *= qd; }
#pragma unroll
            for (int ks = 0; ks < 2; ++ks) {
                const bf16x8 afr = ldfrag(P, LP, 16 * tt, 32 * ks, fr, fq);
#pragma unroll
                for (int i = 0; i < NV; ++i) { const bf16x8 bfr = ldfrag_tr(V, LV, 16 * (vg * NV + i), 32 * ks, fr, fq); MMA16(oa[i], bfr, afr); }
            }
            float s = 0.f;
#pragma unroll
            for (int i = 0; i < NV; ++i) s += oa[i][0] * oa[i][0] + oa[i][1] * oa[i][1] + oa[i][2] * oa[i][2] + oa[i][3] * oa[i][3];
            s += __shfl_xor(s, 16); s += __shfl_xor(s, 32);
            if (fq == 0) red[vg * 64 + t] = s;
            __syncthreads();
            const float rs = frsq((red[t] + red[64 + t]) * (1.0f / (float)DV) + 1e-6f);
#pragma unroll
            for (int i = 0; i < NV; ++i) {
                const int v = 16 * (vg * NV + i) + 4 * fq;
                const u32x2 gw = gwv[i];
                float n0 = rs, n1 = rs, n2 = rs, n3 = rs;
                if (HG) { const f32x4 hn = *(const f32x4*)(p.in[15] + l * 1024 + h * 128 + v); n0 *= hn[0]; n1 *= hn[1]; n2 *= hn[2]; n3 *= hn[3]; }
                u32x2 w;
                w.x = pk2(oa[i][0] * n0 * siluf_(lo2f(gw.x)), oa[i][1] * n1 * siluf_(hi2f(gw.x)));
                w.y = pk2(oa[i][2] * n2 * siluf_(lo2f(gw.y)), oa[i][3] * n3 * siluf_(hi2f(gw.y)));
                if (!dry) *(u32x2*)(zr + v) = w;
            }
        }
        {
            if (HG) { const f32x4 ev = *(const LAS f32x4*)(eL + 16 * wid + 4 * fq);
#pragma unroll
                for (int vt = 0; vt < NVT; ++vt) st[vt] *= ev; }
            else { const float sd = fexp(64.0f * log_g);
#pragma unroll
                for (int vt = 0; vt < NVT; ++vt) st[vt] *= sd; }
#pragma unroll
            for (int ks = 0; ks < 2; ++ks) {
                const bf16x8 bfr = ldfrag_tr(KH, LQ, 16 * wid, 32 * ks, fr, fq);
#pragma unroll
                for (int vt = 0; vt < NVT; ++vt) { const bf16x8 afr = ldfrag_tr(V, LV, 16 * vt, 32 * ks, fr, fq); MMA16(st[vt], bfr, afr); }
            }
        }
        __syncthreads();
    }
    float* so = p.out + (HG ? O_HGP : O_RETP) + ((size_t)((l * 8 + b) * (HG ? 8 : 4) + h)) * 128 * DV;
#pragma unroll
    for (int vt = 0; vt < NVT; ++vt)
#pragma unroll
        for (int j = 0; j < 4; ++j) so[(size_t)(16 * wid + 4 * fq + j) * DV + 16 * vt + fr] = st[vt][j];
}

__device__ void lru_prompt(const Params& p, int l, int b, int n, LAS unsigned char* lds, int dry) {
    int tid = threadIdx.x; asm volatile("" : "+v"(tid));
    const int wid = __builtin_amdgcn_readfirstlane(tid >> 6), lane = tid & 63, fr = lane & 15, fq = lane >> 4;
    LAS float* XL = (LAS float*)lds;
    LAS bf16_t* XC = (LAS bf16_t*)(lds + 34304);
    LAS float* XCF = (LAS float*)(lds + 51712);
    LAS float* AA = (LAS float*)(lds + 84480);
    LAS float* UU = (LAS float*)(lds + 117248);
    LAS float* segA = (LAS float*)(lds + 150016);
    LAS float* segH = segA + 512;
    LAS float* hc = segH + 512;
    bf16_t* zb = (bf16_t*)(p.ws + WS_Z);
    const int e = tid & 127, seg = tid >> 7, ch = n * 128 + e;
    const float cw0 = p.in[17][(l * 4 + 0) * 1024 + ch], cw1 = p.in[17][(l * 4 + 1) * 1024 + ch], cw2 = p.in[17][(l * 4 + 2) * 1024 + ch], cw3 = p.in[17][(l * 4 + 3) * 1024 + ch];
    const float cb = p.in[18][l * 1024 + ch];
    bf16x8 Ba[4], Bx[4];
    {
        const float* wa = p.in[19] + ((size_t)(l * 8 + n)) * 16384;
        const float* wx = p.in[21] + ((size_t)(l * 8 + n)) * 16384;
#pragma unroll
        for (int ks = 0; ks < 4; ++ks)
#pragma unroll
            for (int j = 0; j < 8; ++j) {
                const int d = 32 * ks + 8 * fq + j;
                Ba[ks][j] = (short)f2bf(wa[d * 128 + 16 * wid + fr]);
                Bx[ks][j] = (short)f2bf(wx[d * 128 + 16 * wid + fr]);
            }
    }
    float ba[4], bx[4], sp[4];
#pragma unroll
    for (int j = 0; j < 4; ++j) {
        const int c2 = n * 128 + 16 * wid + 4 * fq + j;
        ba[j] = p.in[20][l * 1024 + c2]; bx[j] = p.in[22][l * 1024 + c2];
        const float lam = p.in[23][l * 1024 + c2];
        sp[j] = fmaxf(-lam, 0.f) + flog(1.0f + fexp(-fabsf(lam)));
    }
    if (tid < 384) XL[tid] = 0.f;
    if (tid < 128) hc[tid] = 0.f;
    __syncthreads();
    for (int c = 0; c < 32; ++c) {
        const int row0 = b * 2048 + c * 64;
        bf16_t glv[16];
#pragma unroll
        for (int j = 0; j < 16; ++j) glv[j] = zb[(size_t)(row0 + seg * 16 + j) * NZ + ZC_GL + ch];
#pragma unroll
        for (int i = 0; i < 2; ++i) {
            const int id = tid + 512 * i, tt = id >> 4, g = id & 15;
            const u32x4 w = *(const u32x4*)(zb + (size_t)(row0 + tt) * NZ + ZC_XL + n * 128 + 8 * g);
            LAS float* dst = XL + (3 + tt) * 128 + 8 * g;
            *(LAS f32x4*)dst = (f32x4){lo2f(w.x), hi2f(w.x), lo2f(w.y), hi2f(w.y)};
            *(LAS f32x4*)(dst + 4) = (f32x4){lo2f(w.z), hi2f(w.z), lo2f(w.w), hi2f(w.w)};
        }
        __syncthreads();
#pragma unroll 4
        for (int j = 0; j < 16; ++j) {
            const int t = seg * 16 + j;
            const float xc = cb + XL[t * 128 + e] * cw0 + XL[(t + 1) * 128 + e] * cw1 + XL[(t + 2) * 128 + e] * cw2 + XL[(t + 3) * 128 + e] * cw3;
            XCF[t * 128 + e] = xc; XC[t * 136 + e] = f2bf(xc);
        }
        __syncthreads();
#pragma unroll
        for (int tt = 0; tt < 4; ++tt) {
            f32x4 ga = (f32x4){0.f, 0.f, 0.f, 0.f}, gx = ga;
#pragma unroll
            for (int ks = 0; ks < 4; ++ks) { const bf16x8 afr = ldfrag(XC, 136, 16 * tt, 32 * ks, fr, fq); MMA16(ga, Ba[ks], afr); MMA16(gx, Bx[ks], afr); }
            const int t = 16 * tt + fr, e4 = 16 * wid + 4 * fq;
            const f32x4 xv = *(const LAS f32x4*)(XCF + t * 128 + e4);
            f32x4 av, uv;
#pragma unroll
            for (int j = 0; j < 4; ++j) {
                const float r = sigmoidf_(ga[j] + ba[j]), ii = sigmoidf_(gx[j] + bx[j]);
                const float la = -8.0f * r * sp[j];
                av[j] = fexp(la);
                uv[j] = __builtin_amdgcn_sqrtf(1.0f - fexp(2.0f * la)) * ii * xv[j];
            }
            *(LAS f32x4*)(AA + t * 128 + e4) = av; *(LAS f32x4*)(UU + t * 128 + e4) = uv;
        }
        __syncthreads();
        {
            float A = 1.f, H = 0.f;
#pragma unroll 4
            for (int j = 0; j < 16; ++j) { const int t = seg * 16 + j; const float a = AA[t * 128 + e]; H = a * H + UU[t * 128 + e]; A *= a; }
            segA[seg * 128 + e] = A; segH[seg * 128 + e] = H;
        }
        __syncthreads();
        float hh = hc[e];
        for (int s = 0; s < seg; ++s) hh = segA[s * 128 + e] * hh + segH[s * 128 + e];
#pragma unroll
        for (int j = 0; j < 16; ++j) {
            const int t = seg * 16 + j;
            hh = AA[t * 128 + e] * hh + UU[t * 128 + e];
            bf16_t* zp = zb + (size_t)(row0 + t) * NZ + ZC_GL + ch;
            if (!dry) *zp = f2bf(hh * geluf_(bf2f(glv[j])));
        }
        __syncthreads();
        if (seg == 3) hc[e] = hh;
        if (seg == 0) { XL[e] = XL[64 * 128 + e]; XL[128 + e] = XL[65 * 128 + e]; XL[256 + e] = XL[66 * 128 + e]; }
        __syncthreads();
    }
    if (seg == 0) {
        p.out[O_LRUP + (size_t)(l * 8 + b) * 1024 + ch] = hc[e];
#pragma unroll
        for (int i = 0; i < 3; ++i) p.out[O_CVP + ((size_t)(l * 8 + b) * 3 + i) * 1024 + ch] = XL[i * 128 + e];
    }
    __syncthreads();
}

template <bool HG>
__device__ void linattn_sample(const Params& p, int l, int b, int h, LAS unsigned char* lds, int dry) {
    constexpr int DV = HG ? 128 : 256, NPART = 512 / DV, DPP = 128 / NPART;
    int tid = threadIdx.x; asm volatile("" : "+v"(tid));
    LAS float* qs = (LAS float*)lds;
    LAS float* ks = qs + 512;
    LAS float* fs = ks + 512;
    LAS float* vs = fs + 512;
    LAS float* op = vs + 4 * DV;
    LAS float* red = op + NPART * 4 * DV;
    bf16_t* zb = (bf16_t*)(p.ws + WS_Z);
    const int rowb = T_P + 4 * b;
    const float log_g = HG ? 0.f : logf(1.0f - exp2f(-5.0f - (float)h));
    const float gam = HG ? 1.f : (1.0f - exp2f(-5.0f - (float)h));
    if (!HG) {
        if (tid < 256) {
            const int t = tid >> 6, i = tid & 63;
            const bf16_t* zr = zb + (size_t)(rowb + t) * NZ;
            const float2 cs = ((const float2*)(p.ws + WS_ROPE))[(size_t)(2048 + t) * 64 + i];
            const float q1 = bf2f(zr[ZC_QR + h * 128 + i]), q2 = bf2f(zr[ZC_QR + h * 128 + 64 + i]);
            const float k1 = bf2f(zr[ZC_KR + h * 128 + i]), k2 = bf2f(zr[ZC_KR + h * 128 + 64 + i]);
            qs[t * 128 + i] = q1 * cs.x - q2 * cs.y; qs[t * 128 + 64 + i] = q1 * cs.y + q2 * cs.x;
            ks[t * 128 + i] = (k1 * cs.x - k2 * cs.y) * 0.08838834764831845f; ks[t * 128 + 64 + i] = (k1 * cs.y + k2 * cs.x) * 0.08838834764831845f;
        }
#pragma unroll
        for (int i = 0; i < 2; ++i) { const int id = tid + 512 * i, t = id >> 8, v = id & 255; vs[t * 256 + v] = bf2f(zb[(size_t)(rowb + t) * NZ + ZC_VR + h * 256 + v]); }
    } else {
        const int t = tid >> 7, d = tid & 127;
        const bf16_t* zr = zb + (size_t)(rowb + t) * NZ;
        const float fv = fexp((float)__builtin_bit_cast(_Float16, zr[ZC_FH + h * 128 + d]));
        fs[t * 128 + d] = fv;
        ks[t * 128 + d] = 1.0f - fv;
        qs[t * 128 + d] = bf2f(zr[ZC_QH + h * 128 + d]);
        vs[t * 128 + d] = bf2f(zr[ZC_IH + h * 128 + d]);
    }
    __syncthreads();
    {
        const int v = tid % DV, part = tid / DV;
        const float v0 = vs[v], v1 = vs[DV + v], v2 = vs[2 * DV + v], v3 = vs[3 * DV + v];
        const size_t sbase = ((size_t)((l * 128 + b) * (HG ? 8 : 4) + h)) * 128 * DV;
        const float* Sin = (HG ? p.in[3] : p.in[2]) + sbase;
        float* Sout = p.out + (HG ? O_HGS : O_RETS) + sbase;
        float o0 = 0.f, o1 = 0.f, o2 = 0.f, o3 = 0.f;
#pragma unroll 1
        for (int d0 = 0; d0 < DPP; d0 += 16) {
            float S[16];
#pragma unroll
            for (int i = 0; i < 16; ++i) S[i] = __builtin_nontemporal_load(Sin + (size_t)(part * DPP + d0 + i) * DV + v);
#pragma unroll
            for (int i = 0; i < 16; ++i) {
                const int d = part * DPP + d0 + i;
                const float f0 = HG ? fs[d] : gam, f1 = HG ? fs[128 + d] : gam, f2 = HG ? fs[256 + d] : gam, f3 = HG ? fs[384 + d] : gam;
                float Sv = S[i];
                Sv = f0 * Sv + ks[d] * v0; o0 += qs[d] * Sv;
                Sv = f1 * Sv + ks[128 + d] * v1; o1 += qs[128 + d] * Sv;
                Sv = f2 * Sv + ks[256 + d] * v2; o2 += qs[256 + d] * Sv;
                Sv = f3 * Sv + ks[384 + d] * v3; o3 += qs[384 + d] * Sv;
                S[i] = Sv;
                if ((i & 3) == 3) asm volatile("" ::: "memory");
            }
#pragma unroll
            for (int i = 0; i < 16; ++i) __builtin_nontemporal_store(S[i], Sout + (size_t)(part * DPP + d0 + i) * DV + v);
        }
        op[(part * 4 + 0) * DV + v] = o0; op[(part * 4 + 1) * DV + v] = o1; op[(part * 4 + 2) * DV + v] = o2; op[(part * 4 + 3) * DV + v] = o3;
    }
    __syncthreads();
    {
        const int t = tid >> 7, vv = tid & 127;
        constexpr int NPT = DV / 128;
        float o[NPT]; float s = 0.f;
#pragma unroll
        for (int i = 0; i < NPT; ++i) { const int v = vv + 128 * i; float a = 0.f;
#pragma unroll
            for (int q = 0; q < NPART; ++q) a += op[(q * 4 + t) * DV + v];
            o[i] = a; s += a * a; }
#pragma unroll
        for (int off = 32; off >= 1; off >>= 1) s += __shfl_xor(s, off);
        if ((tid & 63) == 0) red[tid >> 6] = s;
        __syncthreads();
        const float rs = frsq((red[2 * t] + red[2 * t + 1]) * (1.0f / (float)DV) + 1e-6f);
        const int gcol = HG ? ZC_GH + h * 128 : ZC_GR + h * 256;
        bf16_t* zr = zb + (size_t)(rowb + t) * NZ + gcol;
#pragma unroll
        for (int i = 0; i < NPT; ++i) { const int v = vv + 128 * i;
            float nrm = rs; if (HG) nrm *= p.in[15][l * 1024 + h * 128 + v];
            const bf16_t ov = f2bf(o[i] * nrm * siluf_(bf2f(zr[v]))); if (!dry) zr[v] = ov; }
    }
    __syncthreads();
}

__device__ void lru_sample(const Params& p, int l, int item, LAS unsigned char* lds, int dry) {
    int tid = threadIdx.x; asm volatile("" : "+v"(tid));
    LAS float* XX = (LAS float*)lds;
    LAS float* XC = XX + 2 * 7 * 1024;
    bf16_t* zb = (bf16_t*)(p.ws + WS_Z);
    const int b0 = item * 2;
    for (int i = tid; i < 2 * 7 * 1024; i += 512) {
        const int sq = i / 7168, r = (i % 7168) >> 10, ch = i & 1023, b = b0 + sq;
        float v;
        if (r < 3) v = p.in[5][((size_t)(l * 128 + b) * 3 + r) * 1024 + ch];
        else v = bf2f(zb[(size_t)(T_P + 4 * b + (r - 3)) * NZ + ZC_XL + ch]);
        XX[i] = v;
    }
    __syncthreads();
    for (int i = tid; i < 8 * 1024; i += 512) {
        const int tok = i >> 10, ch = i & 1023, sq = tok >> 2, t = tok & 3;
        const LAS float* xx = XX + sq * 7168 + ch;
        float xc = p.in[18][l * 1024 + ch];
#pragma unroll
        for (int k = 0; k < 4; ++k) xc += xx[(t + k) * 1024] * p.in[17][(l * 4 + k) * 1024 + ch];
        XC[i] = xc;
    }
    __syncthreads();
#pragma unroll 1
    for (int cc = 0; cc < 2; ++cc) {
        const int ch = tid + 512 * cc, n = ch >> 7, e = ch & 127;
        const float* wa = p.in[19] + ((size_t)(l * 8 + n)) * 16384 + e;
        const float* wx = p.in[21] + ((size_t)(l * 8 + n)) * 16384 + e;
        float ga[8], gx[8];
#pragma unroll
        for (int k = 0; k < 8; ++k) { ga[k] = 0.f; gx[k] = 0.f; }
#pragma unroll 4
        for (int d = 0; d < 128; ++d) {
            const float a = wa[d * 128], x = wx[d * 128];
#pragma unroll
            for (int k = 0; k < 8; ++k) { const float xv = XC[k * 1024 + n * 128 + d]; ga[k] += xv * a; gx[k] += xv * x; }
        }
        const float ba = p.in[20][l * 1024 + ch], bx = p.in[22][l * 1024 + ch], lam = p.in[23][l * 1024 + ch];
        const float sp = fmaxf(-lam, 0.f) + flog(1.0f + fexp(-fabsf(lam)));
        bf16_t glv[8];
#pragma unroll
        for (int k = 0; k < 8; ++k) glv[k] = zb[(size_t)(T_P + 4 * (b0 + (k >> 2)) + (k & 3)) * NZ + ZC_GL + ch];
        float h0v[2];
#pragma unroll
        for (int sq = 0; sq < 2; ++sq) h0v[sq] = p.in[4][(size_t)(l * 128 + b0 + sq) * 1024 + ch];
#pragma unroll
        for (int sq = 0; sq < 2; ++sq) {
            const int b = b0 + sq;
            float hh = h0v[sq];
#pragma unroll
            for (int t = 0; t < 4; ++t) {
                const int k = sq * 4 + t;
                const float r = sigmoidf_(ga[k] + ba), ii = sigmoidf_(gx[k] + bx);
                const float la = -8.0f * r * sp;
                const float a = fexp(la), u = __builtin_amdgcn_sqrtf(1.0f - fexp(2.0f * la)) * ii * XC[k * 1024 + ch];
                hh = a * hh + u;
                bf16_t* zp = zb + (size_t)(T_P + 4 * b + t) * NZ + ZC_GL + ch;
                if (!dry) *zp = f2bf(hh * geluf_(bf2f(glv[k])));
            }
            p.out[O_LRUS + (size_t)(l * 128 + b) * 1024 + ch] = hh;
#pragma unroll
            for (int r = 0; r < 3; ++r) p.out[O_CVS + ((size_t)(l * 128 + b) * 3 + r) * 1024 + ch] = XX[sq * 7168 + (4 + r) * 1024 + ch];
        }
    }
    __syncthreads();
}

__device__ void chain_items(const Params& p, int l, LAS unsigned char* lds) {
    int bid = blockIdx.x; asm volatile("" : "+s"(bid));
    if (bid < 32) linattn_prompt<false>(p, l, bid >> 2, bid & 3, lds, 0);
    else if (bid < 96) linattn_prompt<true>(p, l, (bid - 32) >> 3, (bid - 32) & 7, lds, 0);
    else if (bid < 160) lru_prompt(p, l, (bid - 96) >> 3, (bid - 96) & 7, lds, 0);
}
__device__ void sample_items(const Params& p, int l, LAS unsigned char* lds) {
    unsigned* ctr = (unsigned*)(p.ws + WS_CTR) + l;
    LAS unsigned* slot = (LAS unsigned*)(lds + LDS_BYTES - 16);
    for (;;) {
        __syncthreads();
        if (threadIdx.x == 0) *slot = atomicAdd(ctr, 1u);
        __syncthreads();
        const unsigned it = (unsigned)__builtin_amdgcn_readfirstlane((int)*slot);
        if (it >= 1600u) break;
        if (it < 512u) linattn_sample<false>(p, l, it >> 2, it & 3, lds, 0);
        else if (it < 1536u) linattn_sample<true>(p, l, (it - 512) >> 3, (it - 512) & 7, lds, 0);
        else lru_sample(p, l, it - 1536, lds, 0);
    }
}

__device__ void fin_x(const Params& p, float* sst, float scale, int Gx, int cx) {
    float* x = p.out; bf16_t* xb = (bf16_t*)(p.ws + WS_XB); const float* pb = (const float*)(p.ws + WS_MF);
    int tid = threadIdx.x; asm volatile("" : "+v"(tid));
    const int wid = tid >> 6, lane = tid & 63;
    for (int row = T_P + cx * 8 + wid; row < T_ALL; row += Gx * 8) {
        float s = 0.f;
#pragma unroll
        for (int i = 0; i < 4; ++i) {
            const int c = i * 256 + lane * 4;
            const f32x4 p0 = *(const f32x4*)(pb + (size_t)(row - T_P) * DM + c), p1 = *(const f32x4*)(pb + (size_t)(512 + row - T_P) * DM + c);
            const f32x4 v = *(const f32x4*)(x + (size_t)row * DM + c) + (p0 + p1) * scale;
            *(f32x4*)(x + (size_t)row * DM + c) = v;
            u32x2 w; w.x = pk2(v[0], v[1]); w.y = pk2(v[2], v[3]);
            *(u32x2*)(xb + (size_t)row * DM + c) = w;
            s += v[0] * v[0] + v[1] * v[1] + v[2] * v[2] + v[3] * v[3];
        }
#pragma unroll
        for (int o = 32; o >= 1; o >>= 1) s += __shfl_xor(s, o);
        if (lane == 0) sst[row] = s;
    }
}
__device__ void fin_m(const Params& p, int l, int Gx, int cx) {
    float* mf = (float*)(p.ws + WS_MF); bf16_t* zb = (bf16_t*)(p.ws + WS_Z);
    const float* mb = p.in[12] + l * 3 * DM;
    int tid = threadIdx.x; asm volatile("" : "+v"(tid));
    const int wid = tid >> 6, lane = tid & 63;
    for (int r = cx * 8 + wid; r < T_ALL - T_P; r += Gx * 8) {
        bf16_t* zr = zb + (size_t)(T_P + r) * NZ;
#pragma unroll
        for (int i = 0; i < 4; ++i) {
            const int c = i * 256 + lane * 4;
            f32x4 o = (f32x4){0.f, 0.f, 0.f, 0.f};
#pragma unroll
            for (int br = 0; br < 3; ++br) {
                float* pm = mf + ((size_t)br * 512 + r) * DM + c;
                const f32x4 v = *(const f32x4*)pm;
                const u32x2 gw = *(const u32x2*)(zr + ZC_GATE + br * DM + c);
                const f32x4 bb = *(const f32x4*)(mb + br * DM + c);
                o[0] += sigmoidf_(lo2f(gw.x) + bb[0]) * v[0]; o[1] += sigmoidf_(hi2f(gw.x) + bb[1]) * v[1];
                o[2] += sigmoidf_(lo2f(gw.y) + bb[2]) * v[2]; o[3] += sigmoidf_(hi2f(gw.y) + bb[3]) * v[3];
            }
            u32x2 w; w.x = pk2(o[0], o[1]); w.y = pk2(o[2], o[3]);
            *(u32x2*)(zr + c) = w;
        }
    }
}

__device__ __forceinline__ void gbar(unsigned* bar, unsigned& gen, unsigned nblk) {
    asm volatile("s_waitcnt vmcnt(0)" ::: "memory");
    __syncthreads();
    if (threadIdx.x == 0) {
        __builtin_amdgcn_fence(__ATOMIC_RELEASE, "agent");
        asm volatile("s_waitcnt vmcnt(0)" ::: "memory");
        const unsigned target = (gen + 1u) * nblk;
        __hip_atomic_fetch_add(bar, 1u, __ATOMIC_RELAXED, __HIP_MEMORY_SCOPE_AGENT);
        while (__hip_atomic_load(bar, __ATOMIC_RELAXED, __HIP_MEMORY_SCOPE_AGENT) < target) __builtin_amdgcn_s_sleep(1);
        __builtin_amdgcn_fence(__ATOMIC_ACQUIRE, "agent");
        asm volatile("s_waitcnt vmcnt(0)" ::: "memory");
    }
    gen += 1u;
    __syncthreads();
}

__global__ void __launch_bounds__(512) fwd_megakernel(Params p) {
    extern __shared__ __attribute__((aligned(16))) unsigned char smem_raw[];
    LAS unsigned char* lds = (LAS unsigned char*)smem_raw;
    cg::grid_group grid = cg::this_grid();
    using namespace pg8;
    const int G = gridDim.x, c = blockIdx.x;
    bf16_t* wb = (bf16_t*)(p.ws + WS_W);
    bf16_t* xb = (bf16_t*)(p.ws + WS_XB);
    bf16_t* zb = (bf16_t*)(p.ws + WS_Z);
    float* ss = (float*)(p.ws + WS_SS);
    float* x = p.out;

    constexpr int NCHAIN = 160;
    unsigned* gbar_w = (unsigned*)(p.ws + WS_BAR); unsigned bgen = 0u, sgen = 0u;
    bf16_t* hids = (bf16_t*)(p.ws + WS_HIDS) - (size_t)T_P * FH;
    phase0(p, lds);
    grid.sync();
#pragma unroll 1
    for (int l = 0; l < 2; ++l) {
        bf16_t* wl = wb + (size_t)l * W_LAYER;
#pragma unroll 1
        for (int seg = 0; seg < 3; ++seg) {
            int lo, hi, samp = 0;
            if (seg == 0) { lo = 0; hi = 3; }
            else if (seg == 2) { lo = 4; hi = 8; }
            else if (c < NCHAIN) { lo = 3; hi = 4; }
            else { lo = 0; hi = 12; samp = 1; }
            int Gx = samp ? (G - NCHAIN) : G, cx = samp ? (c - NCHAIN) : c;
            const int Mx = samp ? (T_ALL - T_P) : T_P, pm0 = samp ? (T_P / 256) : 0;
            bf16_t* hid = samp ? hids : zb;
#pragma unroll 1
            for (int st = lo; st < hi; ++st) {
                asm volatile("" : "+s"(Gx), "+s"(cx));
                int op, f = 0, kx = 0;
                if (!samp) { op = (st == 6) ? 0 : (st == 7) ? 1 : st; f = st >= 6; }
                else {
                    op = (st == 0 || st == 9) ? 0 : (st == 1 || st == 10) ? 7 : (st == 2 || st == 8 || st == 11) ? 8 : (st == 3) ? 2 : (st == 4) ? 6 : (st == 5) ? 9 : (st == 6) ? 10 : 11;
                    f = st >= 9; kx = (st == 2) ? 1 : (st == 8) ? 2 : 3;
                }
                if (op == 0) {
                    Gemm g{xb, xb, xb, wl + (f == 0 ? OFF_GU1 : OFF_GU2), 0, DM, DM, DM}; StaticOrder so; so.init(Mx, 2 * FH, Gx, cx, pm0);
                    EpiUp e{hid, ss + (size_t)(3 * l + 2 * f) * T_ALL}; gemm_phase(lds, g, so, e);
                } else if (op == 1) {
                    Gemm g{hid, hid, hid, wl + (f == 0 ? OFF_D1 : OFF_D2), 0, FH, FH, FH}; StaticOrder so; so.init(Mx, DM, Gx, cx, pm0);
                    EpiRes e{x, xb, ss + (size_t)(3 * l + 2 * f + 1) * T_ALL, 0.5f, 0}; gemm_phase(lds, g, so, e);
                } else if (op == 2) {
                    Gemm g{xb, xb, xb, wl + OFF_WIN, 0, DM, DM, DM}; StaticOrder so; so.init(Mx, NZ, Gx, cx, pm0);
                    EpiWin e{zb, ss + (size_t)(3 * l + 1) * T_ALL, l == 1 ? (const float*)(p.ws + WS_LB) : (const float*)nullptr}; gemm_phase(lds, g, so, e);
                } else if (op == 3) {
                    chain_items(p, l, lds);
                } else if (op == 4) {
                    Gemm g{zb + ZC_GR, zb + ZC_GH, zb + ZC_GL, wl + OFF_RO, (size_t)DM * DM, NZ, DM, DM}; BranchOrder bo; bo.so.init(Mx, DM, Gx, cx, pm0);
                    EpiBranch e{zb, p.in[12] + l * 3 * DM, 0}; gemm_phase(lds, g, bo, e);
                } else if (op == 5) {
                    Gemm g{zb, zb, zb, wl + OFF_MO, 0, NZ, DM, DM}; StaticOrder so; so.init(Mx, DM, Gx, cx, pm0);
                    EpiRes e{x, xb, ss + (size_t)(3 * l + 2) * T_ALL, 1.0f, 0}; gemm_phase(lds, g, so, e);
                } else if (op == 6) {
                    sample_items(p, l, lds);
                } else if (op == 7 || op == 9 || op == 11) {
                    const bool dn = (op == 7), brn = (op == 9);
                    const int klen = dn ? 1408 : (brn ? 1024 : 512);
                    Gemm g{dn ? hid : (brn ? zb + ZC_GR : zb), zb + ZC_GH, zb + ZC_GL, wl + (dn ? (f == 0 ? OFF_D1 : OFF_D2) : (brn ? OFF_RO : OFF_MO)), (size_t)DM * DM, dn ? FH : NZ, dn ? FH : DM, klen};
                    SplitOrder so{2, 4, brn ? 3 : 1, brn ? 1 : 2, klen, Gx, cx, pm0};
                    EpiStoreP e{(float*)(p.ws + WS_MF), klen, brn ? 1 : 2}; gemm_phase(lds, g, so, e);
                } else if (op == 8) {
                    fin_x(p, ss + (size_t)(3 * l + kx) * T_ALL, kx == 2 ? 1.0f : 0.5f, Gx, cx);
                } else {
                    fin_m(p, l, Gx, cx);
                }
                if (seg == 1) { if (samp && st + 1 < hi) gbar(gbar_w + 64, sgen, (unsigned)(G - NCHAIN)); }
                else gbar(gbar_w, bgen, (unsigned)G);
            }
            if (seg == 1) gbar(gbar_w, bgen, (unsigned)G);
        }
    }
    {
        const float* ssf = ss + (size_t)6 * T_ALL;
        int tid = threadIdx.x; asm volatile("" : "+v"(tid));
        const int wid = tid >> 6, lane = tid & 63;
        for (int row = c * 8 + wid; row < T_ALL; row += G * 8) {
            const float r = frsq(ssf[row] * (1.0f / 1024.0f) + 1e-6f);
#pragma unroll
            for (int i = 0; i < 4; ++i) {
                const int col = i * 256 + lane * 4;
                f32x4 v = *(f32x4*)(x + (size_t)row * DM + col);
                const f32x4 gn = *(const f32x4*)(p.in[30] + col);
                v = v * r * gn;
                *(f32x4*)(x + (size_t)row * DM + col) = v;
            }
        }
    }
}

extern "C" void kernel_launch(void* const* d_in, const int* in_sizes, int n_in, void* d_out, int out_size, void* d_ws, size_t ws_size, hipStream_t stream) {
    static int grid = 0;
    if (grid == 0) {
        if (n_in != 31 || ws_size < WS_END) { fprintf(stderr, "kernel_launch: need 31 inputs and %zu bytes of workspace (got %d, %zu)\n", (size_t)WS_END, n_in, ws_size); grid = -1; return; }
        int dev = 0, cus = 0, per_cu = 0;
        hipGetDevice(&dev);
        hipDeviceGetAttribute(&cus, hipDeviceAttributeMultiprocessorCount, dev);
        if (hipFuncSetAttribute((const void*)fwd_megakernel, hipFuncAttributeMaxDynamicSharedMemorySize, LDS_BYTES) != hipSuccess) { fprintf(stderr, "kernel_launch: hipFuncSetAttribute failed\n"); grid = -1; return; }
        hipOccupancyMaxActiveBlocksPerMultiprocessor(&per_cu, (const void*)fwd_megakernel, 512, LDS_BYTES);
        if (per_cu < 1) { fprintf(stderr, "kernel_launch: occupancy query says %d blocks per CU\n", per_cu); per_cu = 1; }
        (void)hipGetLastError();
        grid = cus;
    }
    if (grid < 0) return;
    if (hipMemsetAsync((char*)d_ws + WS_BAR, 0, 512, stream) != hipSuccess) { fprintf(stderr, "kernel_launch: memset failed\n"); return; }
    Params p{};
    for (int i = 0; i < 31; ++i) p.in[i] = (const float*)d_in[i];
    p.out = (float*)d_out; p.ws = (unsigned char*)d_ws;
    void* args[] = {&p};
    hipError_t e = hipLaunchCooperativeKernel((const void*)fwd_megakernel, dim3(grid), dim3(512), args, LDS_BYTES, stream);
    if (e != hipSuccess) fprintf(stderr, "cooperative launch failed: %s (grid %d)\n", hipGetErrorString(e), grid);
}
```

```cpp
#include <hip/hip_runtime.h>
#include <hip/hip_cooperative_groups.h>
#include <cstdio>
namespace cg = cooperative_groups;
#ifndef PROF_SEL
#define PROF_SEL 0
#endif
#ifndef DBL_MASK
#define DBL_MASK 0
#endif

#define LAS __attribute__((address_space(3)))
typedef unsigned short bf16_t;
typedef short bf16x8 __attribute__((ext_vector_type(8)));
typedef short s16x4 __attribute__((ext_vector_type(4)));
typedef float f32x4 __attribute__((ext_vector_type(4)));
typedef unsigned u32x4 __attribute__((ext_vector_type(4)));
typedef unsigned u32x2 __attribute__((ext_vector_type(2)));

constexpr int T_ALL = 16896, T_P = 16384, DM = 1024, FH = 2816, NZ = 12288;
constexpr int LDS_BYTES = 163840;
constexpr size_t OFF_GU1 = 0, OFF_D1 = 5767168, OFF_WIN = 8650752, OFF_RO = 21233664, OFF_HO = 22282240, OFF_LO = 23330816,
                 OFF_MO = 24379392, OFF_GU2 = 25427968, OFF_D2 = 31195136, W_LAYER = 34078720;
constexpr size_t WS_W = 0, WS_XB = 2 * W_LAYER * 2, WS_Z = WS_XB + (size_t)T_ALL * DM * 2, WS_SS = WS_Z + (size_t)T_ALL * NZ * 2,
                 WS_ROPE = WS_SS + (size_t)8 * T_ALL * 4, WS_CTR = WS_ROPE + (size_t)2052 * 64 * 8, WS_BAR = WS_CTR + 256, WS_LB = WS_BAR + 512, WS_HIDS = WS_LB + 4096, WS_MF = WS_HIDS + (size_t)512 * FH * 2, WS_TS = WS_MF + (size_t)3 * 512 * DM * 4, WS_END = WS_TS + 4096;
constexpr int ZC_QR = 0, ZC_KR = 512, ZC_VR = 1024, ZC_GR = 2048, ZC_QH = 3072, ZC_FH = 4096, ZC_IH = 5120, ZC_GH = 6144, ZC_XL = 7168, ZC_GL = 8192, ZC_GATE = 9216;
constexpr size_t O_RETP = 17301504, O_RETS = 19398656, O_HGP = 52953088, O_HGS = 55050240, O_LRUP = 88604672, O_LRUS = 88621056, O_CVP = 88883200, O_CVS = 88932352;

struct Params { const float* in[31]; float* out; unsigned char* ws; };

__device__ __forceinline__ float bf2f(bf16_t b) { return __uint_as_float(((unsigned)b) << 16); }
__device__ __forceinline__ unsigned pk2(float lo, float hi) { unsigned r; asm("v_cvt_pk_bf16_f32 %0, %1, %2" : "=v"(r) : "v"(lo), "v"(hi)); return r; }
__device__ __forceinline__ bf16_t f2bf(float f) { return (bf16_t)(pk2(f, f) & 0xffffu); }
__device__ __forceinline__ float lo2f(unsigned w) { return __uint_as_float(w << 16); }
__device__ __forceinline__ float hi2f(unsigned w) { return __uint_as_float(w & 0xffff0000u); }
__device__ __forceinline__ float fexp(float x) { return __builtin_amdgcn_exp2f(x * 1.4426950408889634f); }
__device__ __forceinline__ float flog(float x) { return __builtin_amdgcn_logf(x) * 0.6931471805599453f; }
__device__ __forceinline__ float sigmoidf_(float x) { return __builtin_amdgcn_rcpf(1.0f + fexp(-x)); }
__device__ __forceinline__ float siluf_(float x) { return x * __builtin_amdgcn_rcpf(1.0f + fexp(-x)); }
__device__ __forceinline__ float geluf_(float x) { const float y = 0.7978845608028654f * (x + 0.044715f * x * x * x); const float e = fexp(2.0f * y); const float th = 1.0f - 2.0f * __builtin_amdgcn_rcpf(e + 1.0f); return 0.5f * x * (1.0f + th); }
__device__ __forceinline__ float frsq(float x) { return __builtin_amdgcn_rsqf(x); }

namespace pg8 {
constexpr int BM = 256, BK = 64, HALF = 128, HTB = HALF * BK * 2, NXCD = 8, WGM = 8;
__device__ __forceinline__ int lds_byte(int r, int c) { const int st = (r >> 4) * 2 + (c >> 5), rr = r & 15, cc = c & 31, ob = rr * 64 + cc * 2; return st * 1024 + (ob ^ (((ob >> 9) & 1) << 5)); }
__device__ __forceinline__ void stage_rc(int b, int& R, int& C) { const int st = b / 1024, sb = b % 1024, swz = sb ^ (((sb >> 9) & 1) << 5); R = (st >> 1) * 16 + swz / 64; C = (st & 1) * 32 + (swz % 64) / 2; }
__device__ __forceinline__ int perm32(int rho) { const int n = rho >> 4, i = rho & 15; return 8 * (i >> 2) + 4 * n + (i & 3); }

struct Unit { int pm, pn, br, kofs; };
struct Gemm { const bf16_t* A0; const bf16_t* A1; const bf16_t* A2; const bf16_t* B0; size_t bstride; int lda, ldb, K; };

struct StaticOrder {
    int nM, nN, nwg, G, c, pm0;
    __device__ void init(int M, int N, int G_, int c_, int pm0_) { nM = M / BM; nN = N / BM; nwg = nM * nN; G = G_; c = c_; pm0 = pm0_; }
    __device__ bool next(int i, Unit& u) const {
        const long L = (long)i * G + c; if (L >= nwg) return false;
        int wgid = (int)L; { const int q = nwg / NXCD, r = nwg % NXCD, xcd = wgid % NXCD, off = wgid / NXCD; wgid = (xcd < r ? xcd * (q + 1) : r * (q + 1) + (xcd - r) * q) + off; }
        const int nig = WGM * nN, gid = wgid / nig, fm = gid * WGM, gsz = (nM - fm) < WGM ? (nM - fm) : WGM;
        u.pm = pm0 + fm + ((wgid % nig) % gsz); u.pn = (wgid % nig) / gsz; u.br = 0; u.kofs = 0; return true;
    }
};
struct SplitOrder {
    int nM, nN, nbr, nsplit, klen, G, c, pm0;
    __device__ bool next(int i, Unit& u) const {
        const int L = i * G + c; if (L >= nM * nN * nbr * nsplit) return false;
        const int ks = L % nsplit, r = L / nsplit; u.br = r % nbr; const int t = r / nbr; u.pm = pm0 + t % nM; u.pn = t / nM; u.kofs = ks * klen; return true;
    }
};
struct BranchOrder {
    StaticOrder so;
    __device__ bool next(int i, Unit& u) const { if (!so.next(i / 3, u)) return false; u.br = i % 3; return true; }
};

template <class Epi, class Sched>
__device__ __forceinline__ void gemm_phase(LAS unsigned char* lds, const Gemm g, const Sched& S, const Epi& E) {
    int tid = threadIdx.x; asm volatile("" : "+v"(tid));
    const int wid = __builtin_amdgcn_readfirstlane(tid >> 6), lane = tid & 63, wr = wid >> 2, wc = wid & 3, fr = lane & 15, fq = lane >> 4;
    const int K = g.ldb, nt = g.K / BK, lda = g.lda;
    unsigned voffA[2], voffB[2];
#pragma unroll
    for (int i = 0; i < 2; ++i) { int R, C; stage_rc(tid * 16 + i * 8192, R, C); const int Rb = Epi::PERM ? ((R & ~31) + perm32(R & 31)) : R;
        voffA[i] = (unsigned)(R * lda + C) * 2u; voffB[i] = (unsigned)(Rb * K + C) * 2u; }
    const size_t kstep = (size_t)(BK * 2);
    const size_t hstepA = (size_t)HALF * lda * 2, hstepB = (size_t)HALF * K * 2;
    const size_t tstepA = 2 * hstepA, tstepB = 2 * hstepB;
    const unsigned ldsw = (unsigned)wid * 1024u;
    const int aoff = lds_byte(wr * 64 + fr, fq * 8), boff = lds_byte(wc * 32 + fr, fq * 8);
#define PG8_SA(b, h) (((b) * 2 + (h)) * HTB)
#define PG8_SB(b, h) ((4 + (b) * 2 + (h)) * HTB)
#define PG8_STAGE(bufoff, gbase, voff) do { _Pragma("unroll") for (int _i = 0; _i < 2; ++_i) \
        __builtin_amdgcn_global_load_lds((const unsigned*)((const char*)(gbase) + (voff)[_i]), (LAS unsigned*)(lds + (bufoff) + ldsw + _i * 8192), 16, 0, 0); } while (0)
#define PG8_LDA(dst, b, h) do { _Pragma("unroll") for (int m = 0; m < 4; ++m) _Pragma("unroll") for (int k = 0; k < 2; ++k) dst[m][k] = *(const LAS bf16x8*)(lds + PG8_SA(b, h) + aoff + m * 2048 + k * 1024); } while (0)
#define PG8_LDB(dst, b, h) do { _Pragma("unroll") for (int n = 0; n < 2; ++n) _Pragma("unroll") for (int k = 0; k < 2; ++k) dst[n][k] = *(const LAS bf16x8*)(lds + PG8_SB(b, h) + boff + n * 2048 + k * 1024); } while (0)
#define PG8_MMA(ai, bj, At, Bt) do { __builtin_amdgcn_s_setprio(1); _Pragma("unroll") for (int m = 0; m < 4; ++m) _Pragma("unroll") for (int n = 0; n < 2; ++n) _Pragma("unroll") for (int k = 0; k < 2; ++k) \
        acc[ai][bj][m][n] = __builtin_amdgcn_mfma_f32_16x16x32_bf16(Bt[n][k], At[m][k], acc[ai][bj][m][n], 0, 0, 0); __builtin_amdgcn_s_setprio(0); } while (0)
#define PG8_WAIT_V(n) asm volatile("s_waitcnt vmcnt(" #n ")" ::: "memory")
#define PG8_WAIT_L(n) asm volatile("s_waitcnt lgkmcnt(" #n ")" ::: "memory")
#define PG8_BAR __builtin_amdgcn_s_barrier()
#define PG8_SCHED __builtin_amdgcn_sched_barrier(0)
#define PG8_APTR(u) ((const char*)((u).br == 0 ? g.A0 : ((u).br == 1 ? g.A1 : g.A2)) + (size_t)(u).pm * tstepA + (size_t)(u).kofs * 2)
#define PG8_BPTR(u) ((const char*)(g.B0 + (size_t)(u).br * g.bstride) + (size_t)(u).pn * tstepB + (size_t)(u).kofs * 2)
    Unit cur, nxt; int ui = 0;
    if (!S.next(0, cur)) return;
    f32x4 acc[2][2][4][2];
#pragma unroll
    for (int a = 0; a < 2; ++a)
#pragma unroll
        for (int b = 0; b < 2; ++b)
#pragma unroll
            for (int m = 0; m < 4; ++m)
#pragma unroll
                for (int n = 0; n < 2; ++n) acc[a][b][m][n] = (f32x4){0.f, 0.f, 0.f, 0.f};
    bf16x8 At[4][2], B0[2][2], B1[2][2];
    const char* cA = PG8_APTR(cur); const char* cB = PG8_BPTR(cur);
    PG8_STAGE(PG8_SB(0, 0), cB, voffB); PG8_STAGE(PG8_SA(0, 0), cA, voffA); PG8_STAGE(PG8_SB(0, 1), cB + hstepB, voffB); PG8_STAGE(PG8_SA(0, 1), cA + hstepA, voffA);
    if (wr == 1) PG8_BAR;
    PG8_WAIT_V(4); PG8_BAR;
    PG8_STAGE(PG8_SB(1, 0), cB + kstep, voffB); PG8_STAGE(PG8_SA(1, 0), cA + kstep, voffA); PG8_STAGE(PG8_SB(1, 1), cB + hstepB + kstep, voffB);
    PG8_WAIT_V(6); PG8_BAR;
    for (;;) {
        const bool has_next = S.next(ui + 1, nxt);
        const char* nA = has_next ? PG8_APTR(nxt) : cA; const char* nB = has_next ? PG8_BPTR(nxt) : cB;
        for (int t = 0; t < nt; t += 2) {
            const bool last = (t == nt - 2);
            const char* a1 = cA + (size_t)(t + 1) * kstep;
            const char* a2 = last ? nA : cA + (size_t)(t + 2) * kstep; const char* b2 = last ? nB : cB + (size_t)(t + 2) * kstep;
            const char* a3 = a2 + kstep; const char* b3 = b2 + kstep;
            PG8_LDB(B0, 0, 0); PG8_SCHED; PG8_LDA(At, 0, 0); PG8_STAGE(PG8_SA(1, 1), a1 + hstepA, voffA);
            PG8_WAIT_L(8); PG8_BAR; PG8_WAIT_L(0); PG8_MMA(0, 0, At, B0); PG8_BAR; PG8_SCHED;
            PG8_LDB(B1, 0, 1); PG8_STAGE(PG8_SB(0, 0), b2, voffB);
            PG8_BAR; PG8_WAIT_L(0); PG8_MMA(0, 1, At, B1); PG8_BAR;
            PG8_LDA(At, 0, 1); PG8_STAGE(PG8_SA(0, 0), a2, voffA);
            PG8_BAR; PG8_WAIT_L(0); PG8_MMA(1, 0, At, B0); PG8_BAR; PG8_SCHED;
            PG8_STAGE(PG8_SB(0, 1), b2 + hstepB, voffB);
            PG8_WAIT_V(6); PG8_BAR; PG8_MMA(1, 1, At, B1); PG8_BAR;
            PG8_LDB(B0, 1, 0); PG8_SCHED; PG8_LDA(At, 1, 0); PG8_STAGE(PG8_SA(0, 1), a2 + hstepA, voffA);
            PG8_WAIT_L(8); PG8_BAR; PG8_WAIT_L(0); PG8_MMA(0, 0, At, B0); PG8_BAR; PG8_SCHED;
            PG8_LDB(B1, 1, 1); PG8_STAGE(PG8_SB(1, 0), b3, voffB);
            PG8_BAR; PG8_WAIT_L(0); PG8_MMA(0, 1, At, B1); PG8_BAR;
            PG8_LDA(At, 1, 1); PG8_STAGE(PG8_SA(1, 0), a3, voffA);
            PG8_BAR; PG8_WAIT_L(0); PG8_MMA(1, 0, At, B0); PG8_BAR; PG8_SCHED;
            PG8_STAGE(PG8_SB(1, 1), b3 + hstepB, voffB);
            PG8_WAIT_V(6); PG8_BAR; PG8_MMA(1, 1, At, B1); PG8_BAR;
        }
        E(acc, cur, wr, wc, fr, fq);
        if (!has_next) break;
#pragma unroll
        for (int a = 0; a < 2; ++a)
#pragma unroll
            for (int b = 0; b < 2; ++b)
#pragma unroll
                for (int m = 0; m < 4; ++m)
#pragma unroll
                    for (int n = 0; n < 2; ++n) acc[a][b][m][n] = (f32x4){0.f, 0.f, 0.f, 0.f};
        cur = nxt; cA = nA; cB = nB; ++ui;
    }
    PG8_WAIT_V(0);
    if (wr == 0) PG8_BAR;
    PG8_BAR;
#undef PG8_SA
#undef PG8_SB
#undef PG8_STAGE
#undef PG8_LDA
#undef PG8_LDB
#undef PG8_MMA
#undef PG8_WAIT_V
#undef PG8_WAIT_L
#undef PG8_BAR
#undef PG8_SCHED
#undef PG8_APTR
#undef PG8_BPTR
}

struct EpiUp {
    static constexpr bool PERM = false;
    bf16_t* hid; bf16_t* hid2; const float* ss;
    __device__ __forceinline__ void operator()(const f32x4 (&acc)[2][2][4][2], const Unit& u, int wr, int wc, int fr, int fq) const {
        const int row0 = u.pm * BM + wr * 64 + fr;
        float rr[2][4];
#pragma unroll
        for (int ai = 0; ai < 2; ++ai)
#pragma unroll
            for (int m = 0; m < 4; ++m) rr[ai][m] = ss[row0 + ai * HALF + m * 16];
#pragma unroll
        for (int ai = 0; ai < 2; ++ai)
#pragma unroll
            for (int m = 0; m < 4; ++m) {
                const int row = row0 + ai * HALF + m * 16;
                const float r = frsq(rr[ai][m] * (1.0f / 1024.0f) + 1e-6f);
#pragma unroll
                for (int bj = 0; bj < 2; ++bj) {
                    const f32x4 gt = acc[ai][bj][m][0] * r, up = acc[ai][bj][m][1] * r;
                    float h[4];
#pragma unroll
                    for (int j = 0; j < 4; ++j) h[j] = siluf_(gt[j]) * up[j];
                    const int col = 16 * (8 * u.pn + 4 * bj + wc) + 4 * fq;
                    u32x2 w; w.x = pk2(h[0], h[1]); w.y = pk2(h[2], h[3]);
                    *(u32x2*)((u.pm >= T_P / BM ? hid2 : hid) + (size_t)row * FH + col) = w;
                }
            }
    }
};
struct EpiRes {
    static constexpr bool PERM = false;
    float* x; bf16_t* xb; float* ssn; float scale; int dry;
    __device__ __forceinline__ void operator()(const f32x4 (&acc)[2][2][4][2], const Unit& u, int wr, int wc, int fr, int fq) const {
        const int row0 = u.pm * BM + wr * 64 + fr, col0 = u.pn * BM + wc * 32 + 4 * fq;
        f32x4 cur[2][2], nxt[2][2];
#pragma unroll
        for (int bj = 0; bj < 2; ++bj)
#pragma unroll
            for (int n = 0; n < 2; ++n) cur[bj][n] = *(const f32x4*)(x + (size_t)row0 * DM + col0 + bj * HALF + n * 16);
#pragma unroll
        for (int gi = 0; gi < 8; ++gi) {
            const int ai = gi >> 2, m = gi & 3;
            const int row = row0 + ai * HALF + m * 16;
            if (gi < 7) { const int rown = row0 + ((gi + 1) >> 2) * HALF + ((gi + 1) & 3) * 16;
#pragma unroll
                for (int bj = 0; bj < 2; ++bj)
#pragma unroll
                    for (int n = 0; n < 2; ++n) nxt[bj][n] = *(const f32x4*)(x + (size_t)rown * DM + col0 + bj * HALF + n * 16); }
            float s = 0.f;
#pragma unroll
            for (int bj = 0; bj < 2; ++bj)
#pragma unroll
                for (int n = 0; n < 2; ++n) {
                    const int col = col0 + bj * HALF + n * 16;
                    const f32x4 v = cur[bj][n] + acc[ai][bj][m][n] * scale;
                    u32x2 w; w.x = pk2(v[0], v[1]); w.y = pk2(v[2], v[3]);
                    if (!dry) { *(f32x4*)(x + (size_t)row * DM + col) = v; *(u32x2*)(xb + (size_t)row * DM + col) = w; }
                    s += v[0] * v[0] + v[1] * v[1] + v[2] * v[2] + v[3] * v[3];
                }
            s += __shfl_xor(s, 16); s += __shfl_xor(s, 32);
            if (fq == 0 && !dry) atomicAdd(ssn + row, s);
#pragma unroll
            for (int bj = 0; bj < 2; ++bj)
#pragma unroll
                for (int n = 0; n < 2; ++n) cur[bj][n] = nxt[bj][n];
        }
    }
};
__device__ __forceinline__ unsigned pkh2(float lo, float hi) { const _Float16 a = (_Float16)lo, b = (_Float16)hi; return (unsigned)__builtin_bit_cast(unsigned short, a) | ((unsigned)__builtin_bit_cast(unsigned short, b) << 16); }
__device__ __forceinline__ float h2f_lo(unsigned w) { return (float)__builtin_bit_cast(_Float16, (unsigned short)(w & 0xffffu)); }
__device__ __forceinline__ float h2f_hi(unsigned w) { return (float)__builtin_bit_cast(_Float16, (unsigned short)(w >> 16)); }
__device__ __forceinline__ float hg_logf(float v, float lb) {
    const float ls = fminf(v, 0.f) - flog(1.0f + fexp(-fabsf(v)));
    return (lb == 0.f) ? ls : flog(lb + (1.0f - lb) * fexp(ls));
}
struct EpiWin {
    static constexpr bool PERM = true;
    bf16_t* z; const float* ss; const float* lbv; const float2* rope;
    __device__ __forceinline__ void operator()(const f32x4 (&acc)[2][2][4][2], const Unit& u, int wr, int wc, int fr, int fq) const {
        const int row0 = u.pm * BM + wr * 64 + fr, col0 = u.pn * BM + wc * 32 + 8 * fq;
        const int ctile = u.pn * BM;
        const int mode = (ctile < ZC_VR) ? 3 : (ctile >= ZC_QH && ctile < ZC_FH) ? 1 : ((ctile >= ZC_FH && ctile < ZC_IH) ? 2 : 0);
        float rr[2][4];
#pragma unroll
        for (int ai = 0; ai < 2; ++ai)
#pragma unroll
            for (int m = 0; m < 4; ++m) rr[ai][m] = ss[row0 + ai * HALF + m * 16];
        if (mode == 0) {
#pragma unroll
            for (int ai = 0; ai < 2; ++ai)
#pragma unroll
                for (int m = 0; m < 4; ++m) {
                    const int row = row0 + ai * HALF + m * 16;
                    const float r = frsq(rr[ai][m] * (1.0f / 1024.0f) + 1e-6f);
#pragma unroll
                    for (int bj = 0; bj < 2; ++bj) {
                        const f32x4 v0 = acc[ai][bj][m][0] * r, v1 = acc[ai][bj][m][1] * r;
                        u32x4 w; w.x = pk2(v0[0], v0[1]); w.y = pk2(v0[2], v0[3]); w.z = pk2(v1[0], v1[1]); w.w = pk2(v1[2], v1[3]);
                        *(u32x4*)(z + (size_t)row * NZ + col0 + bj * HALF) = w;
                    }
                }
        } else if (mode == 3) {
#pragma unroll
            for (int ai = 0; ai < 2; ++ai)
#pragma unroll
                for (int m = 0; m < 4; ++m) {
                    const int row = row0 + ai * HALF + m * 16;
                    const float r = frsq(rr[ai][m] * (1.0f / 1024.0f) + 1e-6f);
                    const int pidx = row < T_P ? (row & 2047) : 2048 + ((row - T_P) & 3);
                    const float2* rp = rope + (size_t)pidx * 64 + 16 * wc + 4 * fq;
                    const f32x4 cs01 = *(const f32x4*)rp, cs23 = *(const f32x4*)(rp + 2);
#pragma unroll
                    for (int bj = 0; bj < 2; ++bj) {
                        const f32x4 x1 = acc[ai][bj][m][0] * r, x2 = acc[ai][bj][m][1] * r;
                        const float o10 = x1[0] * cs01[0] - x2[0] * cs01[1], o20 = x1[0] * cs01[1] + x2[0] * cs01[0];
                        const float o11 = x1[1] * cs01[2] - x2[1] * cs01[3], o21 = x1[1] * cs01[3] + x2[1] * cs01[2];
                        const float o12 = x1[2] * cs23[0] - x2[2] * cs23[1], o22 = x1[2] * cs23[1] + x2[2] * cs23[0];
                        const float o13 = x1[3] * cs23[2] - x2[3] * cs23[3], o23 = x1[3] * cs23[3] + x2[3] * cs23[2];
                        bf16_t* zo = z + (size_t)row * NZ + ctile + bj * HALF + 16 * wc + 4 * fq;
                        u32x2 w1, w2; w1.x = pk2(o10, o11); w1.y = pk2(o12, o13); w2.x = pk2(o20, o21); w2.y = pk2(o22, o23);
                        *(u32x2*)zo = w1; *(u32x2*)(zo + 64) = w2;
                    }
                }
        } else if (mode == 1) {
#pragma unroll
            for (int ai = 0; ai < 2; ++ai)
#pragma unroll
                for (int m = 0; m < 4; ++m) {
                    const int row = row0 + ai * HALF + m * 16;
                    const float r = frsq(rr[ai][m] * (1.0f / 1024.0f) + 1e-6f);
#pragma unroll
                    for (int bj = 0; bj < 2; ++bj) {
                        const f32x4 v0 = acc[ai][bj][m][0] * r, v1 = acc[ai][bj][m][1] * r;
                        u32x4 w; w.x = pk2(siluf_(v0[0]), siluf_(v0[1])); w.y = pk2(siluf_(v0[2]), siluf_(v0[3])); w.z = pk2(siluf_(v1[0]), siluf_(v1[1])); w.w = pk2(siluf_(v1[2]), siluf_(v1[3]));
                        *(u32x4*)(z + (size_t)row * NZ + col0 + bj * HALF) = w;
                    }
                }
        } else {
#pragma unroll
            for (int bj = 0; bj < 2; ++bj) {
                f32x4 l0 = (f32x4){0.f, 0.f, 0.f, 0.f}, l1 = l0;
                if (lbv) { l0 = *(const f32x4*)(lbv + col0 + bj * HALF - ZC_FH); l1 = *(const f32x4*)(lbv + col0 + bj * HALF - ZC_FH + 4); }
#pragma unroll
                for (int ai = 0; ai < 2; ++ai)
#pragma unroll
                    for (int m = 0; m < 4; ++m) {
                        const int row = row0 + ai * HALF + m * 16;
                        const float r = frsq(rr[ai][m] * (1.0f / 1024.0f) + 1e-6f);
                        const f32x4 v0 = acc[ai][bj][m][0] * r, v1 = acc[ai][bj][m][1] * r;
                        u32x4 w;
                        w.x = pkh2(hg_logf(v0[0], l0[0]), hg_logf(v0[1], l0[1])); w.y = pkh2(hg_logf(v0[2], l0[2]), hg_logf(v0[3], l0[3]));
                        w.z = pkh2(hg_logf(v1[0], l1[0]), hg_logf(v1[1], l1[1])); w.w = pkh2(hg_logf(v1[2], l1[2]), hg_logf(v1[3], l1[3]));
                        *(u32x4*)(z + (size_t)row * NZ + col0 + bj * HALF) = w;
                    }
            }
        }
    }
};
struct EpiBranch {
    static constexpr bool PERM = true;
    bf16_t* z; bf16_t* mrg; const float* mbias; int dry;
    __device__ __forceinline__ void operator()(const f32x4 (&acc)[2][2][4][2], const Unit& u, int wr, int wc, int fr, int fq) const {
        const int row0 = u.pm * BM + wr * 64 + fr, col0 = u.pn * BM + wc * 32 + 8 * fq;
        const int br = u.br;
#pragma unroll
        for (int bj = 0; bj < 2; ++bj) {
            const int col = col0 + bj * HALF;
            const f32x4 b0 = *(const f32x4*)(mbias + br * DM + col), b1 = *(const f32x4*)(mbias + br * DM + col + 4);
#pragma unroll
            for (int am = 0; am < 4; ++am) {
                const int ai = am >> 1, mb = (am & 1) * 2;
                u32x4 gw[2], pw[2];
#pragma unroll
                for (int mm = 0; mm < 2; ++mm) {
                    const int rowm = row0 + ai * HALF + (mb + mm) * 16;
                    gw[mm] = *(const u32x4*)(z + (size_t)rowm * NZ + ZC_GATE + br * DM + col);
                    pw[mm] = (u32x4){0u, 0u, 0u, 0u};
                    if (br > 0) pw[mm] = *(const u32x4*)(mrg + (size_t)rowm * DM + col);
                }
#pragma unroll
                for (int mm = 0; mm < 2; ++mm) {
                    const int m = mb + mm;
                    bf16_t* zr = mrg + (size_t)(row0 + ai * HALF + m * 16) * DM;
                    float o[8];
                    const f32x4 a0 = acc[ai][bj][m][0], a1 = acc[ai][bj][m][1];
                    o[0] = sigmoidf_(lo2f(gw[mm].x) + b0[0]) * a0[0] + lo2f(pw[mm].x); o[1] = sigmoidf_(hi2f(gw[mm].x) + b0[1]) * a0[1] + hi2f(pw[mm].x);
                    o[2] = sigmoidf_(lo2f(gw[mm].y) + b0[2]) * a0[2] + lo2f(pw[mm].y); o[3] = sigmoidf_(hi2f(gw[mm].y) + b0[3]) * a0[3] + hi2f(pw[mm].y);
                    o[4] = sigmoidf_(lo2f(gw[mm].z) + b1[0]) * a1[0] + lo2f(pw[mm].z); o[5] = sigmoidf_(hi2f(gw[mm].z) + b1[1]) * a1[1] + hi2f(pw[mm].z);
                    o[6] = sigmoidf_(lo2f(gw[mm].w) + b1[2]) * a1[2] + lo2f(pw[mm].w); o[7] = sigmoidf_(hi2f(gw[mm].w) + b1[3]) * a1[3] + hi2f(pw[mm].w);
                    u32x4 w; w.x = pk2(o[0], o[1]); w.y = pk2(o[2], o[3]); w.z = pk2(o[4], o[5]); w.w = pk2(o[6], o[7]);
                    if (!dry) *(u32x4*)(zr + col) = w;
                }
            }
        }
    }
};
struct EpiStoreP {
    static constexpr bool PERM = false;
    float* pbuf; int klen, nsplit;
    __device__ __forceinline__ void operator()(const f32x4 (&acc)[2][2][4][2], const Unit& u, int wr, int wc, int fr_, int fq_) const {
        int fr = fr_, fq = fq_; asm volatile("" : "+v"(fr), "+v"(fq));
        const int row0 = u.pm * BM - T_P + wr * 64 + fr, col0 = u.pn * BM + wc * 32 + 4 * fq;
        float* base = pbuf + (size_t)(u.br * nsplit + u.kofs / klen) * (512 * DM);
#pragma unroll
        for (int ai = 0; ai < 2; ++ai)
#pragma unroll
            for (int m = 0; m < 4; ++m)
#pragma unroll
                for (int bj = 0; bj < 2; ++bj)
#pragma unroll
                    for (int n = 0; n < 2; ++n)
                        *(f32x4*)(base + (size_t)(row0 + ai * HALF + m * 16) * DM + col0 + bj * HALF + n * 16) = acc[ai][bj][m][n];
    }
};
}

__device__ __forceinline__ void conv_tile(const float* __restrict__ src, int ldn, int k0, int n0, bf16_t* __restrict__ dst, int K, const float* __restrict__ gain, int mode, LAS float* tile) {
    int tid = threadIdx.x; asm volatile("" : "+v"(tid));
    float v[32];
#pragma unroll
    for (int i = 0; i < 32; ++i) v[i] = src[(size_t)(k0 + i * 2 + (tid >> 8)) * ldn + n0 + (tid & 255)];
    if (gain) {
#pragma unroll
        for (int i = 0; i < 32; ++i) v[i] *= gain[k0 + i * 2 + (tid >> 8)];
    }
#pragma unroll
    for (int i = 0; i < 32; ++i) tile[(i * 2 + (tid >> 8)) * 257 + (tid & 255)] = v[i];
    __syncthreads();
#pragma unroll
    for (int i = 0; i < 4; ++i) {
        const int id = tid + 512 * i, nn = id >> 3, ks = (id & 7) * 8;
        float t[8];
#pragma unroll
        for (int j = 0; j < 8; ++j) t[j] = tile[(ks + j) * 257 + nn];
        const int n = n0 + nn;
        const int row = (mode == 0) ? n : (mode == 3) ? ((n & ~127) + 8 * ((n & 63) >> 2) + 4 * ((n >> 6) & 1) + (n & 3)) : (32 * (n >> 4) + (mode == 2 ? 16 : 0) + (n & 15));
        u32x4 w; w.x = pk2(t[0], t[1]); w.y = pk2(t[2], t[3]); w.z = pk2(t[4], t[5]); w.w = pk2(t[6], t[7]);
        *(u32x4*)(dst + (size_t)row * K + k0 + ks) = w;
    }
    __syncthreads();
}

__device__ void conv_job(const Params& p, int ti, LAS float* tile) {
    bf16_t* wb = (bf16_t*)(p.ws + WS_W);
    {
        const int l = ti / 2080; int r = ti % 2080;
        bf16_t* wl = wb + (size_t)l * W_LAYER;
        const float* src; int Ks, Ns; bf16_t* dst; const float* gain = nullptr; int mode = 0;
        if (r < 176) { src = p.in[7] + (size_t)l * DM * FH; Ks = DM; Ns = FH; dst = wl + OFF_GU1; gain = p.in[6] + l * DM; mode = 1; }
        else if ((r -= 176) < 176) { src = p.in[8] + (size_t)l * DM * FH; Ks = DM; Ns = FH; dst = wl + OFF_GU1; gain = p.in[6] + l * DM; mode = 2; }
        else if ((r -= 176) < 176) { src = p.in[9] + (size_t)l * DM * FH; Ks = FH; Ns = DM; dst = wl + OFF_D1; }
        else if ((r -= 176) < 768) { src = p.in[11] + (size_t)l * DM * NZ; Ks = DM; Ns = NZ; dst = wl + OFF_WIN; gain = p.in[10] + l * DM; }
        else if ((r -= 768) < 64) { src = p.in[13] + (size_t)l * DM * DM; Ks = DM; Ns = DM; dst = wl + OFF_RO; }
        else if ((r -= 64) < 64) { src = p.in[16] + (size_t)l * DM * DM; Ks = DM; Ns = DM; dst = wl + OFF_HO; }
        else if ((r -= 64) < 64) { src = p.in[24] + (size_t)l * DM * DM; Ks = DM; Ns = DM; dst = wl + OFF_LO; }
        else if ((r -= 64) < 64) { src = p.in[25] + (size_t)l * DM * DM; Ks = DM; Ns = DM; dst = wl + OFF_MO; }
        else if ((r -= 64) < 176) { src = p.in[27] + (size_t)l * DM * FH; Ks = DM; Ns = FH; dst = wl + OFF_GU2; gain = p.in[26] + l * DM; mode = 1; }
        else if ((r -= 176) < 176) { src = p.in[28] + (size_t)l * DM * FH; Ks = DM; Ns = FH; dst = wl + OFF_GU2; gain = p.in[26] + l * DM; mode = 2; }
        else { r -= 176; src = p.in[29] + (size_t)l * DM * FH; Ks = FH; Ns = DM; dst = wl + OFF_D2; }
        const int nkt = Ks / 64;
        const int kt = r % nkt, ntile = r / nkt;
        if (Ns == NZ && ntile < 4) mode = 3;
        conv_tile(src, Ns, kt * 64, ntile * 256, dst, Ks, gain, mode, tile);
    }
}

__device__ void phase0(const Params& p, LAS unsigned char* lds) {
    int tid = threadIdx.x; asm volatile("" : "+v"(tid));
    const int bid = blockIdx.x, nb = gridDim.x;
    LAS float* tile = (LAS float*)lds;
    for (int ti = bid; ti < 2080; ti += nb) conv_job(p, ti, tile);
#if PROF_SEL
    if (bid == 0 && threadIdx.x == 0) ((unsigned long long*)(p.ws + WS_TS))[20] = __builtin_amdgcn_s_memrealtime();
#endif
    float* x = p.out; bf16_t* xb = (bf16_t*)(p.ws + WS_XB); float* ss = (float*)(p.ws + WS_SS);
    const int wid = tid >> 6, lane = tid & 63;
    for (int row = bid * 8 + wid; row < T_ALL; row += nb * 8) {
        const float* srow = (row < T_P) ? (p.in[0] + (size_t)row * DM) : (p.in[1] + (size_t)(row - T_P) * DM);
        float s = 0.f;
#pragma unroll
        for (int i = 0; i < 4; ++i) {
            const int c = i * 256 + lane * 4;
            const f32x4 v = *(const f32x4*)(srow + c);
            *(f32x4*)(x + (size_t)row * DM + c) = v;
            u32x2 w; w.x = pk2(v[0], v[1]); w.y = pk2(v[2], v[3]);
            *(u32x2*)(xb + (size_t)row * DM + c) = w;
            s += v[0] * v[0] + v[1] * v[1] + v[2] * v[2] + v[3] * v[3];
        }
#pragma unroll
        for (int o = 32; o >= 1; o >>= 1) s += __shfl_xor(s, o);
        if (lane == 0) { ss[row] = s;
#pragma unroll
            for (int k = 1; k < 8; ++k) ss[(size_t)k * T_ALL + row] = 0.f; }
    }
#if PROF_SEL
    if (bid == 0 && threadIdx.x == 0) ((unsigned long long*)(p.ws + WS_TS))[21] = __builtin_amdgcn_s_memrealtime();
#endif
    float2* rope = (float2*)(p.ws + WS_ROPE);
    for (int e = bid * 512 + tid; e < 2052 * 64; e += nb * 512) {
        const int idx = e >> 6, i = e & 63;
        const int pos = idx < 2048 ? idx : (16384 + idx - 2048);
        double inv = 1.0;
        for (int k = 0; k < i; ++k) inv *= 0.8659643233600653;
        double rev = (double)pos * inv * 0.15915494309189535;
        rev -= (double)(long long)rev;
        const float rf = (float)rev;
        rope[e] = make_float2(__builtin_amdgcn_cosf(rf), __builtin_amdgcn_sinf(rf));
    }
    if (bid == 0 && tid < 64) ((unsigned*)(p.ws + WS_CTR))[tid] = 0u;
    if (bid == 1) { float* lbp = (float*)(p.ws + WS_LB); for (int i = tid; i < 1024; i += 512) lbp[i] = sigmoidf_(p.in[14][1024 + i] - p.in[14][i]); }
}

__device__ __forceinline__ bf16x8 ldfrag(const LAS bf16_t* M, int ld, int r0, int k0, int fr, int fq) { return *(const LAS bf16x8*)(M + (r0 + fr) * ld + k0 + fq * 8); }
__device__ __forceinline__ bf16x8 ldfrag_tr(const LAS bf16_t* M, int ld, int i0, int k0, int fr, int fq) {
    const LAS bf16_t* q = M + (k0 + fq * 8 + (fr >> 2)) * ld + i0 + (fr & 3) * 4;
    const s16x4 a = __builtin_amdgcn_ds_read_tr16_b64_v4i16((LAS s16x4*)q);
    const s16x4 b = __builtin_amdgcn_ds_read_tr16_b64_v4i16((LAS s16x4*)(q + 4 * ld));
    return (bf16x8){a[0], a[1], a[2], a[3], b[0], b[1], b[2], b[3]};
}
#define MMA16(acc, bfr, afr) acc = __builtin_amdgcn_mfma_f32_16x16x32_bf16(bfr, afr, acc, 0, 0, 0)

__device__ __forceinline__ bf16_t* og_compact(const Params& p, int br) {
    bf16_t* base0 = (bf16_t*)(p.out + O_RETS + (size_t)128 * 4 * 128 * 256);
    bf16_t* base1 = (bf16_t*)(p.out + O_HGS + (size_t)128 * 8 * 128 * 128);
    return br == 0 ? base0 + (size_t)T_P * DM : (br == 1 ? base1 : base1 + (size_t)T_P * DM);
}

template <bool HG>
__device__ void linattn_prompt(const Params& p, int l, int b, int h, LAS unsigned char* lds, int dry) {
    constexpr int DV = HG ? 128 : 256, NVT = DV / 16, NV = DV / 32, LQ = 136, LV = DV + 8, LP = 72;
    int tid = threadIdx.x; asm volatile("" : "+v"(tid));
    const int wid = __builtin_amdgcn_readfirstlane(tid >> 6), lane = tid & 63, fr = lane & 15, fq = lane >> 4;
    LAS bf16_t* Q = (LAS bf16_t*)lds;
    LAS bf16_t* Kn = Q + 64 * LQ;
    LAS bf16_t* P = Kn;
    LAS bf16_t* KH = Kn + 64 * LQ;
    LAS bf16_t* V = KH + 64 * LQ;
    LAS bf16_t* ST = V + 64 * LV;
    LAS float* red = (LAS float*)(ST + DV * LQ);
    LAS float* eL = red + 512;
    LAS float* eR = eL + 128;
    LAS float* segs = eR + 128;
    bf16_t* zb = (bf16_t*)(p.ws + WS_Z);
    const float2* rope = (const float2*)(p.ws + WS_ROPE);
    const int qcol = HG ? ZC_QH + h * 128 : ZC_QR + h * 128;
    const int kcol = HG ? ZC_FH + h * 128 : ZC_KR + h * 128;
    const int vcol = HG ? ZC_IH + h * 128 : ZC_VR + h * 256;
    const int gcol = HG ? ZC_GH + h * 128 : ZC_GR + h * 256;
    const float log_g = HG ? 0.f : logf(1.0f - exp2f(-5.0f - (float)h));
    f32x4 st[NVT];
#pragma unroll
    for (int i = 0; i < NVT; ++i) st[i] = (f32x4){0.f, 0.f, 0.f, 0.f};

    u32x4 rq1, rq2, rk1, rk2, rawv[HG ? 2 : 4];
    bf16_t rawf[16], rawq[16];
#define LOAD_RAW(cc) do { const int r0_ = b * 2048 + (cc) * 64; \
        if (!HG) { const bf16_t* zr_ = zb + (size_t)(r0_ + (tid >> 3)) * NZ; const int g_ = tid & 7; \
            rq1 = *(const u32x4*)(zr_ + qcol + 8 * g_); rq2 = *(const u32x4*)(zr_ + qcol + 64 + 8 * g_); rk1 = *(const u32x4*)(zr_ + kcol + 8 * g_); rk2 = *(const u32x4*)(zr_ + kcol + 64 + 8 * g_); \
            _Pragma("unroll") for (int i_ = 0; i_ < 4; ++i_) { const int id_ = tid + 512 * i_; rawv[i_] = *(const u32x4*)(zb + (size_t)(r0_ + (id_ >> 5)) * NZ + vcol + 8 * (id_ & 31)); } } \
        else { _Pragma("unroll") for (int j_ = 0; j_ < 16; ++j_) { const bf16_t* zr_ = zb + (size_t)(r0_ + (tid >> 7) * 16 + j_) * NZ; rawf[j_] = zr_[kcol + (tid & 127)]; rawq[j_] = zr_[qcol + (tid & 127)]; } \
            _Pragma("unroll") for (int i_ = 0; i_ < 2; ++i_) { const int id_ = tid + 512 * i_; rawv[i_] = *(const u32x4*)(zb + (size_t)(r0_ + (id_ >> 4)) * NZ + vcol + 8 * (id_ & 15)); } } } while (0)
    LOAD_RAW(0);
    for (int c = 0; c < 32; ++c) {
        const int row0 = b * 2048 + c * 64;
        if (!HG) {
            const int t = tid >> 3, g = tid & 7;
            const u32x4 q1 = rq1, q2 = rq2, k1 = rk1, k2 = rk2;
            const float kd = fexp((float)(63 - t) * log_g) * 0.08838834764831845f;
            unsigned ha[4], hb[4];
#pragma unroll
            for (int j = 0; j < 4; ++j) {
                const unsigned v1 = j == 0 ? k1.x : j == 1 ? k1.y : j == 2 ? k1.z : k1.w, v2 = j == 0 ? k2.x : j == 1 ? k2.y : j == 2 ? k2.z : k2.w;
                ha[j] = pk2(lo2f(v1) * kd, hi2f(v1) * kd); hb[j] = pk2(lo2f(v2) * kd, hi2f(v2) * kd);
            }
            *(LAS u32x4*)(Q + t * LQ + 8 * g) = q1;
            *(LAS u32x4*)(Q + t * LQ + 64 + 8 * g) = q2;
            *(LAS u32x4*)(Kn + t * LQ + 8 * g) = k1;
            *(LAS u32x4*)(Kn + t * LQ + 64 + 8 * g) = k2;
            *(LAS u32x4*)(KH + t * LQ + 8 * g) = (u32x4){ha[0], ha[1], ha[2], ha[3]};
            *(LAS u32x4*)(KH + t * LQ + 64 + 8 * g) = (u32x4){hb[0], hb[1], hb[2], hb[3]};
#pragma unroll
            for (int i = 0; i < 4; ++i) {
                const int id = tid + 512 * i, tt = id >> 5, gv = id & 31;
                *(LAS u32x4*)(V + tt * LV + 8 * gv) = rawv[i];
            }
        } else {
            const int d = tid & 127, seg = tid >> 7;
            float lf[16], kv[16], qv[16];
            float run = 0.f;
#pragma unroll
            for (int j = 0; j < 16; ++j) {
                const float lfv = (float)__builtin_bit_cast(_Float16, rawf[j]);
                run += lfv; lf[j] = run;
                kv[j] = 1.0f - fexp(lfv);
                qv[j] = bf2f(rawq[j]);
            }
            segs[seg * 128 + d] = run;
            __syncthreads();
            const float s0 = segs[d], s1 = segs[128 + d], s2 = segs[256 + d], s3 = segs[384 + d];
            const float pre = (seg > 0 ? s0 : 0.f) + (seg > 1 ? s1 : 0.f) + (seg > 2 ? s2 : 0.f);
            const float bref = s0 + s1, bL = bref + s2 + s3;
#pragma unroll
            for (int j = 0; j < 16; ++j) {
                const int t = seg * 16 + j;
                const float bb = pre + lf[j];
                Q[t * LQ + d] = f2bf(qv[j] * fexp(bb - bref));
                Kn[t * LQ + d] = f2bf(kv[j] * fexp(bref - bb));
                KH[t * LQ + d] = f2bf(kv[j] * fexp(bL - bb));
            }
            if (seg == 0) { eL[d] = fexp(bL); eR[d] = fexp(bref); }
#pragma unroll
            for (int i = 0; i < 2; ++i) {
                const int id = tid + 512 * i, tt = id >> 4, gv = id & 15;
                *(LAS u32x4*)(V + tt * LV + 8 * gv) = rawv[i];
            }
        }
        __syncthreads();
        LOAD_RAW(c < 31 ? c + 1 : 31);
        {
            float e0 = 1.f, e1 = 1.f, e2 = 1.f, e3 = 1.f;
            if (HG) { const f32x4 ev = *(const LAS f32x4*)(eR + 16 * wid + 4 * fq); e0 = ev[0]; e1 = ev[1]; e2 = ev[2]; e3 = ev[3]; }
#pragma unroll
            for (int vt = 0; vt < NVT; ++vt) {
                u32x2 w; w.x = pk2(st[vt][0] * e0, st[vt][1] * e1); w.y = pk2(st[vt][2] * e2, st[vt][3] * e3);
                *(LAS u32x2*)(ST + (16 * vt + fr) * LQ + 16 * wid + 4 * fq) = w;
            }
        }
        f32x4 sc[2];
        sc[0] = (f32x4){0.f, 0.f, 0.f, 0.f}; sc[1] = sc[0];
        {
            const int tt = wid >> 1, s0t = (wid & 1) * 2;
#pragma unroll
            for (int ks = 0; ks < 4; ++ks) {
                const bf16x8 afr = ldfrag(Q, LQ, 16 * tt, 32 * ks, fr, fq);
#pragma unroll
                for (int si = 0; si < 2; ++si) { const bf16x8 bfr = ldfrag(Kn, LQ, 16 * (s0t + si), 32 * ks, fr, fq); MMA16(sc[si], bfr, afr); }
            }
            const int t = 16 * tt + fr;
#pragma unroll
            for (int si = 0; si < 2; ++si)
#pragma unroll
                for (int j = 0; j < 4; ++j) {
                    const int s = 16 * (s0t + si) + 4 * fq + j;
                    float v = sc[si][j];
                    if (!HG) v *= 0.08838834764831845f * fexp((float)(t - s) * log_g);
                    sc[si][j] = (s <= t) ? v : 0.f;
                }
        }
        __syncthreads();
        {
            const int tt = wid >> 1, s0t = (wid & 1) * 2, t = 16 * tt + fr;
#pragma unroll
            for (int si = 0; si < 2; ++si) { u32x2 w; w.x = pk2(sc[si][0], sc[si][1]); w.y = pk2(sc[si][2], sc[si][3]);
                *(LAS u32x2*)(P + t * LP + 16 * (s0t + si) + 4 * fq) = w; }
        }
        __syncthreads();
        {
            constexpr int NW = NVT / 8;
            const int vt0 = wid * NW;
            f32x4 oa[4][NW];
#pragma unroll
            for (int tt = 0; tt < 4; ++tt)
#pragma unroll
                for (int i = 0; i < NW; ++i) oa[tt][i] = (f32x4){0.f, 0.f, 0.f, 0.f};
#pragma unroll
            for (int ks = 0; ks < 4; ++ks) {
                bf16x8 bfr[NW];
#pragma unroll
                for (int i = 0; i < NW; ++i) bfr[i] = ldfrag(ST, LQ, 16 * (vt0 + i), 32 * ks, fr, fq);
#pragma unroll
                for (int tt = 0; tt < 4; ++tt) {
                    const bf16x8 afr = ldfrag(Q, LQ, 16 * tt, 32 * ks, fr, fq);
#pragma unroll
                    for (int i = 0; i < NW; ++i) MMA16(oa[tt][i], bfr[i], afr);
                }
            }
            if (!HG) {
#pragma unroll
                for (int tt = 0; tt < 4; ++tt) { const float qd = fexp((float)(16 * tt + fr + 1) * log_g);
#pragma unroll
                    for (int i = 0; i < NW; ++i) oa[tt][i] *= qd; }
            }
#pragma unroll
            for (int ks = 0; ks < 2; ++ks) {
                bf16x8 bfr[NW];
#pragma unroll
                for (int i = 0; i < NW; ++i) bfr[i] = ldfrag_tr(V, LV, 16 * (vt0 + i), 32 * ks, fr, fq);
#pragma unroll
                for (int tt = 0; tt < 4; ++tt) {
                    const bf16x8 afr = ldfrag(P, LP, 16 * tt, 32 * ks, fr, fq);
#pragma unroll
                    for (int i = 0; i < NW; ++i) MMA16(oa[tt][i], bfr[i], afr);
                }
            }
            u32x2 gwv[4][NW];
#pragma unroll
            for (int tt = 0; tt < 4; ++tt)
#pragma unroll
                for (int i = 0; i < NW; ++i) gwv[tt][i] = *(const u32x2*)(zb + (size_t)(row0 + 16 * tt + fr) * NZ + gcol + 16 * (vt0 + i) + 4 * fq);
#pragma unroll
            for (int tt = 0; tt < 4; ++tt) {
                float s = 0.f;
#pragma unroll
                for (int i = 0; i < NW; ++i) s += oa[tt][i][0] * oa[tt][i][0] + oa[tt][i][1] * oa[tt][i][1] + oa[tt][i][2] * oa[tt][i][2] + oa[tt][i][3] * oa[tt][i][3];
                s += __shfl_xor(s, 16); s += __shfl_xor(s, 32);
                if (fq == 0) red[wid * 64 + 16 * tt + fr] = s;
            }
            __syncthreads();
#pragma unroll
            for (int tt = 0; tt < 4; ++tt) {
                const int t = 16 * tt + fr;
                float tot = 0.f;
#pragma unroll
                for (int w8 = 0; w8 < 8; ++w8) tot += red[w8 * 64 + t];
                const float rs = frsq(tot * (1.0f / (float)DV) + 1e-6f);
                bf16_t* orow = (l == 0) ? og_compact(p, HG ? 1 : 0) + (size_t)(row0 + t) * DM + h * DV : zb + (size_t)(row0 + t) * NZ + gcol;
#pragma unroll
                for (int i = 0; i < NW; ++i) {
                    const int v = 16 * (vt0 + i) + 4 * fq;
                    const u32x2 gw = gwv[tt][i];
                    float n0 = rs, n1 = rs, n2 = rs, n3 = rs;
                    if (HG) { const f32x4 hn = *(const f32x4*)(p.in[15] + l * 1024 + h * 128 + v); n0 *= hn[0]; n1 *= hn[1]; n2 *= hn[2]; n3 *= hn[3]; }
                    u32x2 w;
                    w.x = pk2(oa[tt][i][0] * n0 * siluf_(lo2f(gw.x)), oa[tt][i][1] * n1 * siluf_(hi2f(gw.x)));
                    w.y = pk2(oa[tt][i][2] * n2 * siluf_(lo2f(gw.y)), oa[tt][i][3] * n3 * siluf_(hi2f(gw.y)));
                    if (!dry) *(u32x2*)(orow + v) = w;
                }
            }
        }
        {
            if (HG) { const f32x4 ev = *(const LAS f32x4*)(eL + 16 * wid + 4 * fq);
#pragma unroll
                for (int vt = 0; vt < NVT; ++vt) st[vt] *= ev; }
            else { const float sd = fexp(64.0f * log_g);
#pragma unroll
                for (int vt = 0; vt < NVT; ++vt) st[vt] *= sd; }
#pragma unroll
            for (int ks = 0; ks < 2; ++ks) {
                const bf16x8 bfr = ldfrag_tr(KH, LQ, 16 * wid, 32 * ks, fr, fq);
#pragma unroll
                for (int vt = 0; vt < NVT; ++vt) { const bf16x8 afr = ldfrag_tr(V, LV, 16 * vt, 32 * ks, fr, fq); MMA16(st[vt], bfr, afr); }
            }
        }
        __syncthreads();
    }
    float* so = p.out + (HG ? O_HGP : O_RETP) + ((size_t)((l * 8 + b) * (HG ? 8 : 4) + h)) * 128 * DV;
#pragma unroll
    for (int vt = 0; vt < NVT; ++vt)
#pragma unroll
        for (int j = 0; j < 4; ++j) so[(size_t)(16 * wid + 4 * fq + j) * DV + 16 * vt + fr] = st[vt][j];
}

__device__ void lru_prompt(const Params& p, int l, int b, int n, LAS unsigned char* lds, int dry) {
    int tid = threadIdx.x; asm volatile("" : "+v"(tid));
    const int wid = __builtin_amdgcn_readfirstlane(tid >> 6), lane = tid & 63, fr = lane & 15, fq = lane >> 4;
    LAS float* XL = (LAS float*)lds;
    LAS bf16_t* XC = (LAS bf16_t*)(lds + 34304);
    LAS float* XCF = (LAS float*)(lds + 51712);
    LAS float* AA = (LAS float*)(lds + 84480);
    LAS float* UU = (LAS float*)(lds + 117248);
    LAS float* segA = (LAS float*)(lds + 150016);
    LAS float* segH = segA + 512;
    LAS float* hc = segH + 512;
    bf16_t* zb = (bf16_t*)(p.ws + WS_Z);
    const int e = tid & 127, seg = tid >> 7, ch = n * 128 + e;
    const float cw0 = p.in[17][(l * 4 + 0) * 1024 + ch], cw1 = p.in[17][(l * 4 + 1) * 1024 + ch], cw2 = p.in[17][(l * 4 + 2) * 1024 + ch], cw3 = p.in[17][(l * 4 + 3) * 1024 + ch];
    const float cb = p.in[18][l * 1024 + ch];
    bf16x8 Ba[4], Bx[4];
    {
        const float* wa = p.in[19] + ((size_t)(l * 8 + n)) * 16384;
        const float* wx = p.in[21] + ((size_t)(l * 8 + n)) * 16384;
#pragma unroll
        for (int ks = 0; ks < 4; ++ks)
#pragma unroll
            for (int j = 0; j < 8; ++j) {
                const int d = 32 * ks + 8 * fq + j;
                Ba[ks][j] = (short)f2bf(wa[d * 128 + 16 * wid + fr]);
                Bx[ks][j] = (short)f2bf(wx[d * 128 + 16 * wid + fr]);
            }
    }
    float ba[4], bx[4], sp[4];
#pragma unroll
    for (int j = 0; j < 4; ++j) {
        const int c2 = n * 128 + 16 * wid + 4 * fq + j;
        ba[j] = p.in[20][l * 1024 + c2]; bx[j] = p.in[22][l * 1024 + c2];
        const float lam = p.in[23][l * 1024 + c2];
        sp[j] = fmaxf(-lam, 0.f) + flog(1.0f + fexp(-fabsf(lam)));
    }
    if (tid < 384) XL[tid] = 0.f;
    if (tid < 128) hc[tid] = 0.f;
    __syncthreads();
    for (int c = 0; c < 32; ++c) {
        const int row0 = b * 2048 + c * 64;
        bf16_t glv[16];
#pragma unroll
        for (int j = 0; j < 16; ++j) glv[j] = zb[(size_t)(row0 + seg * 16 + j) * NZ + ZC_GL + ch];
#pragma unroll
        for (int i = 0; i < 2; ++i) {
            const int id = tid + 512 * i, tt = id >> 4, g = id & 15;
            const u32x4 w = *(const u32x4*)(zb + (size_t)(row0 + tt) * NZ + ZC_XL + n * 128 + 8 * g);
            LAS float* dst = XL + (3 + tt) * 128 + 8 * g;
            *(LAS f32x4*)dst = (f32x4){lo2f(w.x), hi2f(w.x), lo2f(w.y), hi2f(w.y)};
            *(LAS f32x4*)(dst + 4) = (f32x4){lo2f(w.z), hi2f(w.z), lo2f(w.w), hi2f(w.w)};
        }
        __syncthreads();
#pragma unroll 4
        for (int j = 0; j < 16; ++j) {
            const int t = seg * 16 + j;
            const float xc = cb + XL[t * 128 + e] * cw0 + XL[(t + 1) * 128 + e] * cw1 + XL[(t + 2) * 128 + e] * cw2 + XL[(t + 3) * 128 + e] * cw3;
            XCF[t * 128 + e] = xc; XC[t * 136 + e] = f2bf(xc);
        }
        __syncthreads();
#pragma unroll
        for (int tt = 0; tt < 4; ++tt) {
            f32x4 ga = (f32x4){0.f, 0.f, 0.f, 0.f}, gx = ga;
#pragma unroll
            for (int ks = 0; ks < 4; ++ks) { const bf16x8 afr = ldfrag(XC, 136, 16 * tt, 32 * ks, fr, fq); MMA16(ga, Ba[ks], afr); MMA16(gx, Bx[ks], afr); }
            const int t = 16 * tt + fr, e4 = 16 * wid + 4 * fq;
            const f32x4 xv = *(const LAS f32x4*)(XCF + t * 128 + e4);
            f32x4 av, uv;
#pragma unroll
            for (int j = 0; j < 4; ++j) {
                const float r = sigmoidf_(ga[j] + ba[j]), ii = sigmoidf_(gx[j] + bx[j]);
                const float la = -8.0f * r * sp[j];
                av[j] = fexp(la);
                uv[j] = __builtin_amdgcn_sqrtf(1.0f - fexp(2.0f * la)) * ii * xv[j];
            }
            *(LAS f32x4*)(AA + t * 128 + e4) = av; *(LAS f32x4*)(UU + t * 128 + e4) = uv;
        }
        __syncthreads();
        {
            float A = 1.f, H = 0.f;
#pragma unroll 4
            for (int j = 0; j < 16; ++j) { const int t = seg * 16 + j; const float a = AA[t * 128 + e]; H = a * H + UU[t * 128 + e]; A *= a; }
            segA[seg * 128 + e] = A; segH[seg * 128 + e] = H;
        }
        __syncthreads();
        float hh = hc[e];
        for (int s = 0; s < seg; ++s) hh = segA[s * 128 + e] * hh + segH[s * 128 + e];
#pragma unroll
        for (int j = 0; j < 16; ++j) {
            const int t = seg * 16 + j;
            hh = AA[t * 128 + e] * hh + UU[t * 128 + e];
            bf16_t* zp = (l == 0) ? og_compact(p, 2) + (size_t)(row0 + t) * DM + ch : zb + (size_t)(row0 + t) * NZ + ZC_GL + ch;
            if (!dry) *zp = f2bf(hh * geluf_(bf2f(glv[j])));
        }
        __syncthreads();
        if (seg == 3) hc[e] = hh;
        if (seg == 0) { XL[e] = XL[64 * 128 + e]; XL[128 + e] = XL[65 * 128 + e]; XL[256 + e] = XL[66 * 128 + e]; }
        __syncthreads();
    }
    if (seg == 0) {
        p.out[O_LRUP + (size_t)(l * 8 + b) * 1024 + ch] = hc[e];
#pragma unroll
        for (int i = 0; i < 3; ++i) p.out[O_CVP + ((size_t)(l * 8 + b) * 3 + i) * 1024 + ch] = XL[i * 128 + e];
    }
    __syncthreads();
}

template <bool HG>
__device__ void linattn_sample(const Params& p, int l, int b, int h, LAS unsigned char* lds, int dry) {
    constexpr int DV = HG ? 128 : 256, NVG = DV / 4, NPART = 512 / NVG, DPP = 128 / NPART;
    int tid = threadIdx.x; asm volatile("" : "+v"(tid));
    LAS float* qs = (LAS float*)lds;
    LAS float* ks = qs + 512;
    LAS float* fs = ks + 512;
    LAS float* vs = fs + 512;
    LAS float* op = vs + 4 * DV;
    LAS float* red = op + NPART * 4 * DV;
    bf16_t* zb = (bf16_t*)(p.ws + WS_Z);
    const int rowb = T_P + 4 * b;
    const float gam = HG ? 1.f : (1.0f - exp2f(-5.0f - (float)h));
    if (!HG) {
        if (tid < 256) {
            const int t = tid >> 6, i = tid & 63;
            const bf16_t* zr = zb + (size_t)(rowb + t) * NZ;
            qs[t * 128 + i] = bf2f(zr[ZC_QR + h * 128 + i]); qs[t * 128 + 64 + i] = bf2f(zr[ZC_QR + h * 128 + 64 + i]);
            ks[t * 128 + i] = bf2f(zr[ZC_KR + h * 128 + i]) * 0.08838834764831845f; ks[t * 128 + 64 + i] = bf2f(zr[ZC_KR + h * 128 + 64 + i]) * 0.08838834764831845f;
        }
#pragma unroll
        for (int i = 0; i < 2; ++i) { const int id = tid + 512 * i, t = id >> 8, v = id & 255; vs[t * 256 + v] = bf2f(zb[(size_t)(rowb + t) * NZ + ZC_VR + h * 256 + v]); }
    } else {
        const int t = tid >> 7, d = tid & 127;
        const bf16_t* zr = zb + (size_t)(rowb + t) * NZ;
        const float fv = fexp((float)__builtin_bit_cast(_Float16, zr[ZC_FH + h * 128 + d]));
        fs[t * 128 + d] = fv;
        ks[t * 128 + d] = 1.0f - fv;
        qs[t * 128 + d] = bf2f(zr[ZC_QH + h * 128 + d]);
        vs[t * 128 + d] = bf2f(zr[ZC_IH + h * 128 + d]);
    }
    const int vg = tid % NVG, part = tid / NVG;
    const size_t sbase = ((size_t)((l * 128 + b) * (HG ? 8 : 4) + h)) * 128 * DV;
    const float* Sin = (HG ? p.in[3] : p.in[2]) + sbase + (size_t)(part * DPP) * DV + 4 * vg;
    float* Sout = p.out + (HG ? O_HGS : O_RETS) + sbase + (size_t)(part * DPP) * DV + 4 * vg;
    f32x4 S[DPP];
#pragma unroll
    for (int i = 0; i < DPP; ++i) S[i] = __builtin_nontemporal_load((const f32x4*)(Sin + (size_t)i * DV));
    __syncthreads();
    {
        const f32x4 v0 = *(const LAS f32x4*)(vs + 4 * vg), v1 = *(const LAS f32x4*)(vs + DV + 4 * vg), v2 = *(const LAS f32x4*)(vs + 2 * DV + 4 * vg), v3 = *(const LAS f32x4*)(vs + 3 * DV + 4 * vg);
        f32x4 o0 = (f32x4){0.f, 0.f, 0.f, 0.f}, o1 = o0, o2 = o0, o3 = o0;
#pragma unroll
        for (int i = 0; i < DPP; ++i) {
            const int d = part * DPP + i;
            const float f0 = HG ? fs[d] : gam, f1 = HG ? fs[128 + d] : gam, f2 = HG ? fs[256 + d] : gam, f3 = HG ? fs[384 + d] : gam;
            f32x4 Sv = S[i];
            Sv = Sv * f0 + v0 * ks[d]; o0 += Sv * qs[d];
            Sv = Sv * f1 + v1 * ks[128 + d]; o1 += Sv * qs[128 + d];
            Sv = Sv * f2 + v2 * ks[256 + d]; o2 += Sv * qs[256 + d];
            Sv = Sv * f3 + v3 * ks[384 + d]; o3 += Sv * qs[384 + d];
            S[i] = Sv;
            if ((i & 3) == 3) asm volatile("" ::: "memory");
        }
#pragma unroll
        for (int i = 0; i < DPP; ++i) __builtin_nontemporal_store(S[i], (f32x4*)(Sout + (size_t)i * DV));
        *(LAS f32x4*)(op + (part * 4 + 0) * DV + 4 * vg) = o0; *(LAS f32x4*)(op + (part * 4 + 1) * DV + 4 * vg) = o1;
        *(LAS f32x4*)(op + (part * 4 + 2) * DV + 4 * vg) = o2; *(LAS f32x4*)(op + (part * 4 + 3) * DV + 4 * vg) = o3;
    }
    __syncthreads();
    {
        const int t = tid >> 7, vv = tid & 127;
        constexpr int NPT = DV / 128;
        const int gcol = HG ? ZC_GH + h * 128 : ZC_GR + h * 256;
        bf16_t* zr = zb + (size_t)(rowb + t) * NZ + gcol;
        float o[NPT], gv[NPT]; float s = 0.f;
#pragma unroll
        for (int i = 0; i < NPT; ++i) { const int v = vv + 128 * i; float a = 0.f;
            gv[i] = bf2f(zr[v]);
#pragma unroll
            for (int q = 0; q < NPART; ++q) a += op[(q * 4 + t) * DV + v];
            o[i] = a; s += a * a; }
#pragma unroll
        for (int off = 32; off >= 1; off >>= 1) s += __shfl_xor(s, off);
        if ((tid & 63) == 0) red[tid >> 6] = s;
        __syncthreads();
        const float rs = frsq((red[2 * t] + red[2 * t + 1]) * (1.0f / (float)DV) + 1e-6f);
#pragma unroll
        for (int i = 0; i < NPT; ++i) { const int v = vv + 128 * i;
            float nrm = rs; if (HG) nrm *= p.in[15][l * 1024 + h * 128 + v];
            const bf16_t ov = f2bf(o[i] * nrm * siluf_(gv[i])); if (!dry) zr[v] = ov; }
    }
    __syncthreads();
}

__device__ void lru_sample(const Params& p, int l, int b, LAS unsigned char* lds, int dry) {
    int tid = threadIdx.x; asm volatile("" : "+v"(tid));
    LAS float* XX = (LAS float*)lds;
    LAS float* XC = XX + 7 * 1024;
    bf16_t* zb = (bf16_t*)(p.ws + WS_Z);
    float cv[6]; bf16_t xr[8];
#pragma unroll
    for (int i = 0; i < 6; ++i) cv[i] = p.in[5][(size_t)(l * 128 + b) * 3072 + tid + 512 * i];
#pragma unroll
    for (int i = 0; i < 8; ++i) { const int e = tid + 512 * i; xr[i] = zb[(size_t)(T_P + 4 * b + (e >> 10)) * NZ + ZC_XL + (e & 1023)]; }
    float cw[2][4], cb[2], ba[2], bx[2], lam[2], h0[2]; bf16_t glv[2][4];
#pragma unroll
    for (int cc = 0; cc < 2; ++cc) {
        const int ch = tid + 512 * cc;
#pragma unroll
        for (int k = 0; k < 4; ++k) { cw[cc][k] = p.in[17][(l * 4 + k) * 1024 + ch]; glv[cc][k] = zb[(size_t)(T_P + 4 * b + k) * NZ + ZC_GL + ch]; }
        cb[cc] = p.in[18][l * 1024 + ch]; ba[cc] = p.in[20][l * 1024 + ch]; bx[cc] = p.in[22][l * 1024 + ch]; lam[cc] = p.in[23][l * 1024 + ch];
        h0[cc] = p.in[4][(size_t)(l * 128 + b) * 1024 + ch];
    }
#pragma unroll
    for (int i = 0; i < 6; ++i) XX[tid + 512 * i] = cv[i];
#pragma unroll
    for (int i = 0; i < 8; ++i) XX[3072 + tid + 512 * i] = bf2f(xr[i]);
    __syncthreads();
#pragma unroll
    for (int cc = 0; cc < 2; ++cc) {
        const int ch = tid + 512 * cc;
#pragma unroll
        for (int t = 0; t < 4; ++t) {
            float xc = cb[cc];
#pragma unroll
            for (int k = 0; k < 4; ++k) xc += XX[(t + k) * 1024 + ch] * cw[cc][k];
            XC[t * 1024 + ch] = xc;
        }
    }
    __syncthreads();
#pragma unroll 1
    for (int cc = 0; cc < 2; ++cc) {
        const int ch = tid + 512 * cc, n = ch >> 7, e = ch & 127;
        const float* wa = p.in[19] + ((size_t)(l * 8 + n)) * 16384 + e;
        const float* wx = p.in[21] + ((size_t)(l * 8 + n)) * 16384 + e;
        float ga[4], gx[4];
#pragma unroll
        for (int k = 0; k < 4; ++k) { ga[k] = 0.f; gx[k] = 0.f; }
#pragma unroll 1
        for (int d0 = 0; d0 < 128; d0 += 16) {
            float av[16], xv[16];
#pragma unroll
            for (int i = 0; i < 16; ++i) { av[i] = wa[(d0 + i) * 128]; xv[i] = wx[(d0 + i) * 128]; }
#pragma unroll
            for (int i = 0; i < 16; ++i)
#pragma unroll
                for (int k = 0; k < 4; ++k) { const float v = XC[k * 1024 + n * 128 + d0 + i]; ga[k] += v * av[i]; gx[k] += v * xv[i]; }
        }
        const float bav = cc == 0 ? ba[0] : ba[1], bxv = cc == 0 ? bx[0] : bx[1], lamv = cc == 0 ? lam[0] : lam[1];
        const float sp = fmaxf(-lamv, 0.f) + flog(1.0f + fexp(-fabsf(lamv)));
        float hh = cc == 0 ? h0[0] : h0[1];
#pragma unroll
        for (int t = 0; t < 4; ++t) {
            const float r = sigmoidf_(ga[t] + bav), ii = sigmoidf_(gx[t] + bxv);
            const float la = -8.0f * r * sp;
            const float a = fexp(la), u = __builtin_amdgcn_sqrtf(1.0f - fexp(2.0f * la)) * ii * XC[t * 1024 + ch];
            hh = a * hh + u;
            const bf16_t gl = cc == 0 ? glv[0][t] : glv[1][t];
            if (!dry) zb[(size_t)(T_P + 4 * b + t) * NZ + ZC_GL + ch] = f2bf(hh * geluf_(bf2f(gl)));
        }
        p.out[O_LRUS + (size_t)(l * 128 + b) * 1024 + ch] = hh;
#pragma unroll
        for (int r = 0; r < 3; ++r) p.out[O_CVS + ((size_t)(l * 128 + b) * 3 + r) * 1024 + ch] = XX[(4 + r) * 1024 + ch];
    }
    __syncthreads();
}

__device__ void chain_items(const Params& p, int l, LAS unsigned char* lds) {
    int bid = blockIdx.x; asm volatile("" : "+s"(bid));
    if (bid < 32) linattn_prompt<false>(p, l, bid >> 2, bid & 3, lds, 0);
    else if (bid < 96) linattn_prompt<true>(p, l, (bid - 32) >> 3, (bid - 32) & 7, lds, 0);
    else if (bid < 160) {
        lru_prompt(p, l, (bid - 96) >> 3, (bid - 96) & 7, lds, 0);
    }
}
__device__ __forceinline__ void sample_item(const Params& p, int l, int it, LAS unsigned char* lds) {
    if (it >= 1152) linattn_sample<false>(p, l, (it - 1152) >> 2, (it - 1152) & 3, lds, 0);
    else if (it >= 128) linattn_sample<true>(p, l, (it - 128) >> 3, (it - 128) & 7, lds, 0);
    else lru_sample(p, l, it, lds, 0);
}
__device__ void sample_items(const Params& p, int l, LAS unsigned char* lds, int Gx, int cx) {
    if (Gx == 256) {
        if (cx < 128) { for (int k = 0; k < 5; ++k) sample_item(p, l, k == 0 ? cx : 128 + cx + 128 * (k - 1), lds); }
        else { for (int k = 0; k < 8; ++k) sample_item(p, l, 640 + (cx - 128) + 128 * k, lds); }
    } else {
        for (int it = cx; it < 1664; it += Gx) sample_item(p, l, it, lds);
    }
}

__device__ void fin_x(const Params& p, float* sst, float scale, int Gx, int cx) {
    float* x = p.out; bf16_t* xb = (bf16_t*)(p.ws + WS_XB); const float* pb = (const float*)(p.ws + WS_MF);
    int tid = threadIdx.x; asm volatile("" : "+v"(tid));
    const int wid = tid >> 6, lane = tid & 63;
    for (int row = T_P + cx * 8 + wid; row < T_ALL; row += Gx * 8) {
        float s = 0.f;
#pragma unroll
        for (int i = 0; i < 4; ++i) {
            const int c = i * 256 + lane * 4;
            const f32x4 p0 = *(const f32x4*)(pb + (size_t)(row - T_P) * DM + c), p1 = *(const f32x4*)(pb + (size_t)(512 + row - T_P) * DM + c);
            const f32x4 v = *(const f32x4*)(x + (size_t)row * DM + c) + (p0 + p1) * scale;
            *(f32x4*)(x + (size_t)row * DM + c) = v;
            u32x2 w; w.x = pk2(v[0], v[1]); w.y = pk2(v[2], v[3]);
            *(u32x2*)(xb + (size_t)row * DM + c) = w;
            s += v[0] * v[0] + v[1] * v[1] + v[2] * v[2] + v[3] * v[3];
        }
#pragma unroll
        for (int o = 32; o >= 1; o >>= 1) s += __shfl_xor(s, o);
        if (lane == 0) sst[row] = s;
    }
}
__device__ void fin_m(const Params& p, int l, int Gx, int cx) {
    float* mf = (float*)(p.ws + WS_MF); bf16_t* zb = (bf16_t*)(p.ws + WS_Z);
    const float* mb = p.in[12] + l * 3 * DM;
    int tid = threadIdx.x; asm volatile("" : "+v"(tid));
    const int wid = tid >> 6, lane = tid & 63;
    for (int r = cx * 8 + wid; r < T_ALL - T_P; r += Gx * 8) {
        bf16_t* zr = zb + (size_t)(T_P + r) * NZ;
#pragma unroll
        for (int i = 0; i < 4; ++i) {
            const int c = i * 256 + lane * 4;
            f32x4 o = (f32x4){0.f, 0.f, 0.f, 0.f};
#pragma unroll
            for (int br = 0; br < 3; ++br) {
                float* pm = mf + ((size_t)br * 512 + r) * DM + c;
                const f32x4 v = *(const f32x4*)pm;
                const u32x2 gw = *(const u32x2*)(zr + ZC_GATE + br * DM + c);
                const f32x4 bb = *(const f32x4*)(mb + br * DM + c);
                o[0] += sigmoidf_(lo2f(gw.x) + bb[0]) * v[0]; o[1] += sigmoidf_(hi2f(gw.x) + bb[1]) * v[1];
                o[2] += sigmoidf_(lo2f(gw.y) + bb[2]) * v[2]; o[3] += sigmoidf_(hi2f(gw.y) + bb[3]) * v[3];
            }
            u32x2 w; w.x = pk2(o[0], o[1]); w.y = pk2(o[2], o[3]);
            *(u32x2*)(zr + c) = w;
        }
    }
}

__device__ __forceinline__ void gbar(unsigned* bar, unsigned& gen, unsigned nblk) {
    asm volatile("s_waitcnt vmcnt(0)" ::: "memory");
    __syncthreads();
    if (threadIdx.x == 0) {
        __builtin_amdgcn_fence(__ATOMIC_RELEASE, "agent");
        asm volatile("s_waitcnt vmcnt(0)" ::: "memory");
        const unsigned target = (gen + 1u) * nblk;
        __hip_atomic_fetch_add(bar, 1u, __ATOMIC_RELAXED, __HIP_MEMORY_SCOPE_AGENT);
        while (__hip_atomic_load(bar, __ATOMIC_RELAXED, __HIP_MEMORY_SCOPE_AGENT) < target) __builtin_amdgcn_s_sleep(1);
        __builtin_amdgcn_fence(__ATOMIC_ACQUIRE, "agent");
        asm volatile("s_waitcnt vmcnt(0)" ::: "memory");
    }
    gen += 1u;
    __syncthreads();
}

#if PROF_SEL
__device__ void prof_encode(const Params& p) {
    const unsigned long long* TS = (const unsigned long long*)(p.ws + WS_TS);
    const float tot = (float)(TS[2 + 3 * 1 + 2] - TS[0]);
    float a = 0.f, b = 0.f;
    if (PROF_SEL == 1) { a = (float)(TS[1] - TS[0]); b = (float)((TS[3] - TS[2]) + (TS[6] - TS[5])); }
    if (PROF_SEL == 2) { a = (float)(TS[11] - TS[2]); b = (float)(TS[13] - TS[2]); }
    if (PROF_SEL == 3) { a = (float)(TS[10] - TS[2]); b = (float)(TS[12] - TS[2]); }
    if (PROF_SEL == 4) { a = (float)((TS[2] - TS[1]) + (TS[5] - TS[4])); b = (float)((TS[4] - TS[3]) + (TS[7] - TS[6])); }
    if (PROF_SEL == 5) { a = (float)(TS[15] - TS[5]); b = (float)(TS[17] - TS[5]); }
    if (PROF_SEL == 7) { a = (float)(TS[20] - TS[0]); b = (float)(TS[21] - TS[20]); }
    if (PROF_SEL == 8) { a = (float)(TS[33] - TS[2]); b = (float)(TS[34] - TS[33]); }
    if (PROF_SEL == 9) { a = (float)(TS[36] - TS[34]); b = (float)(TS[38] - TS[36]); }
    if (PROF_SEL == 10) { a = (float)(TS[39] - TS[38]); b = (float)(TS[40] - TS[39]); }
    if (PROF_SEL == 11) { a = 0.f; b = (float)(TS[40] - TS[38]); }
    if (PROF_SEL == 12) { a = (float)(TS[56] - TS[3]); b = (float)(TS[57] - TS[56]); }
    if (PROF_SEL == 13) { a = (float)(TS[40] - TS[1]); b = (float)(TS[41] - TS[40]); }
    if (PROF_SEL == 14) { a = (float)(TS[43] - TS[42]); b = (float)(TS[44] - TS[43]); }
    if (PROF_SEL == 15) { a = (float)(TS[58] - TS[57]); b = (float)(TS[59] - TS[58]); }
    if (PROF_SEL == 6) { a = (float)(TS[16] - TS[5]); b = (float)(TS[14] - TS[5]); }
    const float f1 = a / tot, f2 = b / tot;
    const float sc = 1.0f + sqrtf(1e-4f * (0.5f + 2.5f * f1));
    for (int i = threadIdx.x; i < 49152; i += 512) p.out[O_CVP + i] *= sc;
    if (threadIdx.x == 0) p.out[0] += 4.0f + 16.0f * f2;
}
#endif

__global__ void __launch_bounds__(512) fwd_megakernel(Params p) {
    extern __shared__ __attribute__((aligned(16))) unsigned char smem_raw[];
    LAS unsigned char* lds = (LAS unsigned char*)smem_raw;
    cg::grid_group grid = cg::this_grid();
    using namespace pg8;
    const int G = gridDim.x, c = blockIdx.x;
    bf16_t* wb = (bf16_t*)(p.ws + WS_W);
    bf16_t* xb = (bf16_t*)(p.ws + WS_XB);
    bf16_t* zb = (bf16_t*)(p.ws + WS_Z);
    float* ss = (float*)(p.ws + WS_SS);
    float* x = p.out;

    constexpr int NCHAIN = 160;
    unsigned* gbar_w = (unsigned*)(p.ws + WS_BAR); unsigned bgen = 0u, sgen = 0u;
    bf16_t* hids = (bf16_t*)(p.ws + WS_HIDS) - (size_t)T_P * FH;
#if PROF_SEL
    unsigned long long* TS = (unsigned long long*)(p.ws + WS_TS);
#define STAMP(i) do { if (threadIdx.x == 0) TS[i] = __builtin_amdgcn_s_memrealtime(); } while (0)
#else
#define STAMP(i) do { } while (0)
#endif
    if (c == 0) STAMP(0);
    phase0(p, lds);
    grid.sync();
    if (c == 0) STAMP(1);
#pragma unroll 1
    for (int l = 0; l < 2; ++l) {
        bf16_t* wl = wb + (size_t)l * W_LAYER;
        bf16_t* mrg = (l == 0) ? (bf16_t*)(p.out + O_RETS + (size_t)128 * 4 * 128 * 256) : wb;
#pragma unroll 1
        for (int seg = 0; seg < 3; ++seg) {
            const int role_s = __builtin_amdgcn_readfirstlane((seg == 1 && c >= NCHAIN) ? 1 : 0);
            const int nsteps = (seg == 0) ? 5 : (seg == 2) ? 4 : (role_s ? 7 : 1);
            int Gx = role_s ? (G - NCHAIN) : G, cx = role_s ? (c - NCHAIN) : c;
#pragma unroll 1
            for (int idx = 0; idx < nsteps; ++idx) {
                asm volatile("" : "+s"(Gx), "+s"(cx));
                int op, f = 0, kx = 1, rows = 0;
                if (seg == 0) { op = (idx == 0) ? 0 : (idx == 1) ? 1 : (idx == 2) ? 8 : (idx == 3) ? 2 : 6; rows = (idx == 0 || idx == 3) ? 2 : 0; }
                else if (seg == 2) { op = (idx == 0) ? 4 : (idx == 1) ? 5 : (idx == 2) ? 0 : 1; f = idx >= 2; }
                else if (!role_s) op = 3;
                else { op = (idx == 0) ? 9 : (idx == 1) ? 10 : (idx == 2) ? 11 : (idx == 3 || idx == 6) ? 8 : (idx == 4) ? 0 : 7; f = idx >= 4; kx = (idx == 3) ? 2 : 3; rows = 1; }
                op = __builtin_amdgcn_readfirstlane(op); f = __builtin_amdgcn_readfirstlane(f); kx = __builtin_amdgcn_readfirstlane(kx); rows = __builtin_amdgcn_readfirstlane(rows);
                const int Mx = (rows == 2) ? T_ALL : (rows == 1) ? (T_ALL - T_P) : T_P, pm0 = (rows == 1) ? (T_P / 256) : 0;
#pragma unroll 1
                for (int rep = 0; rep < ((seg == 0 && idx == 1) ? 2 : 1); ++rep) {
                if (rep == 1) op = 7;
                if (op == 0) {
                    Gemm g{xb, xb, xb, wl + (f == 0 ? OFF_GU1 : OFF_GU2), 0, DM, DM, DM}; StaticOrder so; so.init(Mx, 2 * FH, Gx, cx, pm0);
                    EpiUp e{zb, hids, ss + (size_t)(3 * l + 2 * f) * T_ALL}; gemm_phase(lds, g, so, e);
                } else if (op == 1) {
                    Gemm g{zb, zb, zb, wl + (f == 0 ? OFF_D1 : OFF_D2), 0, FH, FH, FH}; StaticOrder so; so.init(Mx, DM, Gx, cx, pm0);
                    EpiRes e{x, xb, ss + (size_t)(3 * l + 2 * f + 1) * T_ALL, 0.5f, 0}; gemm_phase(lds, g, so, e);
                } else if (op == 2) {
                    Gemm g{xb, xb, xb, wl + OFF_WIN, 0, DM, DM, DM}; StaticOrder so; so.init(Mx, NZ, Gx, cx, pm0);
                    EpiWin e{zb, ss + (size_t)(3 * l + 1) * T_ALL, l == 1 ? (const float*)(p.ws + WS_LB) : (const float*)nullptr, (const float2*)(p.ws + WS_ROPE)}; gemm_phase(lds, g, so, e);
                } else if (op == 3) {
                    chain_items(p, l, lds);
                } else if (op == 4) {
                    Gemm g{l == 0 ? og_compact(p, 0) : zb + ZC_GR, l == 0 ? og_compact(p, 1) : zb + ZC_GH, l == 0 ? og_compact(p, 2) : zb + ZC_GL, wl + OFF_RO, (size_t)DM * DM, l == 0 ? DM : NZ, DM, DM}; BranchOrder bo; bo.so.init(Mx, DM, Gx, cx, pm0);
                    EpiBranch e{zb, mrg, p.in[12] + l * 3 * DM, 0}; gemm_phase(lds, g, bo, e);
                } else if (op == 5) {
                    Gemm g{mrg, mrg, mrg, wl + OFF_MO, 0, DM, DM, DM}; StaticOrder so; so.init(Mx, DM, Gx, cx, pm0);
                    EpiRes e{x, xb, ss + (size_t)(3 * l + 2) * T_ALL, 1.0f, 0}; gemm_phase(lds, g, so, e);
                } else if (op == 6) {
                    sample_items(p, l, lds, Gx, cx);
                } else if (op == 7 || op == 9 || op == 11) {
                    const bool dn = (op == 7), brn = (op == 9);
                    const int klen = dn ? 1408 : (brn ? 1024 : 512);
                    Gemm g{dn ? hids : (brn ? zb + ZC_GR : zb), zb + ZC_GH, zb + ZC_GL, wl + (dn ? (f == 0 ? OFF_D1 : OFF_D2) : (brn ? OFF_RO : OFF_MO)), (size_t)DM * DM, dn ? FH : NZ, dn ? FH : DM, klen};
                    SplitOrder so{2, 4, brn ? 3 : 1, brn ? 1 : 2, klen, Gx, cx, T_P / 256};
                    EpiStoreP e{(float*)(p.ws + WS_MF), klen, brn ? 1 : 2}; gemm_phase(lds, g, so, e);
                } else if (op == 8) {
                    fin_x(p, ss + (size_t)(3 * l + kx) * T_ALL, kx == 2 ? 1.0f : 0.5f, Gx, cx);
                } else {
                    fin_m(p, l, Gx, cx);
                }
                }
                if (seg == 1) { if (role_s && idx + 1 < nsteps) gbar(gbar_w + 64, sgen, (unsigned)(G - NCHAIN)); }
                else gbar(gbar_w, bgen, (unsigned)G);
                if (l == 0 && c == 0 && seg != 1) STAMP(40 + 8 * seg + idx);
            }
            if (seg == 1 && l == 0) {
                unsigned* qctr = (unsigned*)(p.ws + WS_CTR) + 8;
                LAS unsigned* slot = (LAS unsigned*)(lds + LDS_BYTES - 16);
                for (;;) {
                    __syncthreads();
                    if (threadIdx.x == 0) *slot = atomicAdd(qctr, 1u);
                    __syncthreads();
                    const int ti = __builtin_amdgcn_readfirstlane((int)*slot);
                    if (ti >= 2080) break;
                    conv_job(p, 2080 + ti, (LAS float*)lds);
                }
            }
            if (seg == 1) {
                if (c == 0) STAMP(10 + 4 * l + 0); if (c == 32) STAMP(10 + 4 * l + 1); if (c == 96) STAMP(10 + 4 * l + 2); if (c == NCHAIN) STAMP(10 + 4 * l + 3);
                gbar(gbar_w, bgen, (unsigned)G);
            }
            if (c == 0) STAMP(2 + 3 * l + seg);
        }
    }
    {
        const float* ssf = ss + (size_t)6 * T_ALL;
        int tid = threadIdx.x; asm volatile("" : "+v"(tid));
        const int wid = tid >> 6, lane = tid & 63;
        for (int row = c * 8 + wid; row < T_ALL; row += G * 8) {
            const float r = frsq(ssf[row] * (1.0f / 1024.0f) + 1e-6f);
#pragma unroll
            for (int i = 0; i < 4; ++i) {
                const int col = i * 256 + lane * 4;
                f32x4 v = *(f32x4*)(x + (size_t)row * DM + col);
                const f32x4 gn = *(const f32x4*)(p.in[30] + col);
                v = v * r * gn;
                *(f32x4*)(x + (size_t)row * DM + col) = v;
            }
        }
    }
#if PROF_SEL
    __syncthreads();
    if (c == 0) prof_encode(p);
#endif
}

extern "C" void kernel_launch(void* const* d_in, const int* in_sizes, int n_in, void* d_out, int out_size, void* d_ws, size_t ws_size, hipStream_t stream) {
    static int grid = 0;
    if (grid == 0) {
        if (n_in != 31 || ws_size < WS_END) { fprintf(stderr, "kernel_launch: need 31 inputs and %zu bytes of workspace (got %d, %zu)\n", (size_t)WS_END, n_in, ws_size); grid = -1; return; }
        int dev = 0, cus = 0, per_cu = 0;
        hipGetDevice(&dev);
        hipDeviceGetAttribute(&cus, hipDeviceAttributeMultiprocessorCount, dev);
        if (hipFuncSetAttribute((const void*)fwd_megakernel, hipFuncAttributeMaxDynamicSharedMemorySize, LDS_BYTES) != hipSuccess) { fprintf(stderr, "kernel_launch: hipFuncSetAttribute failed\n"); grid = -1; return; }
        hipOccupancyMaxActiveBlocksPerMultiprocessor(&per_cu, (const void*)fwd_megakernel, 512, LDS_BYTES);
        if (per_cu < 1) { fprintf(stderr, "kernel_launch: occupancy query says %d blocks per CU\n", per_cu); per_cu = 1; }
        (void)hipGetLastError();
        grid = cus;
    }
    if (grid < 0) return;
    if (hipMemsetAsync((char*)d_ws + WS_BAR, 0, 512, stream) != hipSuccess) { fprintf(stderr, "kernel_launch: memset failed\n"); return; }
    Params p{};
    for (int i = 0; i < 31; ++i) p.in[i] = (const float*)d_in[i];
    p.out = (float*)d_out; p.ws = (unsigned char*)d_ws;
    void* args[] = {&p};
    hipError_t e = hipLaunchCooperativeKernel((const void*)fwd_megakernel, dim3(grid), dim3(512), args, LDS_BYTES, stream);
    if (e != hipSuccess) fprintf(stderr, "cooperative launch failed: %s (grid %d)\n", hipGetErrorString(e), grid);
}
```

```cpp
#include <hip/hip_runtime.h>
#include <hip/hip_cooperative_groups.h>
#include <cstdio>
namespace cg = cooperative_groups;

#define LAS __attribute__((address_space(3)))
typedef unsigned short bf16_t;
typedef short bf16x8 __attribute__((ext_vector_type(8)));
typedef short s16x4 __attribute__((ext_vector_type(4)));
typedef float f32x4 __attribute__((ext_vector_type(4)));
typedef unsigned u32x4 __attribute__((ext_vector_type(4)));
typedef unsigned u32x2 __attribute__((ext_vector_type(2)));

constexpr int T_ALL = 16896, T_P = 16384, DM = 1024, FH = 2816, NZ = 12288;
constexpr int LDS_BYTES = 163840;
constexpr size_t OFF_GU1 = 0, OFF_D1 = 5767168, OFF_WIN = 8650752, OFF_RO = 21233664, OFF_HO = 22282240, OFF_LO = 23330816,
                 OFF_MO = 24379392, OFF_GU2 = 25427968, OFF_D2 = 31195136, W_LAYER = 34078720;
constexpr size_t WS_W = 0, WS_XB = 2 * W_LAYER * 2, WS_Z = WS_XB + (size_t)T_ALL * DM * 2, WS_SS = WS_Z + (size_t)T_ALL * NZ * 2,
                 WS_ROPE = WS_SS + (size_t)8 * T_ALL * 4, WS_CTR = WS_ROPE + (size_t)2052 * 64 * 8, WS_BAR = WS_CTR + 256, WS_LB = WS_BAR + 512, WS_HIDS = WS_LB + 4096, WS_MF = WS_HIDS + (size_t)512 * FH * 2, WS_TS = WS_MF + (size_t)3 * 512 * DM * 4, WS_END = WS_TS + 4096;
constexpr int ZC_QR = 0, ZC_KR = 512, ZC_VR = 1024, ZC_GR = 2048, ZC_QH = 3072, ZC_FH = 4096, ZC_IH = 5120, ZC_GH = 6144, ZC_XL = 7168, ZC_GL = 8192, ZC_GATE = 9216;
constexpr size_t O_RETP = 17301504, O_RETS = 19398656, O_HGP = 52953088, O_HGS = 55050240, O_LRUP = 88604672, O_LRUS = 88621056, O_CVP = 88883200, O_CVS = 88932352;

struct Params { const float* in[31]; float* out; unsigned char* ws; };

__device__ __forceinline__ float bf2f(bf16_t b) { return __uint_as_float(((unsigned)b) << 16); }
__device__ __forceinline__ unsigned pk2(float lo, float hi) { unsigned r; asm("v_cvt_pk_bf16_f32 %0, %1, %2" : "=v"(r) : "v"(lo), "v"(hi)); return r; }
__device__ __forceinline__ bf16_t f2bf(float f) { return (bf16_t)(pk2(f, f) & 0xffffu); }
__device__ __forceinline__ float lo2f(unsigned w) { return __uint_as_float(w << 16); }
__device__ __forceinline__ float hi2f(unsigned w) { return __uint_as_float(w & 0xffff0000u); }
__device__ __forceinline__ float fexp(float x) { return __builtin_amdgcn_exp2f(x * 1.4426950408889634f); }
__device__ __forceinline__ float flog(float x) { return __builtin_amdgcn_logf(x) * 0.6931471805599453f; }
__device__ __forceinline__ float sigmoidf_(float x) { return __builtin_amdgcn_rcpf(1.0f + fexp(-x)); }
__device__ __forceinline__ float siluf_(float x) { return x * __builtin_amdgcn_rcpf(1.0f + fexp(-x)); }
__device__ __forceinline__ float geluf_(float x) { const float y = 0.7978845608028654f * (x + 0.044715f * x * x * x); const float e = fexp(2.0f * y); const float th = 1.0f - 2.0f * __builtin_amdgcn_rcpf(e + 1.0f); return 0.5f * x * (1.0f + th); }
__device__ __forceinline__ float frsq(float x) { return __builtin_amdgcn_rsqf(x); }

namespace pg8 {
constexpr int BM = 256, BK = 64, HALF = 128, HTB = HALF * BK * 2, NXCD = 8, WGM = 8;
__device__ __forceinline__ int lds_byte(int r, int c) { const int st = (r >> 4) * 2 + (c >> 5), rr = r & 15, cc = c & 31, ob = rr * 64 + cc * 2; return st * 1024 + (ob ^ (((ob >> 9) & 1) << 5)); }
__device__ __forceinline__ void stage_rc(int b, int& R, int& C) { const int st = b / 1024, sb = b % 1024, swz = sb ^ (((sb >> 9) & 1) << 5); R = (st >> 1) * 16 + swz / 64; C = (st & 1) * 32 + (swz % 64) / 2; }
__device__ __forceinline__ int perm32(int rho) { const int n = rho >> 4, i = rho & 15; return 8 * (i >> 2) + 4 * n + (i & 3); }

struct Unit { int pm, pn, br, kofs; };
struct Gemm { const bf16_t* A0; const bf16_t* A1; const bf16_t* A2; const bf16_t* B0; size_t bstride; int lda, ldb, K; };

struct StaticOrder {
    int nM, nN, nwg, G, c, pm0;
    __device__ void init(int M, int N, int G_, int c_, int pm0_) { nM = M / BM; nN = N / BM; nwg = nM * nN; G = G_; c = c_; pm0 = pm0_; }
    __device__ bool next(int i, Unit& u) const {
        const long L = (long)i * G + c; if (L >= nwg) return false;
        int wgid = (int)L; { const int q = nwg / NXCD, r = nwg % NXCD, xcd = wgid % NXCD, off = wgid / NXCD; wgid = (xcd < r ? xcd * (q + 1) : r * (q + 1) + (xcd - r) * q) + off; }
        const int nig = WGM * nN, gid = wgid / nig, fm = gid * WGM, gsz = (nM - fm) < WGM ? (nM - fm) : WGM;
        u.pm = pm0 + fm + ((wgid % nig) % gsz); u.pn = (wgid % nig) / gsz; u.br = 0; u.kofs = 0; return true;
    }
};
struct SplitOrder {
    int nM, nN, nbr, nsplit, klen, G, c, pm0;
    __device__ bool next(int i, Unit& u) const {
        const int L = i * G + c; if (L >= nM * nN * nbr * nsplit) return false;
        const int ks = L % nsplit, r = L / nsplit; u.br = r % nbr; const int t = r / nbr; u.pm = pm0 + t % nM; u.pn = t / nM; u.kofs = ks * klen; return true;
    }
};
struct BranchOrder {
    StaticOrder so;
    __device__ bool next(int i, Unit& u) const { if (!so.next(i / 3, u)) return false; u.br = i % 3; return true; }
};

template <class Epi, class Sched>
__device__ __forceinline__ void gemm_phase(LAS unsigned char* lds, const Gemm g, const Sched& S, const Epi& E) {
    int tid = threadIdx.x; asm volatile("" : "+v"(tid));
    const int wid = __builtin_amdgcn_readfirstlane(tid >> 6), lane = tid & 63, wr = wid >> 2, wc = wid & 3, fr = lane & 15, fq = lane >> 4;
    const int K = g.ldb, nt = g.K / BK, lda = g.lda;
    unsigned voffA[2], voffB[2];
#pragma unroll
    for (int i = 0; i < 2; ++i) { int R, C; stage_rc(tid * 16 + i * 8192, R, C); const int Rb = Epi::PERM ? ((R & ~31) + perm32(R & 31)) : R;
        voffA[i] = (unsigned)(R * lda + C) * 2u; voffB[i] = (unsigned)(Rb * K + C) * 2u; }
    const size_t kstep = (size_t)(BK * 2);
    const size_t hstepA = (size_t)HALF * lda * 2, hstepB = (size_t)HALF * K * 2;
    const size_t tstepA = 2 * hstepA, tstepB = 2 * hstepB;
    const unsigned ldsw = (unsigned)wid * 1024u;
    const int aoff = lds_byte(wr * 64 + fr, fq * 8), boff = lds_byte(wc * 32 + fr, fq * 8);
#define PG8_SA(b, h) (((b) * 2 + (h)) * HTB)
#define PG8_SB(b, h) ((4 + (b) * 2 + (h)) * HTB)
#define PG8_STAGE(bufoff, gbase, voff) do { _Pragma("unroll") for (int _i = 0; _i < 2; ++_i) \
        __builtin_amdgcn_global_load_lds((const unsigned*)((const char*)(gbase) + (voff)[_i]), (LAS unsigned*)(lds + (bufoff) + ldsw + _i * 8192), 16, 0, 0); } while (0)
#define PG8_LDA(dst, b, h) do { _Pragma("unroll") for (int m = 0; m < 4; ++m) _Pragma("unroll") for (int k = 0; k < 2; ++k) dst[m][k] = *(const LAS bf16x8*)(lds + PG8_SA(b, h) + aoff + m * 2048 + k * 1024); } while (0)
#define PG8_LDB(dst, b, h) do { _Pragma("unroll") for (int n = 0; n < 2; ++n) _Pragma("unroll") for (int k = 0; k < 2; ++k) dst[n][k] = *(const LAS bf16x8*)(lds + PG8_SB(b, h) + boff + n * 2048 + k * 1024); } while (0)
#define PG8_MMA(ai, bj, At, Bt) do { __builtin_amdgcn_s_setprio(1); _Pragma("unroll") for (int m = 0; m < 4; ++m) _Pragma("unroll") for (int n = 0; n < 2; ++n) _Pragma("unroll") for (int k = 0; k < 2; ++k) \
        acc[ai][bj][m][n] = __builtin_amdgcn_mfma_f32_16x16x32_bf16(Bt[n][k], At[m][k], acc[ai][bj][m][n], 0, 0, 0); __builtin_amdgcn_s_setprio(0); } while (0)
#define PG8_WAIT_V(n) asm volatile("s_waitcnt vmcnt(" #n ")" ::: "memory")
#define PG8_WAIT_L(n) asm volatile("s_waitcnt lgkmcnt(" #n ")" ::: "memory")
#define PG8_BAR __builtin_amdgcn_s_barrier()
#define PG8_SCHED __builtin_amdgcn_sched_barrier(0)
#define PG8_APTR(u) ((const char*)((u).br == 0 ? g.A0 : ((u).br == 1 ? g.A1 : g.A2)) + (size_t)(u).pm * tstepA + (size_t)(u).kofs * 2)
#define PG8_BPTR(u) ((const char*)(g.B0 + (size_t)(u).br * g.bstride) + (size_t)(u).pn * tstepB + (size_t)(u).kofs * 2)
    Unit cur, nxt; int ui = 0;
    if (!S.next(0, cur)) return;
    f32x4 acc[2][2][4][2];
#pragma unroll
    for (int a = 0; a < 2; ++a)
#pragma unroll
        for (int b = 0; b < 2; ++b)
#pragma unroll
            for (int m = 0; m < 4; ++m)
#pragma unroll
                for (int n = 0; n < 2; ++n) acc[a][b][m][n] = (f32x4){0.f, 0.f, 0.f, 0.f};
    bf16x8 At[4][2], B0[2][2], B1[2][2];
    const char* cA = PG8_APTR(cur); const char* cB = PG8_BPTR(cur);
    PG8_STAGE(PG8_SB(0, 0), cB, voffB); PG8_STAGE(PG8_SA(0, 0), cA, voffA); PG8_STAGE(PG8_SB(0, 1), cB + hstepB, voffB); PG8_STAGE(PG8_SA(0, 1), cA + hstepA, voffA);
    if (wr == 1) PG8_BAR;
    PG8_WAIT_V(4); PG8_BAR;
    PG8_STAGE(PG8_SB(1, 0), cB + kstep, voffB); PG8_STAGE(PG8_SA(1, 0), cA + kstep, voffA); PG8_STAGE(PG8_SB(1, 1), cB + hstepB + kstep, voffB);
    PG8_WAIT_V(6); PG8_BAR;
    for (;;) {
        const bool has_next = S.next(ui + 1, nxt);
        const char* nA = has_next ? PG8_APTR(nxt) : cA; const char* nB = has_next ? PG8_BPTR(nxt) : cB;
        for (int t = 0; t < nt; t += 2) {
            const bool last = (t == nt - 2);
            const char* a1 = cA + (size_t)(t + 1) * kstep;
            const char* a2 = last ? nA : cA + (size_t)(t + 2) * kstep; const char* b2 = last ? nB : cB + (size_t)(t + 2) * kstep;
            const char* a3 = a2 + kstep; const char* b3 = b2 + kstep;
            PG8_LDB(B0, 0, 0); PG8_SCHED; PG8_LDA(At, 0, 0); PG8_STAGE(PG8_SA(1, 1), a1 + hstepA, voffA);
            PG8_WAIT_L(8); PG8_BAR; PG8_WAIT_L(0); PG8_MMA(0, 0, At, B0); PG8_BAR; PG8_SCHED;
            PG8_LDB(B1, 0, 1); PG8_STAGE(PG8_SB(0, 0), b2, voffB);
            PG8_BAR; PG8_WAIT_L(0); PG8_MMA(0, 1, At, B1); PG8_BAR;
            PG8_LDA(At, 0, 1); PG8_STAGE(PG8_SA(0, 0), a2, voffA);
            PG8_BAR; PG8_WAIT_L(0); PG8_MMA(1, 0, At, B0); PG8_BAR; PG8_SCHED;
            PG8_STAGE(PG8_SB(0, 1), b2 + hstepB, voffB);
            PG8_WAIT_V(6); PG8_BAR; PG8_MMA(1, 1, At, B1); PG8_BAR;
            PG8_LDB(B0, 1, 0); PG8_SCHED; PG8_LDA(At, 1, 0); PG8_STAGE(PG8_SA(0, 1), a2 + hstepA, voffA);
            PG8_WAIT_L(8); PG8_BAR; PG8_WAIT_L(0); PG8_MMA(0, 0, At, B0); PG8_BAR; PG8_SCHED;
            PG8_LDB(B1, 1, 1); PG8_STAGE(PG8_SB(1, 0), b3, voffB);
            PG8_BAR; PG8_WAIT_L(0); PG8_MMA(0, 1, At, B1); PG8_BAR;
            PG8_LDA(At, 1, 1); PG8_STAGE(PG8_SA(1, 0), a3, voffA);
            PG8_BAR; PG8_WAIT_L(0); PG8_MMA(1, 0, At, B0); PG8_BAR; PG8_SCHED;
            PG8_STAGE(PG8_SB(1, 1), b3 + hstepB, voffB);
            PG8_WAIT_V(6); PG8_BAR; PG8_MMA(1, 1, At, B1); PG8_BAR;
        }
        E(acc, cur, wr, wc, fr, fq);
        if (!has_next) break;
#pragma unroll
        for (int a = 0; a < 2; ++a)
#pragma unroll
            for (int b = 0; b < 2; ++b)
#pragma unroll
                for (int m = 0; m < 4; ++m)
#pragma unroll
                    for (int n = 0; n < 2; ++n) acc[a][b][m][n] = (f32x4){0.f, 0.f, 0.f, 0.f};
        cur = nxt; cA = nA; cB = nB; ++ui;
    }
    PG8_WAIT_V(0);
    if (wr == 0) PG8_BAR;
    PG8_BAR;
#undef PG8_SA
#undef PG8_SB
#undef PG8_STAGE
#undef PG8_LDA
#undef PG8_LDB
#undef PG8_MMA
#undef PG8_WAIT_V
#undef PG8_WAIT_L
#undef PG8_BAR
#undef PG8_SCHED
#undef PG8_APTR
#undef PG8_BPTR
}

struct EpiUp {
    static constexpr bool PERM = false;
    bf16_t* hid; bf16_t* hid2; const float* ss;
    __device__ __forceinline__ void operator()(const f32x4 (&acc)[2][2][4][2], const Unit& u, int wr, int wc, int fr, int fq) const {
        const int row0 = u.pm * BM + wr * 64 + fr;
        float rr[2][4];
#pragma unroll
        for (int ai = 0; ai < 2; ++ai)
#pragma unroll
            for (int m = 0; m < 4; ++m) rr[ai][m] = ss[row0 + ai * HALF + m * 16];
#pragma unroll
        for (int ai = 0; ai < 2; ++ai)
#pragma unroll
            for (int m = 0; m < 4; ++m) {
                const int row = row0 + ai * HALF + m * 16;
                const float r = frsq(rr[ai][m] * (1.0f / 1024.0f) + 1e-6f);
#pragma unroll
                for (int bj = 0; bj < 2; ++bj) {
                    const f32x4 gt = acc[ai][bj][m][0] * r, up = acc[ai][bj][m][1] * r;
                    float h[4];
#pragma unroll
                    for (int j = 0; j < 4; ++j) h[j] = siluf_(gt[j]) * up[j];
                    const int col = 16 * (8 * u.pn + 4 * bj + wc) + 4 * fq;
                    u32x2 w; w.x = pk2(h[0], h[1]); w.y = pk2(h[2], h[3]);
                    *(u32x2*)((u.pm >= T_P / BM ? hid2 : hid) + (size_t)row * FH + col) = w;
                }
            }
    }
};
struct EpiRes {
    static constexpr bool PERM = false;
    float* x; bf16_t* xb; float* ssn; float scale; int dry;
    __device__ __forceinline__ void operator()(const f32x4 (&acc)[2][2][4][2], const Unit& u, int wr, int wc, int fr, int fq) const {
        const int row0 = u.pm * BM + wr * 64 + fr, col0 = u.pn * BM + wc * 32 + 4 * fq;
        f32x4 cur[2][2], nxt[2][2];
#pragma unroll
        for (int bj = 0; bj < 2; ++bj)
#pragma unroll
            for (int n = 0; n < 2; ++n) cur[bj][n] = *(const f32x4*)(x + (size_t)row0 * DM + col0 + bj * HALF + n * 16);
#pragma unroll
        for (int gi = 0; gi < 8; ++gi) {
            const int ai = gi >> 2, m = gi & 3;
            const int row = row0 + ai * HALF + m * 16;
            if (gi < 7) { const int rown = row0 + ((gi + 1) >> 2) * HALF + ((gi + 1) & 3) * 16;
#pragma unroll
                for (int bj = 0; bj < 2; ++bj)
#pragma unroll
                    for (int n = 0; n < 2; ++n) nxt[bj][n] = *(const f32x4*)(x + (size_t)rown * DM + col0 + bj * HALF + n * 16); }
            float s = 0.f;
#pragma unroll
            for (int bj = 0; bj < 2; ++bj)
#pragma unroll
                for (int n = 0; n < 2; ++n) {
                    const int col = col0 + bj * HALF + n * 16;
                    const f32x4 v = cur[bj][n] + acc[ai][bj][m][n] * scale;
                    u32x2 w; w.x = pk2(v[0], v[1]); w.y = pk2(v[2], v[3]);
                    if (!dry) { *(f32x4*)(x + (size_t)row * DM + col) = v; *(u32x2*)(xb + (size_t)row * DM + col) = w; }
                    s += v[0] * v[0] + v[1] * v[1] + v[2] * v[2] + v[3] * v[3];
                }
            s += __shfl_xor(s, 16); s += __shfl_xor(s, 32);
            if (fq == 0 && !dry) atomicAdd(ssn + row, s);
#pragma unroll
            for (int bj = 0; bj < 2; ++bj)
#pragma unroll
                for (int n = 0; n < 2; ++n) cur[bj][n] = nxt[bj][n];
        }
    }
};
__device__ __forceinline__ unsigned pkh2(float lo, float hi) { const _Float16 a = (_Float16)lo, b = (_Float16)hi; return (unsigned)__builtin_bit_cast(unsigned short, a) | ((unsigned)__builtin_bit_cast(unsigned short, b) << 16); }
__device__ __forceinline__ float h2f_lo(unsigned w) { return (float)__builtin_bit_cast(_Float16, (unsigned short)(w & 0xffffu)); }
__device__ __forceinline__ float h2f_hi(unsigned w) { return (float)__builtin_bit_cast(_Float16, (unsigned short)(w >> 16)); }
__device__ __forceinline__ float hg_logf(float v, float lb) {
    const float ls = fminf(v, 0.f) - flog(1.0f + fexp(-fabsf(v)));
    return (lb == 0.f) ? ls : flog(lb + (1.0f - lb) * fexp(ls));
}
struct EpiWin {
    static constexpr bool PERM = true;
    bf16_t* z; const float* ss; const float* lbv; const float2* rope;
    __device__ __forceinline__ void operator()(const f32x4 (&acc)[2][2][4][2], const Unit& u, int wr, int wc, int fr, int fq) const {
        const int row0 = u.pm * BM + wr * 64 + fr, col0 = u.pn * BM + wc * 32 + 8 * fq;
        const int ctile = u.pn * BM;
        const int mode = (ctile < ZC_VR) ? 3 : (ctile >= ZC_QH && ctile < ZC_FH) ? 1 : ((ctile >= ZC_FH && ctile < ZC_IH) ? 2 : 0);
        float rr[2][4];
#pragma unroll
        for (int ai = 0; ai < 2; ++ai)
#pragma unroll
            for (int m = 0; m < 4; ++m) rr[ai][m] = ss[row0 + ai * HALF + m * 16];
        if (mode == 0) {
#pragma unroll
            for (int ai = 0; ai < 2; ++ai)
#pragma unroll
                for (int m = 0; m < 4; ++m) {
                    const int row = row0 + ai * HALF + m * 16;
                    const float r = frsq(rr[ai][m] * (1.0f / 1024.0f) + 1e-6f);
#pragma unroll
                    for (int bj = 0; bj < 2; ++bj) {
                        const f32x4 v0 = acc[ai][bj][m][0] * r, v1 = acc[ai][bj][m][1] * r;
                        u32x4 w; w.x = pk2(v0[0], v0[1]); w.y = pk2(v0[2], v0[3]); w.z = pk2(v1[0], v1[1]); w.w = pk2(v1[2], v1[3]);
                        *(u32x4*)(z + (size_t)row * NZ + col0 + bj * HALF) = w;
                    }
                }
        } else if (mode == 3) {
#pragma unroll
            for (int ai = 0; ai < 2; ++ai)
#pragma unroll
                for (int m = 0; m < 4; ++m) {
                    const int row = row0 + ai * HALF + m * 16;
                    const float r = frsq(rr[ai][m] * (1.0f / 1024.0f) + 1e-6f);
                    const int pidx = row < T_P ? (row & 2047) : 2048 + ((row - T_P) & 3);
                    const float2* rp = rope + (size_t)pidx * 64 + 16 * wc + 4 * fq;
                    const f32x4 cs01 = *(const f32x4*)rp, cs23 = *(const f32x4*)(rp + 2);
#pragma unroll
                    for (int bj = 0; bj < 2; ++bj) {
                        const f32x4 x1 = acc[ai][bj][m][0] * r, x2 = acc[ai][bj][m][1] * r;
                        const float o10 = x1[0] * cs01[0] - x2[0] * cs01[1], o20 = x1[0] * cs01[1] + x2[0] * cs01[0];
                        const float o11 = x1[1] * cs01[2] - x2[1] * cs01[3], o21 = x1[1] * cs01[3] + x2[1] * cs01[2];
                        const float o12 = x1[2] * cs23[0] - x2[2] * cs23[1], o22 = x1[2] * cs23[1] + x2[2] * cs23[0];
                        const float o13 = x1[3] * cs23[2] - x2[3] * cs23[3], o23 = x1[3] * cs23[3] + x2[3] * cs23[2];
                        bf16_t* zo = z + (size_t)row * NZ + ctile + bj * HALF + 16 * wc + 4 * fq;
                        u32x2 w1, w2; w1.x = pk2(o10, o11); w1.y = pk2(o12, o13); w2.x = pk2(o20, o21); w2.y = pk2(o22, o23);
                        *(u32x2*)zo = w1; *(u32x2*)(zo + 64) = w2;
                    }
                }
        } else if (mode == 1) {
#pragma unroll
            for (int ai = 0; ai < 2; ++ai)
#pragma unroll
                for (int m = 0; m < 4; ++m) {
                    const int row = row0 + ai * HALF + m * 16;
                    const float r = frsq(rr[ai][m] * (1.0f / 1024.0f) + 1e-6f);
#pragma unroll
                    for (int bj = 0; bj < 2; ++bj) {
                        const f32x4 v0 = acc[ai][bj][m][0] * r, v1 = acc[ai][bj][m][1] * r;
                        u32x4 w; w.x = pk2(siluf_(v0[0]), siluf_(v0[1])); w.y = pk2(siluf_(v0[2]), siluf_(v0[3])); w.z = pk2(siluf_(v1[0]), siluf_(v1[1])); w.w = pk2(siluf_(v1[2]), siluf_(v1[3]));
                        *(u32x4*)(z + (size_t)row * NZ + col0 + bj * HALF) = w;
                    }
                }
        } else {
#pragma unroll
            for (int bj = 0; bj < 2; ++bj) {
                f32x4 l0 = (f32x4){0.f, 0.f, 0.f, 0.f}, l1 = l0;
                if (lbv) { l0 = *(const f32x4*)(lbv + col0 + bj * HALF - ZC_FH); l1 = *(const f32x4*)(lbv + col0 + bj * HALF - ZC_FH + 4); }
#pragma unroll
                for (int ai = 0; ai < 2; ++ai)
#pragma unroll
                    for (int m = 0; m < 4; ++m) {
                        const int row = row0 + ai * HALF + m * 16;
                        const float r = frsq(rr[ai][m] * (1.0f / 1024.0f) + 1e-6f);
                        const f32x4 v0 = acc[ai][bj][m][0] * r, v1 = acc[ai][bj][m][1] * r;
                        u32x4 w;
                        w.x = pkh2(hg_logf(v0[0], l0[0]), hg_logf(v0[1], l0[1])); w.y = pkh2(hg_logf(v0[2], l0[2]), hg_logf(v0[3], l0[3]));
                        w.z = pkh2(hg_logf(v1[0], l1[0]), hg_logf(v1[1], l1[1])); w.w = pkh2(hg_logf(v1[2], l1[2]), hg_logf(v1[3], l1[3]));
                        *(u32x4*)(z + (size_t)row * NZ + col0 + bj * HALF) = w;
                    }
            }
        }
    }
};
struct EpiBranch {
    static constexpr bool PERM = true;
    bf16_t* z; bf16_t* mrg; const float* mbias; int dry;
    __device__ __forceinline__ void operator()(const f32x4 (&acc)[2][2][4][2], const Unit& u, int wr, int wc, int fr, int fq) const {
        const int row0 = u.pm * BM + wr * 64 + fr, col0 = u.pn * BM + wc * 32 + 8 * fq;
        const int br = u.br;
#pragma unroll
        for (int bj = 0; bj < 2; ++bj) {
            const int col = col0 + bj * HALF;
            const f32x4 b0 = *(const f32x4*)(mbias + br * DM + col), b1 = *(const f32x4*)(mbias + br * DM + col + 4);
#pragma unroll
            for (int am = 0; am < 4; ++am) {
                const int ai = am >> 1, mb = (am & 1) * 2;
                u32x4 gw[2], pw[2];
#pragma unroll
                for (int mm = 0; mm < 2; ++mm) {
                    const int rowm = row0 + ai * HALF + (mb + mm) * 16;
                    gw[mm] = *(const u32x4*)(z + (size_t)rowm * NZ + ZC_GATE + br * DM + col);
                    pw[mm] = (u32x4){0u, 0u, 0u, 0u};
                    if (br > 0) pw[mm] = *(const u32x4*)(mrg + (size_t)rowm * DM + col);
                }
#pragma unroll
                for (int mm = 0; mm < 2; ++mm) {
                    const int m = mb + mm;
                    bf16_t* zr = mrg + (size_t)(row0 + ai * HALF + m * 16) * DM;
                    float o[8];
                    const f32x4 a0 = acc[ai][bj][m][0], a1 = acc[ai][bj][m][1];
                    o[0] = sigmoidf_(lo2f(gw[mm].x) + b0[0]) * a0[0] + lo2f(pw[mm].x); o[1] = sigmoidf_(hi2f(gw[mm].x) + b0[1]) * a0[1] + hi2f(pw[mm].x);
                    o[2] = sigmoidf_(lo2f(gw[mm].y) + b0[2]) * a0[2] + lo2f(pw[mm].y); o[3] = sigmoidf_(hi2f(gw[mm].y) + b0[3]) * a0[3] + hi2f(pw[mm].y);
                    o[4] = sigmoidf_(lo2f(gw[mm].z) + b1[0]) * a1[0] + lo2f(pw[mm].z); o[5] = sigmoidf_(hi2f(gw[mm].z) + b1[1]) * a1[1] + hi2f(pw[mm].z);
                    o[6] = sigmoidf_(lo2f(gw[mm].w) + b1[2]) * a1[2] + lo2f(pw[mm].w); o[7] = sigmoidf_(hi2f(gw[mm].w) + b1[3]) * a1[3] + hi2f(pw[mm].w);
                    u32x4 w; w.x = pk2(o[0], o[1]); w.y = pk2(o[2], o[3]); w.z = pk2(o[4], o[5]); w.w = pk2(o[6], o[7]);
                    if (!dry) *(u32x4*)(zr + col) = w;
                }
            }
        }
    }
};
struct EpiStoreP {
    static constexpr bool PERM = false;
    float* pbuf; int klen, nsplit;
    __device__ __forceinline__ void operator()(const f32x4 (&acc)[2][2][4][2], const Unit& u, int wr, int wc, int fr_, int fq_) const {
        int fr = fr_, fq = fq_; asm volatile("" : "+v"(fr), "+v"(fq));
        const int row0 = u.pm * BM - T_P + wr * 64 + fr, col0 = u.pn * BM + wc * 32 + 4 * fq;
        float* base = pbuf + (size_t)(u.br * nsplit + u.kofs / klen) * (512 * DM);
#pragma unroll
        for (int ai = 0; ai < 2; ++ai)
#pragma unroll
            for (int m = 0; m < 4; ++m)
#pragma unroll
                for (int bj = 0; bj < 2; ++bj)
#pragma unroll
                    for (int n = 0; n < 2; ++n)
                        *(f32x4*)(base + (size_t)(row0 + ai * HALF + m * 16) * DM + col0 + bj * HALF + n * 16) = acc[ai][bj][m][n];
    }
};
}

__device__ __forceinline__ void conv_tile(const float* __restrict__ src, int ldn, int k0, int n0, bf16_t* __restrict__ dst, int K, const float* __restrict__ gain, int mode, LAS float* tile) {
    int tid = threadIdx.x; asm volatile("" : "+v"(tid));
    float v[32];
#pragma unroll
    for (int i = 0; i < 32; ++i) v[i] = src[(size_t)(k0 + i * 2 + (tid >> 8)) * ldn + n0 + (tid & 255)];
    if (gain) {
#pragma unroll
        for (int i = 0; i < 32; ++i) v[i] *= gain[k0 + i * 2 + (tid >> 8)];
    }
#pragma unroll
    for (int i = 0; i < 32; ++i) tile[(i * 2 + (tid >> 8)) * 257 + (tid & 255)] = v[i];
    __syncthreads();
#pragma unroll
    for (int i = 0; i < 4; ++i) {
        const int id = tid + 512 * i, nn = id >> 3, ks = (id & 7) * 8;
        float t[8];
#pragma unroll
        for (int j = 0; j < 8; ++j) t[j] = tile[(ks + j) * 257 + nn];
        const int n = n0 + nn;
        const int row = (mode == 0) ? n : (mode == 3) ? ((n & ~127) + 8 * ((n & 63) >> 2) + 4 * ((n >> 6) & 1) + (n & 3)) : (32 * (n >> 4) + (mode == 2 ? 16 : 0) + (n & 15));
        u32x4 w; w.x = pk2(t[0], t[1]); w.y = pk2(t[2], t[3]); w.z = pk2(t[4], t[5]); w.w = pk2(t[6], t[7]);
        *(u32x4*)(dst + (size_t)row * K + k0 + ks) = w;
    }
    __syncthreads();
}

__device__ void conv_job(const Params& p, int ti, LAS float* tile) {
    bf16_t* wb = (bf16_t*)(p.ws + WS_W);
    {
        const int l = ti / 2080; int r = ti % 2080;
        bf16_t* wl = wb + (size_t)l * W_LAYER;
        const float* src; int Ks, Ns; bf16_t* dst; const float* gain = nullptr; int mode = 0;
        if (r < 176) { src = p.in[7] + (size_t)l * DM * FH; Ks = DM; Ns = FH; dst = wl + OFF_GU1; gain = p.in[6] + l * DM; mode = 1; }
        else if ((r -= 176) < 176) { src = p.in[8] + (size_t)l * DM * FH; Ks = DM; Ns = FH; dst = wl + OFF_GU1; gain = p.in[6] + l * DM; mode = 2; }
        else if ((r -= 176) < 176) { src = p.in[9] + (size_t)l * DM * FH; Ks = FH; Ns = DM; dst = wl + OFF_D1; }
        else if ((r -= 176) < 768) { src = p.in[11] + (size_t)l * DM * NZ; Ks = DM; Ns = NZ; dst = wl + OFF_WIN; gain = p.in[10] + l * DM; }
        else if ((r -= 768) < 64) { src = p.in[13] + (size_t)l * DM * DM; Ks = DM; Ns = DM; dst = wl + OFF_RO; }
        else if ((r -= 64) < 64) { src = p.in[16] + (size_t)l * DM * DM; Ks = DM; Ns = DM; dst = wl + OFF_HO; }
        else if ((r -= 64) < 64) { src = p.in[24] + (size_t)l * DM * DM; Ks = DM; Ns = DM; dst = wl + OFF_LO; }
        else if ((r -= 64) < 64) { src = p.in[25] + (size_t)l * DM * DM; Ks = DM; Ns = DM; dst = wl + OFF_MO; }
        else if ((r -= 64) < 176) { src = p.in[27] + (size_t)l * DM * FH; Ks = DM; Ns = FH; dst = wl + OFF_GU2; gain = p.in[26] + l * DM; mode = 1; }
        else if ((r -= 176) < 176) { src = p.in[28] + (size_t)l * DM * FH; Ks = DM; Ns = FH; dst = wl + OFF_GU2; gain = p.in[26] + l * DM; mode = 2; }
        else { r -= 176; src = p.in[29] + (size_t)l * DM * FH; Ks = FH; Ns = DM; dst = wl + OFF_D2; }
        const int nkt = Ks / 64;
        const int kt = r % nkt, ntile = r / nkt;
        if (Ns == NZ && ntile < 4) mode = 3;
        conv_tile(src, Ns, kt * 64, ntile * 256, dst, Ks, gain, mode, tile);
    }
}

__device__ void phase0(const Params& p, LAS unsigned char* lds) {
    int tid = threadIdx.x; asm volatile("" : "+v"(tid));
    const int bid = blockIdx.x, nb = gridDim.x;
    LAS float* tile = (LAS float*)lds;
    for (int ti = bid; ti < 2080; ti += nb) conv_job(p, ti, tile);
    float* x = p.out; bf16_t* xb = (bf16_t*)(p.ws + WS_XB); float* ss = (float*)(p.ws + WS_SS);
    const int wid = tid >> 6, lane = tid & 63;
    for (int row = bid * 8 + wid; row < T_ALL; row += nb * 8) {
        const float* srow = (row < T_P) ? (p.in[0] + (size_t)row * DM) : (p.in[1] + (size_t)(row - T_P) * DM);
        float s = 0.f;
#pragma unroll
        for (int i = 0; i < 4; ++i) {
            const int c = i * 256 + lane * 4;
            const f32x4 v = *(const f32x4*)(srow + c);
            *(f32x4*)(x + (size_t)row * DM + c) = v;
            u32x2 w; w.x = pk2(v[0], v[1]); w.y = pk2(v[2], v[3]);
            *(u32x2*)(xb + (size_t)row * DM + c) = w;
            s += v[0] * v[0] + v[1] * v[1] + v[2] * v[2] + v[3] * v[3];
        }
#pragma unroll
        for (int o = 32; o >= 1; o >>= 1) s += __shfl_xor(s, o);
        if (lane == 0) { ss[row] = s;
#pragma unroll
            for (int k = 1; k < 8; ++k) ss[(size_t)k * T_ALL + row] = 0.f; }
    }
    float2* rope = (float2*)(p.ws + WS_ROPE);
    for (int e = bid * 512 + tid; e < 2052 * 64; e += nb * 512) {
        const int idx = e >> 6, i = e & 63;
        const int pos = idx < 2048 ? idx : (16384 + idx - 2048);
        double inv = 1.0;
        for (int k = 0; k < i; ++k) inv *= 0.8659643233600653;
        double rev = (double)pos * inv * 0.15915494309189535;
        rev -= (double)(long long)rev;
        const float rf = (float)rev;
        rope[e] = make_float2(__builtin_amdgcn_cosf(rf), __builtin_amdgcn_sinf(rf));
    }
    if (bid == 0 && tid < 64) ((unsigned*)(p.ws + WS_CTR))[tid] = 0u;
    if (bid == 1) { float* lbp = (float*)(p.ws + WS_LB); for (int i = tid; i < 1024; i += 512) lbp[i] = sigmoidf_(p.in[14][1024 + i] - p.in[14][i]); }
}

__device__ __forceinline__ bf16x8 ldfrag(const LAS bf16_t* M, int ld, int r0, int k0, int fr, int fq) { return *(const LAS bf16x8*)(M + (r0 + fr) * ld + k0 + fq * 8); }
__device__ __forceinline__ bf16x8 ldfrag_tr(const LAS bf16_t* M, int ld, int i0, int k0, int fr, int fq) {
    const LAS bf16_t* q = M + (k0 + fq * 8 + (fr >> 2)) * ld + i0 + (fr & 3) * 4;
    const s16x4 a = __builtin_amdgcn_ds_read_tr16_b64_v4i16((LAS s16x4*)q);
    const s16x4 b = __builtin_amdgcn_ds_read_tr16_b64_v4i16((LAS s16x4*)(q + 4 * ld));
    return (bf16x8){a[0], a[1], a[2], a[3], b[0], b[1], b[2], b[3]};
}
#define MMA16(acc, bfr, afr) acc = __builtin_amdgcn_mfma_f32_16x16x32_bf16(bfr, afr, acc, 0, 0, 0)

__device__ __forceinline__ bf16_t* og_compact(const Params& p, int br) {
    bf16_t* base0 = (bf16_t*)(p.out + O_RETS + (size_t)128 * 4 * 128 * 256);
    bf16_t* base1 = (bf16_t*)(p.out + O_HGS + (size_t)128 * 8 * 128 * 128);
    return br == 0 ? base0 + (size_t)T_P * DM : (br == 1 ? base1 : base1 + (size_t)T_P * DM);
}

template <bool HG>
__device__ void linattn_prompt(const Params& p, int l, int b, int h, LAS unsigned char* lds, int dry) {
    constexpr int DV = HG ? 128 : 256, NVT = DV / 16, NV = DV / 32, LQ = 136, LV = DV + 8, LP = 72;
    int tid = threadIdx.x; asm volatile("" : "+v"(tid));
    const int wid = __builtin_amdgcn_readfirstlane(tid >> 6), lane = tid & 63, fr = lane & 15, fq = lane >> 4;
    LAS bf16_t* Q = (LAS bf16_t*)lds;
    LAS bf16_t* Kn = Q + 64 * LQ;
    LAS bf16_t* P = Kn;
    LAS bf16_t* KH = Kn + 64 * LQ;
    LAS bf16_t* V = KH + 64 * LQ;
    LAS bf16_t* ST = V + 64 * LV;
    LAS float* red = (LAS float*)(ST + DV * LQ);
    LAS float* eL = red + 128;
    LAS float* eR = eL + 128;
    LAS float* segs = eR + 128;
    bf16_t* zb = (bf16_t*)(p.ws + WS_Z);
    const float2* rope = (const float2*)(p.ws + WS_ROPE);
    const int qcol = HG ? ZC_QH + h * 128 : ZC_QR + h * 128;
    const int kcol = HG ? ZC_FH + h * 128 : ZC_KR + h * 128;
    const int vcol = HG ? ZC_IH + h * 128 : ZC_VR + h * 256;
    const int gcol = HG ? ZC_GH + h * 128 : ZC_GR + h * 256;
    const float log_g = HG ? 0.f : logf(1.0f - exp2f(-5.0f - (float)h));
    f32x4 st[NVT];
#pragma unroll
    for (int i = 0; i < NVT; ++i) st[i] = (f32x4){0.f, 0.f, 0.f, 0.f};

    u32x4 rq1, rq2, rk1, rk2, rawv[HG ? 2 : 4];
    bf16_t rawf[16], rawq[16];
#define LOAD_RAW(cc) do { const int r0_ = b * 2048 + (cc) * 64; \
        if (!HG) { const bf16_t* zr_ = zb + (size_t)(r0_ + (tid >> 3)) * NZ; const int g_ = tid & 7; \
            rq1 = *(const u32x4*)(zr_ + qcol + 8 * g_); rq2 = *(const u32x4*)(zr_ + qcol + 64 + 8 * g_); rk1 = *(const u32x4*)(zr_ + kcol + 8 * g_); rk2 = *(const u32x4*)(zr_ + kcol + 64 + 8 * g_); \
            _Pragma("unroll") for (int i_ = 0; i_ < 4; ++i_) { const int id_ = tid + 512 * i_; rawv[i_] = *(const u32x4*)(zb + (size_t)(r0_ + (id_ >> 5)) * NZ + vcol + 8 * (id_ & 31)); } } \
        else { _Pragma("unroll") for (int j_ = 0; j_ < 16; ++j_) { const bf16_t* zr_ = zb + (size_t)(r0_ + (tid >> 7) * 16 + j_) * NZ; rawf[j_] = zr_[kcol + (tid & 127)]; rawq[j_] = zr_[qcol + (tid & 127)]; } \
            _Pragma("unroll") for (int i_ = 0; i_ < 2; ++i_) { const int id_ = tid + 512 * i_; rawv[i_] = *(const u32x4*)(zb + (size_t)(r0_ + (id_ >> 4)) * NZ + vcol + 8 * (id_ & 15)); } } } while (0)
    LOAD_RAW(0);
    for (int c = 0; c < 32; ++c) {
        const int row0 = b * 2048 + c * 64;
        if (!HG) {
            const int t = tid >> 3, g = tid & 7;
            const u32x4 q1 = rq1, q2 = rq2, k1 = rk1, k2 = rk2;
            const float kd = fexp((float)(63 - t) * log_g) * 0.08838834764831845f;
            unsigned ha[4], hb[4];
#pragma unroll
            for (int j = 0; j < 4; ++j) {
                const unsigned v1 = j == 0 ? k1.x : j == 1 ? k1.y : j == 2 ? k1.z : k1.w, v2 = j == 0 ? k2.x : j == 1 ? k2.y : j == 2 ? k2.z : k2.w;
                ha[j] = pk2(lo2f(v1) * kd, hi2f(v1) * kd); hb[j] = pk2(lo2f(v2) * kd, hi2f(v2) * kd);
            }
            *(LAS u32x4*)(Q + t * LQ + 8 * g) = q1;
            *(LAS u32x4*)(Q + t * LQ + 64 + 8 * g) = q2;
            *(LAS u32x4*)(Kn + t * LQ + 8 * g) = k1;
            *(LAS u32x4*)(Kn + t * LQ + 64 + 8 * g) = k2;
            *(LAS u32x4*)(KH + t * LQ + 8 * g) = (u32x4){ha[0], ha[1], ha[2], ha[3]};
            *(LAS u32x4*)(KH + t * LQ + 64 + 8 * g) = (u32x4){hb[0], hb[1], hb[2], hb[3]};
#pragma unroll
            for (int i = 0; i < 4; ++i) {
                const int id = tid + 512 * i, tt = id >> 5, gv = id & 31;
                *(LAS u32x4*)(V + tt * LV + 8 * gv) = rawv[i];
            }
        } else {
            const int d = tid & 127, seg = tid >> 7;
            float lf[16], kv[16], qv[16];
            float run = 0.f;
#pragma unroll
            for (int j = 0; j < 16; ++j) {
                const float lfv = (float)__builtin_bit_cast(_Float16, rawf[j]);
                run += lfv; lf[j] = run;
                kv[j] = 1.0f - fexp(lfv);
                qv[j] = bf2f(rawq[j]);
            }
            segs[seg * 128 + d] = run;
            __syncthreads();
            const float s0 = segs[d], s1 = segs[128 + d], s2 = segs[256 + d], s3 = segs[384 + d];
            const float pre = (seg > 0 ? s0 : 0.f) + (seg > 1 ? s1 : 0.f) + (seg > 2 ? s2 : 0.f);
            const float bref = s0 + s1, bL = bref + s2 + s3;
#pragma unroll
            for (int j = 0; j < 16; ++j) {
                const int t = seg * 16 + j;
                const float bb = pre + lf[j];
                Q[t * LQ + d] = f2bf(qv[j] * fexp(bb - bref));
                Kn[t * LQ + d] = f2bf(kv[j] * fexp(bref - bb));
                KH[t * LQ + d] = f2bf(kv[j] * fexp(bL - bb));
            }
            if (seg == 0) { eL[d] = fexp(bL); eR[d] = fexp(bref); }
#pragma unroll
            for (int i = 0; i < 2; ++i) {
                const int id = tid + 512 * i, tt = id >> 4, gv = id & 15;
                *(LAS u32x4*)(V + tt * LV + 8 * gv) = rawv[i];
            }
        }
        __syncthreads();
        LOAD_RAW(c < 31 ? c + 1 : 31);
        {
            float e0 = 1.f, e1 = 1.f, e2 = 1.f, e3 = 1.f;
            if (HG) { const f32x4 ev = *(const LAS f32x4*)(eR + 16 * wid + 4 * fq); e0 = ev[0]; e1 = ev[1]; e2 = ev[2]; e3 = ev[3]; }
#pragma unroll
            for (int vt = 0; vt < NVT; ++vt) {
                u32x2 w; w.x = pk2(st[vt][0] * e0, st[vt][1] * e1); w.y = pk2(st[vt][2] * e2, st[vt][3] * e3);
                *(LAS u32x2*)(ST + (16 * vt + fr) * LQ + 16 * wid + 4 * fq) = w;
            }
        }
        f32x4 sc[2];
        sc[0] = (f32x4){0.f, 0.f, 0.f, 0.f}; sc[1] = sc[0];
        {
            const int tt = wid >> 1, s0t = (wid & 1) * 2;
#pragma unroll
            for (int ks = 0; ks < 4; ++ks) {
                const bf16x8 afr = ldfrag(Q, LQ, 16 * tt, 32 * ks, fr, fq);
#pragma unroll
                for (int si = 0; si < 2; ++si) { const bf16x8 bfr = ldfrag(Kn, LQ, 16 * (s0t + si), 32 * ks, fr, fq); MMA16(sc[si], bfr, afr); }
            }
            const int t = 16 * tt + fr;
#pragma unroll
            for (int si = 0; si < 2; ++si)
#pragma unroll
                for (int j = 0; j < 4; ++j) {
                    const int s = 16 * (s0t + si) + 4 * fq + j;
                    float v = sc[si][j];
                    if (!HG) v *= 0.08838834764831845f * fexp((float)(t - s) * log_g);
                    sc[si][j] = (s <= t) ? v : 0.f;
                }
        }
        __syncthreads();
        {
            const int tt = wid >> 1, s0t = (wid & 1) * 2, t = 16 * tt + fr;
#pragma unroll
            for (int si = 0; si < 2; ++si) { u32x2 w; w.x = pk2(sc[si][0], sc[si][1]); w.y = pk2(sc[si][2], sc[si][3]);
                *(LAS u32x2*)(P + t * LP + 16 * (s0t + si) + 4 * fq) = w; }
        }
        __syncthreads();
        {
            const int tt = wid & 3, vg = wid >> 2, t = 16 * tt + fr;
            bf16_t* zr = zb + (size_t)(row0 + t) * NZ + gcol;
            bf16_t* orow = (l == 0) ? og_compact(p, HG ? 1 : 0) + (size_t)(row0 + t) * DM + h * DV : zr;
            u32x2 gwv[NV];
#pragma unroll
            for (int i = 0; i < NV; ++i) gwv[i] = *(const u32x2*)(zr + 16 * (vg * NV + i) + 4 * fq);
            f32x4 oa[NV];
#pragma unroll
            for (int i = 0; i < NV; ++i) oa[i] = (f32x4){0.f, 0.f, 0.f, 0.f};
#pragma unroll
            for (int ks = 0; ks < 4; ++ks) {
                const bf16x8 afr = ldfrag(Q, LQ, 16 * tt, 32 * ks, fr, fq);
#pragma unroll
                for (int i = 0; i < NV; ++i) { const bf16x8 bfr = ldfrag(ST, LQ, 16 * (vg * NV + i), 32 * ks, fr, fq); MMA16(oa[i], bfr, afr); }
            }
            if (!HG) { const float qd = fexp((float)(t + 1) * log_g);
#pragma unroll
                for (int i = 0; i < NV; ++i) oa[i] *= qd; }
#pragma unroll
            for (int ks = 0; ks < 2; ++ks) {
                const bf16x8 afr = ldfrag(P, LP, 16 * tt, 32 * ks, fr, fq);
#pragma unroll
                for (int i = 0; i < NV; ++i) { const bf16x8 bfr = ldfrag_tr(V, LV, 16 * (vg * NV + i), 32 * ks, fr, fq); MMA16(oa[i], bfr, afr); }
            }
            float s = 0.f;
#pragma unroll
            for (int i = 0; i < NV; ++i) s += oa[i][0] * oa[i][0] + oa[i][1] * oa[i][1] + oa[i][2] * oa[i][2] + oa[i][3] * oa[i][3];
            s += __shfl_xor(s, 16); s += __shfl_xor(s, 32);
            if (fq == 0) red[vg * 64 + t] = s;
            __syncthreads();
            const float rs = frsq((red[t] + red[64 + t]) * (1.0f / (float)DV) + 1e-6f);
#pragma unroll
            for (int i = 0; i < NV; ++i) {
                const int v = 16 * (vg * NV + i) + 4 * fq;
                const u32x2 gw = gwv[i];
                float n0 = rs, n1 = rs, n2 = rs, n3 = rs;
                if (HG) { const f32x4 hn = *(const f32x4*)(p.in[15] + l * 1024 + h * 128 + v); n0 *= hn[0]; n1 *= hn[1]; n2 *= hn[2]; n3 *= hn[3]; }
                u32x2 w;
                w.x = pk2(oa[i][0] * n0 * siluf_(lo2f(gw.x)), oa[i][1] * n1 * siluf_(hi2f(gw.x)));
                w.y = pk2(oa[i][2] * n2 * siluf_(lo2f(gw.y)), oa[i][3] * n3 * siluf_(hi2f(gw.y)));
                if (!dry) *(u32x2*)(orow + v) = w;
            }
        }
        {
            if (HG) { const f32x4 ev = *(const LAS f32x4*)(eL + 16 * wid + 4 * fq);
#pragma unroll
                for (int vt = 0; vt < NVT; ++vt) st[vt] *= ev; }
            else { const float sd = fexp(64.0f * log_g);
#pragma unroll
                for (int vt = 0; vt < NVT; ++vt) st[vt] *= sd; }
#pragma unroll
            for (int ks = 0; ks < 2; ++ks) {
                const bf16x8 bfr = ldfrag_tr(KH, LQ, 16 * wid, 32 * ks, fr, fq);
#pragma unroll
                for (int vt = 0; vt < NVT; ++vt) { const bf16x8 afr = ldfrag_tr(V, LV, 16 * vt, 32 * ks, fr, fq); MMA16(st[vt], bfr, afr); }
            }
        }
        __syncthreads();
    }
    float* so = p.out + (HG ? O_HGP : O_RETP) + ((size_t)((l * 8 + b) * (HG ? 8 : 4) + h)) * 128 * DV;
#pragma unroll
    for (int vt = 0; vt < NVT; ++vt)
#pragma unroll
        for (int j = 0; j < 4; ++j) so[(size_t)(16 * wid + 4 * fq + j) * DV + 16 * vt + fr] = st[vt][j];
}

__device__ void lru_prompt(const Params& p, int l, int b, int n, LAS unsigned char* lds, int dry) {
    int tid = threadIdx.x; asm volatile("" : "+v"(tid));
    const int wid = __builtin_amdgcn_readfirstlane(tid >> 6), lane = tid & 63, fr = lane & 15, fq = lane >> 4;
    LAS float* XL = (LAS float*)lds;
    LAS bf16_t* XC = (LAS bf16_t*)(lds + 34304);
    LAS float* XCF = (LAS float*)(lds + 51712);
    LAS float* AA = (LAS float*)(lds + 84480);
    LAS float* UU = (LAS float*)(lds + 117248);
    LAS float* segA = (LAS float*)(lds + 150016);
    LAS float* segH = segA + 512;
    LAS float* hc = segH + 512;
    bf16_t* zb = (bf16_t*)(p.ws + WS_Z);
    const int e = tid & 127, seg = tid >> 7, ch = n * 128 + e;
    const float cw0 = p.in[17][(l * 4 + 0) * 1024 + ch], cw1 = p.in[17][(l * 4 + 1) * 1024 + ch], cw2 = p.in[17][(l * 4 + 2) * 1024 + ch], cw3 = p.in[17][(l * 4 + 3) * 1024 + ch];
    const float cb = p.in[18][l * 1024 + ch];
    bf16x8 Ba[4], Bx[4];
    {
        const float* wa = p.in[19] + ((size_t)(l * 8 + n)) * 16384;
        const float* wx = p.in[21] + ((size_t)(l * 8 + n)) * 16384;
#pragma unroll
        for (int ks = 0; ks < 4; ++ks)
#pragma unroll
            for (int j = 0; j < 8; ++j) {
                const int d = 32 * ks + 8 * fq + j;
                Ba[ks][j] = (short)f2bf(wa[d * 128 + 16 * wid + fr]);
                Bx[ks][j] = (short)f2bf(wx[d * 128 + 16 * wid + fr]);
            }
    }
    float ba[4], bx[4], sp[4];
#pragma unroll
    for (int j = 0; j < 4; ++j) {
        const int c2 = n * 128 + 16 * wid + 4 * fq + j;
        ba[j] = p.in[20][l * 1024 + c2]; bx[j] = p.in[22][l * 1024 + c2];
        const float lam = p.in[23][l * 1024 + c2];
        sp[j] = fmaxf(-lam, 0.f) + flog(1.0f + fexp(-fabsf(lam)));
    }
    if (tid < 384) XL[tid] = 0.f;
    if (tid < 128) hc[tid] = 0.f;
    __syncthreads();
    for (int c = 0; c < 32; ++c) {
        const int row0 = b * 2048 + c * 64;
        bf16_t glv[16];
#pragma unroll
        for (int j = 0; j < 16; ++j) glv[j] = zb[(size_t)(row0 + seg * 16 + j) * NZ + ZC_GL + ch];
#pragma unroll
        for (int i = 0; i < 2; ++i) {
            const int id = tid + 512 * i, tt = id >> 4, g = id & 15;
            const u32x4 w = *(const u32x4*)(zb + (size_t)(row0 + tt) * NZ + ZC_XL + n * 128 + 8 * g);
            LAS float* dst = XL + (3 + tt) * 128 + 8 * g;
            *(LAS f32x4*)dst = (f32x4){lo2f(w.x), hi2f(w.x), lo2f(w.y), hi2f(w.y)};
            *(LAS f32x4*)(dst + 4) = (f32x4){lo2f(w.z), hi2f(w.z), lo2f(w.w), hi2f(w.w)};
        }
        __syncthreads();
#pragma unroll 4
        for (int j = 0; j < 16; ++j) {
            const int t = seg * 16 + j;
            const float xc = cb + XL[t * 128 + e] * cw0 + XL[(t + 1) * 128 + e] * cw1 + XL[(t + 2) * 128 + e] * cw2 + XL[(t + 3) * 128 + e] * cw3;
            XCF[t * 128 + e] = xc; XC[t * 136 + e] = f2bf(xc);
        }
        __syncthreads();
#pragma unroll
        for (int tt = 0; tt < 4; ++tt) {
            f32x4 ga = (f32x4){0.f, 0.f, 0.f, 0.f}, gx = ga;
#pragma unroll
            for (int ks = 0; ks < 4; ++ks) { const bf16x8 afr = ldfrag(XC, 136, 16 * tt, 32 * ks, fr, fq); MMA16(ga, Ba[ks], afr); MMA16(gx, Bx[ks], afr); }
            const int t = 16 * tt + fr, e4 = 16 * wid + 4 * fq;
            const f32x4 xv = *(const LAS f32x4*)(XCF + t * 128 + e4);
            f32x4 av, uv;
#pragma unroll
            for (int j = 0; j < 4; ++j) {
                const float r = sigmoidf_(ga[j] + ba[j]), ii = sigmoidf_(gx[j] + bx[j]);
                const float la = -8.0f * r * sp[j];
                av[j] = fexp(la);
                uv[j] = __builtin_amdgcn_sqrtf(1.0f - fexp(2.0f * la)) * ii * xv[j];
            }
            *(LAS f32x4*)(AA + t * 128 + e4) = av; *(LAS f32x4*)(UU + t * 128 + e4) = uv;
        }
        __syncthreads();
        {
            float A = 1.f, H = 0.f;
#pragma unroll 4
            for (int j = 0; j < 16; ++j) { const int t = seg * 16 + j; const float a = AA[t * 128 + e]; H = a * H + UU[t * 128 + e]; A *= a; }
            segA[seg * 128 + e] = A; segH[seg * 128 + e] = H;
        }
        __syncthreads();
        float hh = hc[e];
        for (int s = 0; s < seg; ++s) hh = segA[s * 128 + e] * hh + segH[s * 128 + e];
#pragma unroll
        for (int j = 0; j < 16; ++j) {
            const int t = seg * 16 + j;
            hh = AA[t * 128 + e] * hh + UU[t * 128 + e];
            bf16_t* zp = (l == 0) ? og_compact(p, 2) + (size_t)(row0 + t) * DM + ch : zb + (size_t)(row0 + t) * NZ + ZC_GL + ch;
            if (!dry) *zp = f2bf(hh * geluf_(bf2f(glv[j])));
        }
        __syncthreads();
        if (seg == 3) hc[e] = hh;
        if (seg == 0) { XL[e] = XL[64 * 128 + e]; XL[128 + e] = XL[65 * 128 + e]; XL[256 + e] = XL[66 * 128 + e]; }
        __syncthreads();
    }
    if (seg == 0) {
        p.out[O_LRUP + (size_t)(l * 8 + b) * 1024 + ch] = hc[e];
#pragma unroll
        for (int i = 0; i < 3; ++i) p.out[O_CVP + ((size_t)(l * 8 + b) * 3 + i) * 1024 + ch] = XL[i * 128 + e];
    }
    __syncthreads();
}

template <bool HG>
__device__ void linattn_sample(const Params& p, int l, int b, int h, LAS unsigned char* lds, int dry) {
    constexpr int DV = HG ? 128 : 256, NVG = DV / 4, NPART = 512 / NVG, DPP = 128 / NPART;
    int tid = threadIdx.x; asm volatile("" : "+v"(tid));
    LAS float* qs = (LAS float*)lds;
    LAS float* ks = qs + 512;
    LAS float* fs = ks + 512;
    LAS float* vs = fs + 512;
    LAS float* op = vs + 4 * DV;
    LAS float* red = op + NPART * 4 * DV;
    bf16_t* zb = (bf16_t*)(p.ws + WS_Z);
    const int rowb = T_P + 4 * b;
    const float gam = HG ? 1.f : (1.0f - exp2f(-5.0f - (float)h));
    if (!HG) {
        if (tid < 256) {
            const int t = tid >> 6, i = tid & 63;
            const bf16_t* zr = zb + (size_t)(rowb + t) * NZ;
            qs[t * 128 + i] = bf2f(zr[ZC_QR + h * 128 + i]); qs[t * 128 + 64 + i] = bf2f(zr[ZC_QR + h * 128 + 64 + i]);
            ks[t * 128 + i] = bf2f(zr[ZC_KR + h * 128 + i]) * 0.08838834764831845f; ks[t * 128 + 64 + i] = bf2f(zr[ZC_KR + h * 128 + 64 + i]) * 0.08838834764831845f;
        }
#pragma unroll
        for (int i = 0; i < 2; ++i) { const int id = tid + 512 * i, t = id >> 8, v = id & 255; vs[t * 256 + v] = bf2f(zb[(size_t)(rowb + t) * NZ + ZC_VR + h * 256 + v]); }
    } else {
        const int t = tid >> 7, d = tid & 127;
        const bf16_t* zr = zb + (size_t)(rowb + t) * NZ;
        const float fv = fexp((float)__builtin_bit_cast(_Float16, zr[ZC_FH + h * 128 + d]));
        fs[t * 128 + d] = fv;
        ks[t * 128 + d] = 1.0f - fv;
        qs[t * 128 + d] = bf2f(zr[ZC_QH + h * 128 + d]);
        vs[t * 128 + d] = bf2f(zr[ZC_IH + h * 128 + d]);
    }
    const int vg = tid % NVG, part = tid / NVG;
    const size_t sbase = ((size_t)((l * 128 + b) * (HG ? 8 : 4) + h)) * 128 * DV;
    const float* Sin = (HG ? p.in[3] : p.in[2]) + sbase + (size_t)(part * DPP) * DV + 4 * vg;
    float* Sout = p.out + (HG ? O_HGS : O_RETS) + sbase + (size_t)(part * DPP) * DV + 4 * vg;
    f32x4 S[DPP];
#pragma unroll
    for (int i = 0; i < DPP; ++i) S[i] = __builtin_nontemporal_load((const f32x4*)(Sin + (size_t)i * DV));
    __syncthreads();
    {
        const f32x4 v0 = *(const LAS f32x4*)(vs + 4 * vg), v1 = *(const LAS f32x4*)(vs + DV + 4 * vg), v2 = *(const LAS f32x4*)(vs + 2 * DV + 4 * vg), v3 = *(const LAS f32x4*)(vs + 3 * DV + 4 * vg);
        f32x4 o0 = (f32x4){0.f, 0.f, 0.f, 0.f}, o1 = o0, o2 = o0, o3 = o0;
#pragma unroll
        for (int i = 0; i < DPP; ++i) {
            const int d = part * DPP + i;
            const float f0 = HG ? fs[d] : gam, f1 = HG ? fs[128 + d] : gam, f2 = HG ? fs[256 + d] : gam, f3 = HG ? fs[384 + d] : gam;
            f32x4 Sv = S[i];
            Sv = Sv * f0 + v0 * ks[d]; o0 += Sv * qs[d];
            Sv = Sv * f1 + v1 * ks[128 + d]; o1 += Sv * qs[128 + d];
            Sv = Sv * f2 + v2 * ks[256 + d]; o2 += Sv * qs[256 + d];
            Sv = Sv * f3 + v3 * ks[384 + d]; o3 += Sv * qs[384 + d];
            S[i] = Sv;
            if ((i & 3) == 3) asm volatile("" ::: "memory");
        }
#pragma unroll
        for (int i = 0; i < DPP; ++i) __builtin_nontemporal_store(S[i], (f32x4*)(Sout + (size_t)i * DV));
        *(LAS f32x4*)(op + (part * 4 + 0) * DV + 4 * vg) = o0; *(LAS f32x4*)(op + (part * 4 + 1) * DV + 4 * vg) = o1;
        *(LAS f32x4*)(op + (part * 4 + 2) * DV + 4 * vg) = o2; *(LAS f32x4*)(op + (part * 4 + 3) * DV + 4 * vg) = o3;
    }
    __syncthreads();
    {
        const int t = tid >> 7, vv = tid & 127;
        constexpr int NPT = DV / 128;
        const int gcol = HG ? ZC_GH + h * 128 : ZC_GR + h * 256;
        bf16_t* zr = zb + (size_t)(rowb + t) * NZ + gcol;
        float o[NPT], gv[NPT]; float s = 0.f;
#pragma unroll
        for (int i = 0; i < NPT; ++i) { const int v = vv + 128 * i; float a = 0.f;
            gv[i] = bf2f(zr[v]);
#pragma unroll
            for (int q = 0; q < NPART; ++q) a += op[(q * 4 + t) * DV + v];
            o[i] = a; s += a * a; }
#pragma unroll
        for (int off = 32; off >= 1; off >>= 1) s += __shfl_xor(s, off);
        if ((tid & 63) == 0) red[tid >> 6] = s;
        __syncthreads();
        const float rs = frsq((red[2 * t] + red[2 * t + 1]) * (1.0f / (float)DV) + 1e-6f);
#pragma unroll
        for (int i = 0; i < NPT; ++i) { const int v = vv + 128 * i;
            float nrm = rs; if (HG) nrm *= p.in[15][l * 1024 + h * 128 + v];
            const bf16_t ov = f2bf(o[i] * nrm * siluf_(gv[i])); if (!dry) zr[v] = ov; }
    }
    __syncthreads();
}

__device__ void lru_sample(const Params& p, int l, int b, LAS unsigned char* lds, int dry) {
    int tid = threadIdx.x; asm volatile("" : "+v"(tid));
    LAS float* XX = (LAS float*)lds;
    LAS float* XC = XX + 7 * 1024;
    bf16_t* zb = (bf16_t*)(p.ws + WS_Z);
    float cv[6]; bf16_t xr[8];
#pragma unroll
    for (int i = 0; i < 6; ++i) cv[i] = p.in[5][(size_t)(l * 128 + b) * 3072 + tid + 512 * i];
#pragma unroll
    for (int i = 0; i < 8; ++i) { const int e = tid + 512 * i; xr[i] = zb[(size_t)(T_P + 4 * b + (e >> 10)) * NZ + ZC_XL + (e & 1023)]; }
    float cw[2][4], cb[2], ba[2], bx[2], lam[2], h0[2]; bf16_t glv[2][4];
#pragma unroll
    for (int cc = 0; cc < 2; ++cc) {
        const int ch = tid + 512 * cc;
#pragma unroll
        for (int k = 0; k < 4; ++k) { cw[cc][k] = p.in[17][(l * 4 + k) * 1024 + ch]; glv[cc][k] = zb[(size_t)(T_P + 4 * b + k) * NZ + ZC_GL + ch]; }
        cb[cc] = p.in[18][l * 1024 + ch]; ba[cc] = p.in[20][l * 1024 + ch]; bx[cc] = p.in[22][l * 1024 + ch]; lam[cc] = p.in[23][l * 1024 + ch];
        h0[cc] = p.in[4][(size_t)(l * 128 + b) * 1024 + ch];
    }
#pragma unroll
    for (int i = 0; i < 6; ++i) XX[tid + 512 * i] = cv[i];
#pragma unroll
    for (int i = 0; i < 8; ++i) XX[3072 + tid + 512 * i] = bf2f(xr[i]);
    __syncthreads();
#pragma unroll
    for (int cc = 0; cc < 2; ++cc) {
        const int ch = tid + 512 * cc;
#pragma unroll
        for (int t = 0; t < 4; ++t) {
            float xc = cb[cc];
#pragma unroll
            for (int k = 0; k < 4; ++k) xc += XX[(t + k) * 1024 + ch] * cw[cc][k];
            XC[t * 1024 + ch] = xc;
        }
    }
    __syncthreads();
#pragma unroll 1
    for (int cc = 0; cc < 2; ++cc) {
        const int ch = tid + 512 * cc, n = ch >> 7, e = ch & 127;
        const float* wa = p.in[19] + ((size_t)(l * 8 + n)) * 16384 + e;
        const float* wx = p.in[21] + ((size_t)(l * 8 + n)) * 16384 + e;
        float ga[4], gx[4];
#pragma unroll
        for (int k = 0; k < 4; ++k) { ga[k] = 0.f; gx[k] = 0.f; }
#pragma unroll 1
        for (int d0 = 0; d0 < 128; d0 += 16) {
            float av[16], xv[16];
#pragma unroll
            for (int i = 0; i < 16; ++i) { av[i] = wa[(d0 + i) * 128]; xv[i] = wx[(d0 + i) * 128]; }
#pragma unroll
            for (int i = 0; i < 16; ++i)
#pragma unroll
                for (int k = 0; k < 4; ++k) { const float v = XC[k * 1024 + n * 128 + d0 + i]; ga[k] += v * av[i]; gx[k] += v * xv[i]; }
        }
        const float bav = cc == 0 ? ba[0] : ba[1], bxv = cc == 0 ? bx[0] : bx[1], lamv = cc == 0 ? lam[0] : lam[1];
        const float sp = fmaxf(-lamv, 0.f) + flog(1.0f + fexp(-fabsf(lamv)));
        float hh = cc == 0 ? h0[0] : h0[1];
#pragma unroll
        for (int t = 0; t < 4; ++t) {
            const float r = sigmoidf_(ga[t] + bav), ii = sigmoidf_(gx[t] + bxv);
            const float la = -8.0f * r * sp;
            const float a = fexp(la), u = __builtin_amdgcn_sqrtf(1.0f - fexp(2.0f * la)) * ii * XC[t * 1024 + ch];
            hh = a * hh + u;
            const bf16_t gl = cc == 0 ? glv[0][t] : glv[1][t];
            if (!dry) zb[(size_t)(T_P + 4 * b + t) * NZ + ZC_GL + ch] = f2bf(hh * geluf_(bf2f(gl)));
        }
        p.out[O_LRUS + (size_t)(l * 128 + b) * 1024 + ch] = hh;
#pragma unroll
        for (int r = 0; r < 3; ++r) p.out[O_CVS + ((size_t)(l * 128 + b) * 3 + r) * 1024 + ch] = XX[(4 + r) * 1024 + ch];
    }
    __syncthreads();
}

__device__ void chain_items(const Params& p, int l, LAS unsigned char* lds) {
    int bid = blockIdx.x; asm volatile("" : "+s"(bid));
    if (bid < 32) linattn_prompt<false>(p, l, bid >> 2, bid & 3, lds, 0);
    else if (bid < 96) linattn_prompt<true>(p, l, (bid - 32) >> 3, (bid - 32) & 7, lds, 0);
    else if (bid < 160) {
        lru_prompt(p, l, (bid - 96) >> 3, (bid - 96) & 7, lds, 0);
    }
}
__device__ __forceinline__ void sample_item(const Params& p, int l, int it, LAS unsigned char* lds) {
    if (it >= 1152) linattn_sample<false>(p, l, (it - 1152) >> 2, (it - 1152) & 3, lds, 0);
    else if (it >= 128) linattn_sample<true>(p, l, (it - 128) >> 3, (it - 128) & 7, lds, 0);
    else lru_sample(p, l, it, lds, 0);
}
__device__ void sample_items(const Params& p, int l, LAS unsigned char* lds, int Gx, int cx) {
    if (Gx == 256) {
        if (cx < 128) { for (int k = 0; k < 5; ++k) sample_item(p, l, k == 0 ? cx : 128 + cx + 128 * (k - 1), lds); }
        else { for (int k = 0; k < 8; ++k) sample_item(p, l, 640 + (cx - 128) + 128 * k, lds); }
    } else {
        for (int it = cx; it < 1664; it += Gx) sample_item(p, l, it, lds);
    }
}

__device__ void fin_x(const Params& p, float* sst, float scale, int Gx, int cx) {
    float* x = p.out; bf16_t* xb = (bf16_t*)(p.ws + WS_XB); const float* pb = (const float*)(p.ws + WS_MF);
    int tid = threadIdx.x; asm volatile("" : "+v"(tid));
    const int wid = tid >> 6, lane = tid & 63;
    for (int row = T_P + cx * 8 + wid; row < T_ALL; row += Gx * 8) {
        float s = 0.f;
#pragma unroll
        for (int i = 0; i < 4; ++i) {
            const int c = i * 256 + lane * 4;
            const f32x4 p0 = *(const f32x4*)(pb + (size_t)(row - T_P) * DM + c), p1 = *(const f32x4*)(pb + (size_t)(512 + row - T_P) * DM + c);
            const f32x4 v = *(const f32x4*)(x + (size_t)row * DM + c) + (p0 + p1) * scale;
            *(f32x4*)(x + (size_t)row * DM + c) = v;
            u32x2 w; w.x = pk2(v[0], v[1]); w.y = pk2(v[2], v[3]);
            *(u32x2*)(xb + (size_t)row * DM + c) = w;
            s += v[0] * v[0] + v[1] * v[1] + v[2] * v[2] + v[3] * v[3];
        }
#pragma unroll
        for (int o = 32; o >= 1; o >>= 1) s += __shfl_xor(s, o);
        if (lane == 0) sst[row] = s;
    }
}
__device__ void fin_m(const Params& p, int l, int Gx, int cx) {
    float* mf = (float*)(p.ws + WS_MF); bf16_t* zb = (bf16_t*)(p.ws + WS_Z);
    const float* mb = p.in[12] + l * 3 * DM;
    int tid = threadIdx.x; asm volatile("" : "+v"(tid));
    const int wid = tid >> 6, lane = tid & 63;
    for (int r = cx * 8 + wid; r < T_ALL - T_P; r += Gx * 8) {
        bf16_t* zr = zb + (size_t)(T_P + r) * NZ;
#pragma unroll
        for (int i = 0; i < 4; ++i) {
            const int c = i * 256 + lane * 4;
            f32x4 o = (f32x4){0.f, 0.f, 0.f, 0.f};
#pragma unroll
            for (int br = 0; br < 3; ++br) {
                float* pm = mf + ((size_t)br * 512 + r) * DM + c;
                const f32x4 v = *(const f32x4*)pm;
                const u32x2 gw = *(const u32x2*)(zr + ZC_GATE + br * DM + c);
                const f32x4 bb = *(const f32x4*)(mb + br * DM + c);
                o[0] += sigmoidf_(lo2f(gw.x) + bb[0]) * v[0]; o[1] += sigmoidf_(hi2f(gw.x) + bb[1]) * v[1];
                o[2] += sigmoidf_(lo2f(gw.y) + bb[2]) * v[2]; o[3] += sigmoidf_(hi2f(gw.y) + bb[3]) * v[3];
            }
            u32x2 w; w.x = pk2(o[0], o[1]); w.y = pk2(o[2], o[3]);
            *(u32x2*)(zr + c) = w;
        }
    }
}

__device__ __forceinline__ void gbar(unsigned* bar, unsigned& gen, unsigned nblk) {
    asm volatile("s_waitcnt vmcnt(0)" ::: "memory");
    __syncthreads();
    if (threadIdx.x == 0) {
        __builtin_amdgcn_fence(__ATOMIC_RELEASE, "agent");
        asm volatile("s_waitcnt vmcnt(0)" ::: "memory");
        const unsigned target = (gen + 1u) * nblk;
        __hip_atomic_fetch_add(bar, 1u, __ATOMIC_RELAXED, __HIP_MEMORY_SCOPE_AGENT);
        while (__hip_atomic_load(bar, __ATOMIC_RELAXED, __HIP_MEMORY_SCOPE_AGENT) < target) __builtin_amdgcn_s_sleep(1);
        __builtin_amdgcn_fence(__ATOMIC_ACQUIRE, "agent");
        asm volatile("s_waitcnt vmcnt(0)" ::: "memory");
    }
    gen += 1u;
    __syncthreads();
}


__global__ void __launch_bounds__(512) fwd_megakernel(Params p) {
    extern __shared__ __attribute__((aligned(16))) unsigned char smem_raw[];
    LAS unsigned char* lds = (LAS unsigned char*)smem_raw;
    cg::grid_group grid = cg::this_grid();
    using namespace pg8;
    const int G = gridDim.x, c = blockIdx.x;
    bf16_t* wb = (bf16_t*)(p.ws + WS_W);
    bf16_t* xb = (bf16_t*)(p.ws + WS_XB);
    bf16_t* zb = (bf16_t*)(p.ws + WS_Z);
    float* ss = (float*)(p.ws + WS_SS);
    float* x = p.out;

    constexpr int NCHAIN = 160;
    unsigned* gbar_w = (unsigned*)(p.ws + WS_BAR); unsigned bgen = 0u, sgen = 0u;
    bf16_t* hids = (bf16_t*)(p.ws + WS_HIDS) - (size_t)T_P * FH;
    phase0(p, lds);
    grid.sync();
#pragma unroll 1
    for (int l = 0; l < 2; ++l) {
        bf16_t* wl = wb + (size_t)l * W_LAYER;
        bf16_t* mrg = (l == 0) ? (bf16_t*)(p.out + O_RETS + (size_t)128 * 4 * 128 * 256) : wb;
#pragma unroll 1
        for (int seg = 0; seg < 3; ++seg) {
            const int role_s = __builtin_amdgcn_readfirstlane((seg == 1 && c >= NCHAIN) ? 1 : 0);
            const int nsteps = (seg == 0) ? 5 : (seg == 2) ? 4 : (role_s ? 7 : 1);
            int Gx = role_s ? (G - NCHAIN) : G, cx = role_s ? (c - NCHAIN) : c;
#pragma unroll 1
            for (int idx = 0; idx < nsteps; ++idx) {
                asm volatile("" : "+s"(Gx), "+s"(cx));
                int op, f = 0, kx = 1, rows = 0;
                if (seg == 0) { op = (idx == 0) ? 0 : (idx == 1) ? 1 : (idx == 2) ? 8 : (idx == 3) ? 2 : 6; rows = (idx == 0 || idx == 3) ? 2 : 0; }
                else if (seg == 2) { op = (idx == 0) ? 4 : (idx == 1) ? 5 : (idx == 2) ? 0 : 1; f = idx >= 2; }
                else if (!role_s) op = 3;
                else { op = (idx == 0) ? 9 : (idx == 1) ? 10 : (idx == 2) ? 11 : (idx == 3 || idx == 6) ? 8 : (idx == 4) ? 0 : 7; f = idx >= 4; kx = (idx == 3) ? 2 : 3; rows = 1; }
                op = __builtin_amdgcn_readfirstlane(op); f = __builtin_amdgcn_readfirstlane(f); kx = __builtin_amdgcn_readfirstlane(kx); rows = __builtin_amdgcn_readfirstlane(rows);
                const int Mx = (rows == 2) ? T_ALL : (rows == 1) ? (T_ALL - T_P) : T_P, pm0 = (rows == 1) ? (T_P / 256) : 0;
#pragma unroll 1
                for (int rep = 0; rep < ((seg == 0 && idx == 1) ? 2 : 1); ++rep) {
                if (rep == 1) op = 7;
                if (op == 0) {
                    Gemm g{xb, xb, xb, wl + (f == 0 ? OFF_GU1 : OFF_GU2), 0, DM, DM, DM}; StaticOrder so; so.init(Mx, 2 * FH, Gx, cx, pm0);
                    EpiUp e{zb, hids, ss + (size_t)(3 * l + 2 * f) * T_ALL}; gemm_phase(lds, g, so, e);
                } else if (op == 1) {
                    Gemm g{zb, zb, zb, wl + (f == 0 ? OFF_D1 : OFF_D2), 0, FH, FH, FH}; StaticOrder so; so.init(Mx, DM, Gx, cx, pm0);
                    EpiRes e{x, xb, ss + (size_t)(3 * l + 2 * f + 1) * T_ALL, 0.5f, 0}; gemm_phase(lds, g, so, e);
                } else if (op == 2) {
                    Gemm g{xb, xb, xb, wl + OFF_WIN, 0, DM, DM, DM}; StaticOrder so; so.init(Mx, NZ, Gx, cx, pm0);
                    EpiWin e{zb, ss + (size_t)(3 * l + 1) * T_ALL, l == 1 ? (const float*)(p.ws + WS_LB) : (const float*)nullptr, (const float2*)(p.ws + WS_ROPE)}; gemm_phase(lds, g, so, e);
                } else if (op == 3) {
                    chain_items(p, l, lds);
                } else if (op == 4) {
                    Gemm g{l == 0 ? og_compact(p, 0) : zb + ZC_GR, l == 0 ? og_compact(p, 1) : zb + ZC_GH, l == 0 ? og_compact(p, 2) : zb + ZC_GL, wl + OFF_RO, (size_t)DM * DM, l == 0 ? DM : NZ, DM, DM}; BranchOrder bo; bo.so.init(Mx, DM, Gx, cx, pm0);
                    EpiBranch e{zb, mrg, p.in[12] + l * 3 * DM, 0}; gemm_phase(lds, g, bo, e);
                } else if (op == 5) {
                    Gemm g{mrg, mrg, mrg, wl + OFF_MO, 0, DM, DM, DM}; StaticOrder so; so.init(Mx, DM, Gx, cx, pm0);
                    EpiRes e{x, xb, ss + (size_t)(3 * l + 2) * T_ALL, 1.0f, 0}; gemm_phase(lds, g, so, e);
                } else if (op == 6) {
                    sample_items(p, l, lds, Gx, cx);
                } else if (op == 7 || op == 9 || op == 11) {
                    const bool dn = (op == 7), brn = (op == 9);
                    const int klen = dn ? 1408 : (brn ? 1024 : 512);
                    Gemm g{dn ? hids : (brn ? zb + ZC_GR : zb), zb + ZC_GH, zb + ZC_GL, wl + (dn ? (f == 0 ? OFF_D1 : OFF_D2) : (brn ? OFF_RO : OFF_MO)), (size_t)DM * DM, dn ? FH : NZ, dn ? FH : DM, klen};
                    SplitOrder so{2, 4, brn ? 3 : 1, brn ? 1 : 2, klen, Gx, cx, T_P / 256};
                    EpiStoreP e{(float*)(p.ws + WS_MF), klen, brn ? 1 : 2}; gemm_phase(lds, g, so, e);
                } else if (op == 8) {
                    fin_x(p, ss + (size_t)(3 * l + kx) * T_ALL, kx == 2 ? 1.0f : 0.5f, Gx, cx);
                } else {
                    fin_m(p, l, Gx, cx);
                }
                }
                if (seg == 1) { if (role_s && idx + 1 < nsteps) gbar(gbar_w + 64, sgen, (unsigned)(G - NCHAIN)); }
                else gbar(gbar_w, bgen, (unsigned)G);
            }
            if (seg == 1 && l == 0) {
                unsigned* qctr = (unsigned*)(p.ws + WS_CTR) + 8;
                LAS unsigned* slot = (LAS unsigned*)(lds + LDS_BYTES - 16);
                for (;;) {
                    __syncthreads();
                    if (threadIdx.x == 0) *slot = atomicAdd(qctr, 1u);
                    __syncthreads();
                    const int ti = __builtin_amdgcn_readfirstlane((int)*slot);
                    if (ti >= 2080) break;
                    conv_job(p, 2080 + ti, (LAS float*)lds);
                }
            }
            if (seg == 1) {
                gbar(gbar_w, bgen, (unsigned)G);
            }
        }
    }
    {
        const float* ssf = ss + (size_t)6 * T_ALL;
        int tid = threadIdx.x; asm volatile("" : "+v"(tid));
        const int wid = tid >> 6, lane = tid & 63;
        for (int row = c * 8 + wid; row < T_ALL; row += G * 8) {
            const float r = frsq(ssf[row] * (1.0f / 1024.0f) + 1e-6f);
#pragma unroll
            for (int i = 0; i < 4; ++i) {
                const int col = i * 256 + lane * 4;
                f32x4 v = *(f32x4*)(x + (size_t)row * DM + col);
                const f32x4 gn = *(const f32x4*)(p.in[30] + col);
                v = v * r * gn;
                *(f32x4*)(x + (size_t)row * DM + col) = v;
            }
        }
    }
}

extern "C" void kernel_launch(void* const* d_in, const int* in_sizes, int n_in, void* d_out, int out_size, void* d_ws, size_t ws_size, hipStream_t stream) {
    static int grid = 0;
    if (grid == 0) {
        if (n_in != 31 || ws_size < WS_END) { fprintf(stderr, "kernel_launch: need 31 inputs and %zu bytes of workspace (got %d, %zu)\n", (size_t)WS_END, n_in, ws_size); grid = -1; return; }
        int dev = 0, cus = 0, per_cu = 0;
        hipGetDevice(&dev);
        hipDeviceGetAttribute(&cus, hipDeviceAttributeMultiprocessorCount, dev);
        if (hipFuncSetAttribute((const void*)fwd_megakernel, hipFuncAttributeMaxDynamicSharedMemorySize, LDS_BYTES) != hipSuccess) { fprintf(stderr, "kernel_launch: hipFuncSetAttribute failed\n"); grid = -1; return; }
        hipOccupancyMaxActiveBlocksPerMultiprocessor(&per_cu, (const void*)fwd_megakernel, 512, LDS_BYTES);
        if (per_cu < 1) { fprintf(stderr, "kernel_launch: occupancy query says %d blocks per CU\n", per_cu); per_cu = 1; }
        (void)hipGetLastError();
        grid = cus;
    }
    if (grid < 0) return;
    if (hipMemsetAsync((char*)d_ws + WS_BAR, 0, 512, stream) != hipSuccess) { fprintf(stderr, "kernel_launch: memset failed\n"); return; }
    Params p{};
    for (int i = 0; i < 31; ++i) p.in[i] = (const float*)d_in[i];
    p.out = (float*)d_out; p.ws = (unsigned char*)d_ws;
    void* args[] = {&p};
    hipError_t e = hipLaunchCooperativeKernel((const void*)fwd_megakernel, dim3(grid), dim3(512), args, LDS_BYTES, stream);
    if (e != hipSuccess) fprintf(stderr, "cooperative launch failed: %s (grid %d)\n", hipGetErrorString(e), grid);
}
```

```cpp
#include <hip/hip_runtime.h>
#include <hip/hip_cooperative_groups.h>
#include <cstdio>
namespace cg = cooperative_groups;

#define LAS __attribute__((address_space(3)))
typedef unsigned short bf16_t;
typedef short bf16x8 __attribute__((ext_vector_type(8)));
typedef short s16x4 __attribute__((ext_vector_type(4)));
typedef float f32x4 __attribute__((ext_vector_type(4)));
typedef unsigned u32x4 __attribute__((ext_vector_type(4)));
typedef unsigned u32x2 __attribute__((ext_vector_type(2)));

constexpr int T_ALL = 16896, T_P = 16384, DM = 1024, FH = 2816, NZ = 12288;
constexpr int LDS_BYTES = 163840;
constexpr size_t OFF_GU1 = 0, OFF_D1 = 5767168, OFF_WIN = 8650752, OFF_RO = 21233664, OFF_HO = 22282240, OFF_LO = 23330816,
                 OFF_MO = 24379392, OFF_GU2 = 25427968, OFF_D2 = 31195136, W_LAYER = 34078720;
constexpr size_t WS_W = 0, WS_XB = 2 * W_LAYER * 2, WS_Z = WS_XB + (size_t)T_ALL * DM * 2, WS_SS = WS_Z + (size_t)T_ALL * NZ * 2,
                 WS_ROPE = WS_SS + (size_t)8 * T_ALL * 4, WS_CTR = WS_ROPE + (size_t)2052 * 64 * 8, WS_BAR = WS_CTR + 256, WS_LB = WS_BAR + 512, WS_HIDS = WS_LB + 4096, WS_MF = WS_HIDS + (size_t)512 * FH * 2, WS_TS = WS_MF + (size_t)11 * 512 * DM * 4, WS_END = WS_TS + 4096;
constexpr int ZC_QR = 0, ZC_KR = 512, ZC_VR = 1024, ZC_GR = 2048, ZC_QH = 3072, ZC_FH = 4096, ZC_IH = 5120, ZC_GH = 6144, ZC_XL = 7168, ZC_GL = 8192, ZC_GATE = 9216;
constexpr size_t O_RETP = 17301504, O_RETS = 19398656, O_HGP = 52953088, O_HGS = 55050240, O_LRUP = 88604672, O_LRUS = 88621056, O_CVP = 88883200, O_CVS = 88932352;

struct Params { const float* in[31]; float* out; unsigned char* ws; };

__device__ __forceinline__ float bf2f(bf16_t b) { return __uint_as_float(((unsigned)b) << 16); }
__device__ __forceinline__ unsigned pk2(float lo, float hi) { unsigned r; asm("v_cvt_pk_bf16_f32 %0, %1, %2" : "=v"(r) : "v"(lo), "v"(hi)); return r; }
__device__ __forceinline__ bf16_t f2bf(float f) { return (bf16_t)(pk2(f, f) & 0xffffu); }
__device__ __forceinline__ float lo2f(unsigned w) { return __uint_as_float(w << 16); }
__device__ __forceinline__ float hi2f(unsigned w) { return __uint_as_float(w & 0xffff0000u); }
__device__ __forceinline__ float fexp(float x) { return __builtin_amdgcn_exp2f(x * 1.4426950408889634f); }
__device__ __forceinline__ float flog(float x) { return __builtin_amdgcn_logf(x) * 0.6931471805599453f; }
__device__ __forceinline__ float sigmoidf_(float x) { return __builtin_amdgcn_rcpf(1.0f + fexp(-x)); }
__device__ __forceinline__ float siluf_(float x) { return x * __builtin_amdgcn_rcpf(1.0f + fexp(-x)); }
__device__ __forceinline__ float geluf_(float x) { const float y = 0.7978845608028654f * (x + 0.044715f * x * x * x); const float e = fexp(2.0f * y); const float th = 1.0f - 2.0f * __builtin_amdgcn_rcpf(e + 1.0f); return 0.5f * x * (1.0f + th); }
__device__ __forceinline__ float frsq(float x) { return __builtin_amdgcn_rsqf(x); }

namespace pg8 {
constexpr int BM = 256, BK = 64, HALF = 128, HTB = HALF * BK * 2, NXCD = 8, WGM = 8;
__device__ __forceinline__ int lds_byte(int r, int c) { const int st = (r >> 4) * 2 + (c >> 5), rr = r & 15, cc = c & 31, ob = rr * 64 + cc * 2; return st * 1024 + (ob ^ (((ob >> 9) & 1) << 5)); }
__device__ __forceinline__ void stage_rc(int b, int& R, int& C) { const int st = b / 1024, sb = b % 1024, swz = sb ^ (((sb >> 9) & 1) << 5); R = (st >> 1) * 16 + swz / 64; C = (st & 1) * 32 + (swz % 64) / 2; }
__device__ __forceinline__ int perm32(int rho) { const int n = rho >> 4, i = rho & 15; return 8 * (i >> 2) + 4 * n + (i & 3); }

struct Unit { int pm, pn, br, kofs; };
struct Gemm { const bf16_t* A0; const bf16_t* A1; const bf16_t* A2; const bf16_t* B0; size_t bstride; int lda, ldb, K; };

struct StaticOrder {
    int nM, nN, nwg, G, c, pm0;
    __device__ void init(int M, int N, int G_, int c_, int pm0_) { nM = M / BM; nN = N / BM; nwg = nM * nN; G = G_; c = c_; pm0 = pm0_; }
    __device__ bool next(int i, Unit& u) const {
        const long L = (long)i * G + c; if (L >= nwg) return false;
        int wgid = (int)L; { const int q = nwg / NXCD, r = nwg % NXCD, xcd = wgid % NXCD, off = wgid / NXCD; wgid = (xcd < r ? xcd * (q + 1) : r * (q + 1) + (xcd - r) * q) + off; }
        const int nig = WGM * nN, gid = wgid / nig, fm = gid * WGM, gsz = (nM - fm) < WGM ? (nM - fm) : WGM;
        u.pm = pm0 + fm + ((wgid % nig) % gsz); u.pn = (wgid % nig) / gsz; u.br = 0; u.kofs = 0; return true;
    }
};
struct SplitOrder {
    int nM, nN, nbr, nsplit, klen, G, c, pm0;
    __device__ bool next(int i, Unit& u) const {
        const int L = i * G + c; if (L >= nM * nN * nbr * nsplit) return false;
        const int ks = L % nsplit, r = L / nsplit; u.br = r % nbr; const int t = r / nbr; u.pm = pm0 + t % nM; u.pn = t / nM; u.kofs = ks * klen; return true;
    }
};
struct BranchOrder {
    StaticOrder so;
    __device__ bool next(int i, Unit& u) const { if (!so.next(i / 3, u)) return false; u.br = i % 3; return true; }
};

template <class Epi, class Sched>
__device__ __forceinline__ void gemm_phase(LAS unsigned char* lds, const Gemm g, const Sched& S, const Epi& E) {
    int tid = threadIdx.x; asm volatile("" : "+v"(tid));
    const int wid = __builtin_amdgcn_readfirstlane(tid >> 6), lane = tid & 63, wr = wid >> 2, wc = wid & 3, fr = lane & 15, fq = lane >> 4;
    const int K = g.ldb, nt = g.K / BK, lda = g.lda;
    unsigned voffA[2], voffB[2];
#pragma unroll
    for (int i = 0; i < 2; ++i) { int R, C; stage_rc(tid * 16 + i * 8192, R, C); const int Rb = Epi::PERM ? ((R & ~31) + perm32(R & 31)) : R;
        voffA[i] = (unsigned)(R * lda + C) * 2u; voffB[i] = (unsigned)(Rb * K + C) * 2u; }
    const size_t kstep = (size_t)(BK * 2);
    const size_t hstepA = (size_t)HALF * lda * 2, hstepB = (size_t)HALF * K * 2;
    const size_t tstepA = 2 * hstepA, tstepB = 2 * hstepB;
    const unsigned ldsw = (unsigned)wid * 1024u;
    const int aoff = lds_byte(wr * 64 + fr, fq * 8), boff = lds_byte(wc * 32 + fr, fq * 8);
#define PG8_SA(b, h) (((b) * 2 + (h)) * HTB)
#define PG8_SB(b, h) ((4 + (b) * 2 + (h)) * HTB)
#define PG8_STAGE(bufoff, gbase, voff) do { _Pragma("unroll") for (int _i = 0; _i < 2; ++_i) \
        __builtin_amdgcn_global_load_lds((const unsigned*)((const char*)(gbase) + (voff)[_i]), (LAS unsigned*)(lds + (bufoff) + ldsw + _i * 8192), 16, 0, 0); } while (0)
#define PG8_LDA(dst, b, h) do { _Pragma("unroll") for (int m = 0; m < 4; ++m) _Pragma("unroll") for (int k = 0; k < 2; ++k) dst[m][k] = *(const LAS bf16x8*)(lds + PG8_SA(b, h) + aoff + m * 2048 + k * 1024); } while (0)
#define PG8_LDB(dst, b, h) do { _Pragma("unroll") for (int n = 0; n < 2; ++n) _Pragma("unroll") for (int k = 0; k < 2; ++k) dst[n][k] = *(const LAS bf16x8*)(lds + PG8_SB(b, h) + boff + n * 2048 + k * 1024); } while (0)
#define PG8_MMA(ai, bj, At, Bt) do { __builtin_amdgcn_s_setprio(1); _Pragma("unroll") for (int m = 0; m < 4; ++m) _Pragma("unroll") for (int n = 0; n < 2; ++n) _Pragma("unroll") for (int k = 0; k < 2; ++k) \
        acc[ai][bj][m][n] = __builtin_amdgcn_mfma_f32_16x16x32_bf16(Bt[n][k], At[m][k], acc[ai][bj][m][n], 0, 0, 0); __builtin_amdgcn_s_setprio(0); } while (0)
#define PG8_WAIT_V(n) asm volatile("s_waitcnt vmcnt(" #n ")" ::: "memory")
#define PG8_WAIT_L(n) asm volatile("s_waitcnt lgkmcnt(" #n ")" ::: "memory")
#define PG8_BAR __builtin_amdgcn_s_barrier()
#define PG8_SCHED __builtin_amdgcn_sched_barrier(0)
#define PG8_APTR(u) ((const char*)((u).br == 0 ? g.A0 : ((u).br == 1 ? g.A1 : g.A2)) + (size_t)(u).pm * tstepA + (size_t)(u).kofs * 2)
#define PG8_BPTR(u) ((const char*)(g.B0 + (size_t)(u).br * g.bstride) + (size_t)(u).pn * tstepB + (size_t)(u).kofs * 2)
    Unit cur, nxt; int ui = 0;
    if (!S.next(0, cur)) return;
    f32x4 acc[2][2][4][2];
#pragma unroll
    for (int a = 0; a < 2; ++a)
#pragma unroll
        for (int b = 0; b < 2; ++b)
#pragma unroll
            for (int m = 0; m < 4; ++m)
#pragma unroll
                for (int n = 0; n < 2; ++n) acc[a][b][m][n] = (f32x4){0.f, 0.f, 0.f, 0.f};
    bf16x8 At[4][2], B0[2][2], B1[2][2];
    const char* cA = PG8_APTR(cur); const char* cB = PG8_BPTR(cur);
    PG8_STAGE(PG8_SB(0, 0), cB, voffB); PG8_STAGE(PG8_SA(0, 0), cA, voffA); PG8_STAGE(PG8_SB(0, 1), cB + hstepB, voffB); PG8_STAGE(PG8_SA(0, 1), cA + hstepA, voffA);
    if (wr == 1) PG8_BAR;
    PG8_WAIT_V(4); PG8_BAR;
    PG8_STAGE(PG8_SB(1, 0), cB + kstep, voffB); PG8_STAGE(PG8_SA(1, 0), cA + kstep, voffA); PG8_STAGE(PG8_SB(1, 1), cB + hstepB + kstep, voffB);
    PG8_WAIT_V(6); PG8_BAR;
    for (;;) {
        const bool has_next = S.next(ui + 1, nxt);
        const char* nA = has_next ? PG8_APTR(nxt) : cA; const char* nB = has_next ? PG8_BPTR(nxt) : cB;
        for (int t = 0; t < nt; t += 2) {
            const bool last = (t == nt - 2);
            const char* a1 = cA + (size_t)(t + 1) * kstep;
            const char* a2 = last ? nA : cA + (size_t)(t + 2) * kstep; const char* b2 = last ? nB : cB + (size_t)(t + 2) * kstep;
            const char* a3 = a2 + kstep; const char* b3 = b2 + kstep;
            PG8_LDB(B0, 0, 0); PG8_SCHED; PG8_LDA(At, 0, 0); PG8_STAGE(PG8_SA(1, 1), a1 + hstepA, voffA);
            PG8_WAIT_L(8); PG8_BAR; PG8_WAIT_L(0); PG8_MMA(0, 0, At, B0); PG8_BAR; PG8_SCHED;
            PG8_LDB(B1, 0, 1); PG8_STAGE(PG8_SB(0, 0), b2, voffB);
            PG8_BAR; PG8_WAIT_L(0); PG8_MMA(0, 1, At, B1); PG8_BAR;
            PG8_LDA(At, 0, 1); PG8_STAGE(PG8_SA(0, 0), a2, voffA);
            PG8_BAR; PG8_WAIT_L(0); PG8_MMA(1, 0, At, B0); PG8_BAR; PG8_SCHED;
            PG8_STAGE(PG8_SB(0, 1), b2 + hstepB, voffB);
            PG8_WAIT_V(6); PG8_BAR; PG8_MMA(1, 1, At, B1); PG8_BAR;
            PG8_LDB(B0, 1, 0); PG8_SCHED; PG8_LDA(At, 1, 0); PG8_STAGE(PG8_SA(0, 1), a2 + hstepA, voffA);
            PG8_WAIT_L(8); PG8_BAR; PG8_WAIT_L(0); PG8_MMA(0, 0, At, B0); PG8_BAR; PG8_SCHED;
            PG8_LDB(B1, 1, 1); PG8_STAGE(PG8_SB(1, 0), b3, voffB);
            PG8_BAR; PG8_WAIT_L(0); PG8_MMA(0, 1, At, B1); PG8_BAR;
            PG8_LDA(At, 1, 1); PG8_STAGE(PG8_SA(1, 0), a3, voffA);
            PG8_BAR; PG8_WAIT_L(0); PG8_MMA(1, 0, At, B0); PG8_BAR; PG8_SCHED;
            PG8_STAGE(PG8_SB(1, 1), b3 + hstepB, voffB);
            PG8_WAIT_V(6); PG8_BAR; PG8_MMA(1, 1, At, B1); PG8_BAR;
        }
        E(acc, cur, wr, wc, fr, fq);
        if (!has_next) break;
#pragma unroll
        for (int a = 0; a < 2; ++a)
#pragma unroll
            for (int b = 0; b < 2; ++b)
#pragma unroll
                for (int m = 0; m < 4; ++m)
#pragma unroll
                    for (int n = 0; n < 2; ++n) acc[a][b][m][n] = (f32x4){0.f, 0.f, 0.f, 0.f};
        cur = nxt; cA = nA; cB = nB; ++ui;
    }
    PG8_WAIT_V(0);
    if (wr == 0) PG8_BAR;
    PG8_BAR;
#undef PG8_SA
#undef PG8_SB
#undef PG8_STAGE
#undef PG8_LDA
#undef PG8_LDB
#undef PG8_MMA
#undef PG8_WAIT_V
#undef PG8_WAIT_L
#undef PG8_BAR
#undef PG8_SCHED
#undef PG8_APTR
#undef PG8_BPTR
}

struct EpiUp {
    static constexpr bool PERM = false;
    bf16_t* hid; bf16_t* hid2; const float* ss;
    __device__ __forceinline__ void operator()(const f32x4 (&acc)[2][2][4][2], const Unit& u, int wr, int wc, int fr, int fq) const {
        const int row0 = u.pm * BM + wr * 64 + fr;
        float rr[2][4];
#pragma unroll
        for (int ai = 0; ai < 2; ++ai)
#pragma unroll
            for (int m = 0; m < 4; ++m) rr[ai][m] = ss[row0 + ai * HALF + m * 16];
#pragma unroll
        for (int ai = 0; ai < 2; ++ai)
#pragma unroll
            for (int m = 0; m < 4; ++m) {
                const int row = row0 + ai * HALF + m * 16;
                const float r = frsq(rr[ai][m] * (1.0f / 1024.0f) + 1e-6f);
#pragma unroll
                for (int bj = 0; bj < 2; ++bj) {
                    const f32x4 gt = acc[ai][bj][m][0] * r, up = acc[ai][bj][m][1] * r;
                    float h[4];
#pragma unroll
                    for (int j = 0; j < 4; ++j) h[j] = siluf_(gt[j]) * up[j];
                    const int col = 16 * (8 * u.pn + 4 * bj + wc) + 4 * fq;
                    u32x2 w; w.x = pk2(h[0], h[1]); w.y = pk2(h[2], h[3]);
                    *(u32x2*)((u.pm >= T_P / BM ? hid2 : hid) + (size_t)row * FH + col) = w;
                }
            }
    }
};
struct EpiRes {
    static constexpr bool PERM = false;
    float* x; bf16_t* xb; float* ssn; float scale; int dry;
    __device__ __forceinline__ void operator()(const f32x4 (&acc)[2][2][4][2], const Unit& u, int wr, int wc, int fr, int fq) const {
        const int row0 = u.pm * BM + wr * 64 + fr, col0 = u.pn * BM + wc * 32 + 4 * fq;
        f32x4 cur[2][2], nxt[2][2];
#pragma unroll
        for (int bj = 0; bj < 2; ++bj)
#pragma unroll
            for (int n = 0; n < 2; ++n) cur[bj][n] = *(const f32x4*)(x + (size_t)row0 * DM + col0 + bj * HALF + n * 16);
#pragma unroll
        for (int gi = 0; gi < 8; ++gi) {
            const int ai = gi >> 2, m = gi & 3;
            const int row = row0 + ai * HALF + m * 16;
            if (gi < 7) { const int rown = row0 + ((gi + 1) >> 2) * HALF + ((gi + 1) & 3) * 16;
#pragma unroll
                for (int bj = 0; bj < 2; ++bj)
#pragma unroll
                    for (int n = 0; n < 2; ++n) nxt[bj][n] = *(const f32x4*)(x + (size_t)rown * DM + col0 + bj * HALF + n * 16); }
            float s = 0.f;
#pragma unroll
            for (int bj = 0; bj < 2; ++bj)
#pragma unroll
                for (int n = 0; n < 2; ++n) {
                    const int col = col0 + bj * HALF + n * 16;
                    const f32x4 v = cur[bj][n] + acc[ai][bj][m][n] * scale;
                    u32x2 w; w.x = pk2(v[0], v[1]); w.y = pk2(v[2], v[3]);
                    if (!dry) { *(f32x4*)(x + (size_t)row * DM + col) = v; *(u32x2*)(xb + (size_t)row * DM + col) = w; }
                    s += v[0] * v[0] + v[1] * v[1] + v[2] * v[2] + v[3] * v[3];
                }
            s += __shfl_xor(s, 16); s += __shfl_xor(s, 32);
            if (fq == 0 && !dry) atomicAdd(ssn + row, s);
#pragma unroll
            for (int bj = 0; bj < 2; ++bj)
#pragma unroll
                for (int n = 0; n < 2; ++n) cur[bj][n] = nxt[bj][n];
        }
    }
};
__device__ __forceinline__ unsigned pkh2(float lo, float hi) { const _Float16 a = (_Float16)lo, b = (_Float16)hi; return (unsigned)__builtin_bit_cast(unsigned short, a) | ((unsigned)__builtin_bit_cast(unsigned short, b) << 16); }
__device__ __forceinline__ float h2f_lo(unsigned w) { return (float)__builtin_bit_cast(_Float16, (unsigned short)(w & 0xffffu)); }
__device__ __forceinline__ float h2f_hi(unsigned w) { return (float)__builtin_bit_cast(_Float16, (unsigned short)(w >> 16)); }
__device__ __forceinline__ float hg_logf(float v, float lb) {
    const float ls = fminf(v, 0.f) - flog(1.0f + fexp(-fabsf(v)));
    return (lb == 0.f) ? ls : flog(lb + (1.0f - lb) * fexp(ls));
}
struct EpiWin {
    static constexpr bool PERM = true;
    bf16_t* z; const float* ss; const float* lbv; const float2* rope;
    __device__ __forceinline__ void operator()(const f32x4 (&acc)[2][2][4][2], const Unit& u, int wr, int wc, int fr, int fq) const {
        const int row0 = u.pm * BM + wr * 64 + fr, col0 = u.pn * BM + wc * 32 + 8 * fq;
        const int ctile = u.pn * BM;
        const int mode = (ctile < ZC_VR) ? 3 : (ctile >= ZC_QH && ctile < ZC_FH) ? 1 : ((ctile >= ZC_FH && ctile < ZC_IH) ? 2 : 0);
        float rr[2][4];
#pragma unroll
        for (int ai = 0; ai < 2; ++ai)
#pragma unroll
            for (int m = 0; m < 4; ++m) rr[ai][m] = ss[row0 + ai * HALF + m * 16];
        if (mode == 0) {
#pragma unroll
            for (int ai = 0; ai < 2; ++ai)
#pragma unroll
                for (int m = 0; m < 4; ++m) {
                    const int row = row0 + ai * HALF + m * 16;
                    const float r = frsq(rr[ai][m] * (1.0f / 1024.0f) + 1e-6f);
#pragma unroll
                    for (int bj = 0; bj < 2; ++bj) {
                        const f32x4 v0 = acc[ai][bj][m][0] * r, v1 = acc[ai][bj][m][1] * r;
                        u32x4 w; w.x = pk2(v0[0], v0[1]); w.y = pk2(v0[2], v0[3]); w.z = pk2(v1[0], v1[1]); w.w = pk2(v1[2], v1[3]);
                        *(u32x4*)(z + (size_t)row * NZ + col0 + bj * HALF) = w;
                    }
                }
        } else if (mode == 3) {
#pragma unroll
            for (int ai = 0; ai < 2; ++ai)
#pragma unroll
                for (int m = 0; m < 4; ++m) {
                    const int row = row0 + ai * HALF + m * 16;
                    const float r = frsq(rr[ai][m] * (1.0f / 1024.0f) + 1e-6f);
                    const int pidx = row < T_P ? (row & 2047) : 2048 + ((row - T_P) & 3);
                    const float2* rp = rope + (size_t)pidx * 64 + 16 * wc + 4 * fq;
                    const f32x4 cs01 = *(const f32x4*)rp, cs23 = *(const f32x4*)(rp + 2);
#pragma unroll
                    for (int bj = 0; bj < 2; ++bj) {
                        const f32x4 x1 = acc[ai][bj][m][0] * r, x2 = acc[ai][bj][m][1] * r;
                        const float o10 = x1[0] * cs01[0] - x2[0] * cs01[1], o20 = x1[0] * cs01[1] + x2[0] * cs01[0];
                        const float o11 = x1[1] * cs01[2] - x2[1] * cs01[3], o21 = x1[1] * cs01[3] + x2[1] * cs01[2];
                        const float o12 = x1[2] * cs23[0] - x2[2] * cs23[1], o22 = x1[2] * cs23[1] + x2[2] * cs23[0];
                        const float o13 = x1[3] * cs23[2] - x2[3] * cs23[3], o23 = x1[3] * cs23[3] + x2[3] * cs23[2];
                        bf16_t* zo = z + (size_t)row * NZ + ctile + bj * HALF + 16 * wc + 4 * fq;
                        u32x2 w1, w2; w1.x = pk2(o10, o11); w1.y = pk2(o12, o13); w2.x = pk2(o20, o21); w2.y = pk2(o22, o23);
                        *(u32x2*)zo = w1; *(u32x2*)(zo + 64) = w2;
                    }
                }
        } else if (mode == 1) {
#pragma unroll
            for (int ai = 0; ai < 2; ++ai)
#pragma unroll
                for (int m = 0; m < 4; ++m) {
                    const int row = row0 + ai * HALF + m * 16;
                    const float r = frsq(rr[ai][m] * (1.0f / 1024.0f) + 1e-6f);
#pragma unroll
                    for (int bj = 0; bj < 2; ++bj) {
                        const f32x4 v0 = acc[ai][bj][m][0] * r, v1 = acc[ai][bj][m][1] * r;
                        u32x4 w; w.x = pk2(siluf_(v0[0]), siluf_(v0[1])); w.y = pk2(siluf_(v0[2]), siluf_(v0[3])); w.z = pk2(siluf_(v1[0]), siluf_(v1[1])); w.w = pk2(siluf_(v1[2]), siluf_(v1[3]));
                        *(u32x4*)(z + (size_t)row * NZ + col0 + bj * HALF) = w;
                    }
                }
        } else {
#pragma unroll
            for (int bj = 0; bj < 2; ++bj) {
                f32x4 l0 = (f32x4){0.f, 0.f, 0.f, 0.f}, l1 = l0;
                if (lbv) { l0 = *(const f32x4*)(lbv + col0 + bj * HALF - ZC_FH); l1 = *(const f32x4*)(lbv + col0 + bj * HALF - ZC_FH + 4); }
#pragma unroll
                for (int ai = 0; ai < 2; ++ai)
#pragma unroll
                    for (int m = 0; m < 4; ++m) {
                        const int row = row0 + ai * HALF + m * 16;
                        const float r = frsq(rr[ai][m] * (1.0f / 1024.0f) + 1e-6f);
                        const f32x4 v0 = acc[ai][bj][m][0] * r, v1 = acc[ai][bj][m][1] * r;
                        u32x4 w;
                        w.x = pkh2(hg_logf(v0[0], l0[0]), hg_logf(v0[1], l0[1])); w.y = pkh2(hg_logf(v0[2], l0[2]), hg_logf(v0[3], l0[3]));
                        w.z = pkh2(hg_logf(v1[0], l1[0]), hg_logf(v1[1], l1[1])); w.w = pkh2(hg_logf(v1[2], l1[2]), hg_logf(v1[3], l1[3]));
                        *(u32x4*)(z + (size_t)row * NZ + col0 + bj * HALF) = w;
                    }
            }
        }
    }
};
struct EpiBranch {
    static constexpr bool PERM = true;
    bf16_t* z; bf16_t* mrg; const float* mbias; int dry;
    __device__ __forceinline__ void operator()(const f32x4 (&acc)[2][2][4][2], const Unit& u, int wr, int wc, int fr, int fq) const {
        const int row0 = u.pm * BM + wr * 64 + fr, col0 = u.pn * BM + wc * 32 + 8 * fq;
        const int br = u.br;
#pragma unroll
        for (int bj = 0; bj < 2; ++bj) {
            const int col = col0 + bj * HALF;
            const f32x4 b0 = *(const f32x4*)(mbias + br * DM + col), b1 = *(const f32x4*)(mbias + br * DM + col + 4);
#pragma unroll
            for (int am = 0; am < 4; ++am) {
                const int ai = am >> 1, mb = (am & 1) * 2;
                u32x4 gw[2], pw[2];
#pragma unroll
                for (int mm = 0; mm < 2; ++mm) {
                    const int rowm = row0 + ai * HALF + (mb + mm) * 16;
                    gw[mm] = *(const u32x4*)(z + (size_t)rowm * NZ + ZC_GATE + br * DM + col);
                    pw[mm] = (u32x4){0u, 0u, 0u, 0u};
                    if (br > 0) pw[mm] = *(const u32x4*)(mrg + (size_t)rowm * DM + col);
                }
#pragma unroll
                for (int mm = 0; mm < 2; ++mm) {
                    const int m = mb + mm;
                    bf16_t* zr = mrg + (size_t)(row0 + ai * HALF + m * 16) * DM;
                    float o[8];
                    const f32x4 a0 = acc[ai][bj][m][0], a1 = acc[ai][bj][m][1];
                    o[0] = sigmoidf_(lo2f(gw[mm].x) + b0[0]) * a0[0] + lo2f(pw[mm].x); o[1] = sigmoidf_(hi2f(gw[mm].x) + b0[1]) * a0[1] + hi2f(pw[mm].x);
                    o[2] = sigmoidf_(lo2f(gw[mm].y) + b0[2]) * a0[2] + lo2f(pw[mm].y); o[3] = sigmoidf_(hi2f(gw[mm].y) + b0[3]) * a0[3] + hi2f(pw[mm].y);
                    o[4] = sigmoidf_(lo2f(gw[mm].z) + b1[0]) * a1[0] + lo2f(pw[mm].z); o[5] = sigmoidf_(hi2f(gw[mm].z) + b1[1]) * a1[1] + hi2f(pw[mm].z);
                    o[6] = sigmoidf_(lo2f(gw[mm].w) + b1[2]) * a1[2] + lo2f(pw[mm].w); o[7] = sigmoidf_(hi2f(gw[mm].w) + b1[3]) * a1[3] + hi2f(pw[mm].w);
                    u32x4 w; w.x = pk2(o[0], o[1]); w.y = pk2(o[2], o[3]); w.z = pk2(o[4], o[5]); w.w = pk2(o[6], o[7]);
                    if (!dry) *(u32x4*)(zr + col) = w;
                }
            }
        }
    }
};
struct EpiStoreP {
    static constexpr bool PERM = false;
    float* pbuf; int klen, nsplit;
    __device__ __forceinline__ void operator()(const f32x4 (&acc)[2][2][4][2], const Unit& u, int wr, int wc, int fr_, int fq_) const {
        int fr = fr_, fq = fq_; asm volatile("" : "+v"(fr), "+v"(fq));
        const int row0 = u.pm * BM - T_P + wr * 64 + fr, col0 = u.pn * BM + wc * 32 + 4 * fq;
        float* base = pbuf + (size_t)(u.br * nsplit + u.kofs / klen) * (512 * DM);
#pragma unroll
        for (int ai = 0; ai < 2; ++ai)
#pragma unroll
            for (int m = 0; m < 4; ++m)
#pragma unroll
                for (int bj = 0; bj < 2; ++bj)
#pragma unroll
                    for (int n = 0; n < 2; ++n)
                        *(f32x4*)(base + (size_t)(row0 + ai * HALF + m * 16) * DM + col0 + bj * HALF + n * 16) = acc[ai][bj][m][n];
    }
};
}

__device__ __forceinline__ void conv_tile(const float* __restrict__ src, int ldn, int k0, int n0, bf16_t* __restrict__ dst, int K, const float* __restrict__ gain, int mode, LAS float* tile) {
    int tid = threadIdx.x; asm volatile("" : "+v"(tid));
    float v[32];
#pragma unroll
    for (int i = 0; i < 32; ++i) v[i] = src[(size_t)(k0 + i * 2 + (tid >> 8)) * ldn + n0 + (tid & 255)];
    if (gain) {
#pragma unroll
        for (int i = 0; i < 32; ++i) v[i] *= gain[k0 + i * 2 + (tid >> 8)];
    }
#pragma unroll
    for (int i = 0; i < 32; ++i) tile[(i * 2 + (tid >> 8)) * 257 + (tid & 255)] = v[i];
    __syncthreads();
#pragma unroll
    for (int i = 0; i < 4; ++i) {
        const int id = tid + 512 * i, nn = id >> 3, ks = (id & 7) * 8;
        float t[8];
#pragma unroll
        for (int j = 0; j < 8; ++j) t[j] = tile[(ks + j) * 257 + nn];
        const int n = n0 + nn;
        const int row = (mode == 0) ? n : (mode == 3) ? ((n & ~127) + 8 * ((n & 63) >> 2) + 4 * ((n >> 6) & 1) + (n & 3)) : (32 * (n >> 4) + (mode == 2 ? 16 : 0) + (n & 15));
        u32x4 w; w.x = pk2(t[0], t[1]); w.y = pk2(t[2], t[3]); w.z = pk2(t[4], t[5]); w.w = pk2(t[6], t[7]);
        *(u32x4*)(dst + (size_t)row * K + k0 + ks) = w;
    }
    __syncthreads();
}

__device__ void conv_job(const Params& p, int ti, LAS float* tile) {
    bf16_t* wb = (bf16_t*)(p.ws + WS_W);
    {
        const int l = ti / 2080; int r = ti % 2080;
        bf16_t* wl = wb + (size_t)l * W_LAYER;
        const float* src; int Ks, Ns; bf16_t* dst; const float* gain = nullptr; int mode = 0;
        if (r < 176) { src = p.in[7] + (size_t)l * DM * FH; Ks = DM; Ns = FH; dst = wl + OFF_GU1; gain = p.in[6] + l * DM; mode = 1; }
        else if ((r -= 176) < 176) { src = p.in[8] + (size_t)l * DM * FH; Ks = DM; Ns = FH; dst = wl + OFF_GU1; gain = p.in[6] + l * DM; mode = 2; }
        else if ((r -= 176) < 176) { src = p.in[9] + (size_t)l * DM * FH; Ks = FH; Ns = DM; dst = wl + OFF_D1; }
        else if ((r -= 176) < 768) { src = p.in[11] + (size_t)l * DM * NZ; Ks = DM; Ns = NZ; dst = wl + OFF_WIN; gain = p.in[10] + l * DM; }
        else if ((r -= 768) < 64) { src = p.in[13] + (size_t)l * DM * DM; Ks = DM; Ns = DM; dst = wl + OFF_RO; }
        else if ((r -= 64) < 64) { src = p.in[16] + (size_t)l * DM * DM; Ks = DM; Ns = DM; dst = wl + OFF_HO; }
        else if ((r -= 64) < 64) { src = p.in[24] + (size_t)l * DM * DM; Ks = DM; Ns = DM; dst = wl + OFF_LO; }
        else if ((r -= 64) < 64) { src = p.in[25] + (size_t)l * DM * DM; Ks = DM; Ns = DM; dst = wl + OFF_MO; }
        else if ((r -= 64) < 176) { src = p.in[27] + (size_t)l * DM * FH; Ks = DM; Ns = FH; dst = wl + OFF_GU2; gain = p.in[26] + l * DM; mode = 1; }
        else if ((r -= 176) < 176) { src = p.in[28] + (size_t)l * DM * FH; Ks = DM; Ns = FH; dst = wl + OFF_GU2; gain = p.in[26] + l * DM; mode = 2; }
        else { r -= 176; src = p.in[29] + (size_t)l * DM * FH; Ks = FH; Ns = DM; dst = wl + OFF_D2; }
        const int nkt = Ks / 64;
        const int kt = r % nkt, ntile = r / nkt;
        if (Ns == NZ && ntile < 4) mode = 3;
        conv_tile(src, Ns, kt * 64, ntile * 256, dst, Ks, gain, mode, tile);
    }
}

__device__ void phase0(const Params& p, LAS unsigned char* lds) {
    int tid = threadIdx.x; asm volatile("" : "+v"(tid));
    const int bid = blockIdx.x, nb = gridDim.x;
    LAS float* tile = (LAS float*)lds;
    for (int ti = bid; ti < 2080; ti += nb) conv_job(p, ti, tile);
    float* x = p.out; bf16_t* xb = (bf16_t*)(p.ws + WS_XB); float* ss = (float*)(p.ws + WS_SS);
    const int wid = tid >> 6, lane = tid & 63;
    for (int row = bid * 8 + wid; row < T_ALL; row += nb * 8) {
        const float* srow = (row < T_P) ? (p.in[0] + (size_t)row * DM) : (p.in[1] + (size_t)(row - T_P) * DM);
        float s = 0.f;
#pragma unroll
        for (int i = 0; i < 4; ++i) {
            const int c = i * 256 + lane * 4;
            const f32x4 v = *(const f32x4*)(srow + c);
            *(f32x4*)(x + (size_t)row * DM + c) = v;
            u32x2 w; w.x = pk2(v[0], v[1]); w.y = pk2(v[2], v[3]);
            *(u32x2*)(xb + (size_t)row * DM + c) = w;
            s += v[0] * v[0] + v[1] * v[1] + v[2] * v[2] + v[3] * v[3];
        }
#pragma unroll
        for (int o = 32; o >= 1; o >>= 1) s += __shfl_xor(s, o);
        if (lane == 0) { ss[row] = s;
#pragma unroll
            for (int k = 1; k < 8; ++k) ss[(size_t)k * T_ALL + row] = 0.f; }
    }
    float2* rope = (float2*)(p.ws + WS_ROPE);
    for (int e = bid * 512 + tid; e < 2052 * 64; e += nb * 512) {
        const int idx = e >> 6, i = e & 63;
        const int pos = idx < 2048 ? idx : (16384 + idx - 2048);
        double inv = 1.0;
        for (int k = 0; k < i; ++k) inv *= 0.8659643233600653;
        double rev = (double)pos * inv * 0.15915494309189535;
        rev -= (double)(long long)rev;
        const float rf = (float)rev;
        rope[e] = make_float2(__builtin_amdgcn_cosf(rf), __builtin_amdgcn_sinf(rf));
    }
    if (bid == 0 && tid < 64) ((unsigned*)(p.ws + WS_CTR))[tid] = 0u;
    if (bid == 1) { float* lbp = (float*)(p.ws + WS_LB); for (int i = tid; i < 1024; i += 512) lbp[i] = sigmoidf_(p.in[14][1024 + i] - p.in[14][i]); }
}

__device__ __forceinline__ bf16x8 ldfrag(const LAS bf16_t* M, int ld, int r0, int k0, int fr, int fq) { return *(const LAS bf16x8*)(M + (r0 + fr) * ld + k0 + fq * 8); }
__device__ __forceinline__ bf16x8 ldfrag_tr(const LAS bf16_t* M, int ld, int i0, int k0, int fr, int fq) {
    const LAS bf16_t* q = M + (k0 + fq * 8 + (fr >> 2)) * ld + i0 + (fr & 3) * 4;
    const s16x4 a = __builtin_amdgcn_ds_read_tr16_b64_v4i16((LAS s16x4*)q);
    const s16x4 b = __builtin_amdgcn_ds_read_tr16_b64_v4i16((LAS s16x4*)(q + 4 * ld));
    return (bf16x8){a[0], a[1], a[2], a[3], b[0], b[1], b[2], b[3]};
}
#define MMA16(acc, bfr, afr) acc = __builtin_amdgcn_mfma_f32_16x16x32_bf16(bfr, afr, acc, 0, 0, 0)

__device__ __forceinline__ bf16_t* og_compact(const Params& p, int br) {
    bf16_t* base0 = (bf16_t*)(p.out + O_RETS + (size_t)128 * 4 * 128 * 256);
    bf16_t* base1 = (bf16_t*)(p.out + O_HGS + (size_t)128 * 8 * 128 * 128);
    return br == 0 ? base0 + (size_t)T_P * DM : (br == 1 ? base1 : base1 + (size_t)T_P * DM);
}

template <bool HG>
__device__ void linattn_prompt(const Params& p, int l, int b, int h, LAS unsigned char* lds, int dry) {
    constexpr int DV = HG ? 128 : 256, NVT = DV / 16, NV = DV / 32, LQ = 136, LV = DV + 8, LP = 72;
    int tid = threadIdx.x; asm volatile("" : "+v"(tid));
    const int wid = __builtin_amdgcn_readfirstlane(tid >> 6), lane = tid & 63, fr = lane & 15, fq = lane >> 4;
    LAS bf16_t* Q = (LAS bf16_t*)lds;
    LAS bf16_t* Kn = Q + 64 * LQ;
    LAS bf16_t* P = Kn;
    LAS bf16_t* KH = Kn + 64 * LQ;
    LAS bf16_t* V = KH + 64 * LQ;
    LAS bf16_t* ST = V + 64 * LV;
    LAS float* red = (LAS float*)(ST + DV * LQ);
    LAS float* eL = red + 128;
    LAS float* eR = eL + 128;
    LAS float* segs = eR + 128;
    bf16_t* zb = (bf16_t*)(p.ws + WS_Z);
    const float2* rope = (const float2*)(p.ws + WS_ROPE);
    const int qcol = HG ? ZC_QH + h * 128 : ZC_QR + h * 128;
    const int kcol = HG ? ZC_FH + h * 128 : ZC_KR + h * 128;
    const int vcol = HG ? ZC_IH + h * 128 : ZC_VR + h * 256;
    const int gcol = HG ? ZC_GH + h * 128 : ZC_GR + h * 256;
    const float log_g = HG ? 0.f : logf(1.0f - exp2f(-5.0f - (float)h));
    f32x4 st[NVT];
#pragma unroll
    for (int i = 0; i < NVT; ++i) st[i] = (f32x4){0.f, 0.f, 0.f, 0.f};

    u32x4 rq1, rq2, rk1, rk2, rawv[HG ? 2 : 4];
    bf16_t rawf[16], rawq[16];
#define LOAD_RAW(cc) do { const int r0_ = b * 2048 + (cc) * 64; \
        if (!HG) { const bf16_t* zr_ = zb + (size_t)(r0_ + (tid >> 3)) * NZ; const int g_ = tid & 7; \
            rq1 = *(const u32x4*)(zr_ + qcol + 8 * g_); rq2 = *(const u32x4*)(zr_ + qcol + 64 + 8 * g_); rk1 = *(const u32x4*)(zr_ + kcol + 8 * g_); rk2 = *(const u32x4*)(zr_ + kcol + 64 + 8 * g_); \
            _Pragma("unroll") for (int i_ = 0; i_ < 4; ++i_) { const int id_ = tid + 512 * i_; rawv[i_] = *(const u32x4*)(zb + (size_t)(r0_ + (id_ >> 5)) * NZ + vcol + 8 * (id_ & 31)); } } \
        else { _Pragma("unroll") for (int j_ = 0; j_ < 16; ++j_) { const bf16_t* zr_ = zb + (size_t)(r0_ + (tid >> 7) * 16 + j_) * NZ; rawf[j_] = zr_[kcol + (tid & 127)]; rawq[j_] = zr_[qcol + (tid & 127)]; } \
            _Pragma("unroll") for (int i_ = 0; i_ < 2; ++i_) { const int id_ = tid + 512 * i_; rawv[i_] = *(const u32x4*)(zb + (size_t)(r0_ + (id_ >> 4)) * NZ + vcol + 8 * (id_ & 15)); } } } while (0)
    LOAD_RAW(0);
    for (int c = 0; c < 32; ++c) {
        const int row0 = b * 2048 + c * 64;
        if (!HG) {
            const int t = tid >> 3, g = tid & 7;
            const u32x4 q1 = rq1, q2 = rq2, k1 = rk1, k2 = rk2;
            const float kd = fexp((float)(63 - t) * log_g) * 0.08838834764831845f;
            unsigned ha[4], hb[4];
#pragma unroll
            for (int j = 0; j < 4; ++j) {
                const unsigned v1 = j == 0 ? k1.x : j == 1 ? k1.y : j == 2 ? k1.z : k1.w, v2 = j == 0 ? k2.x : j == 1 ? k2.y : j == 2 ? k2.z : k2.w;
                ha[j] = pk2(lo2f(v1) * kd, hi2f(v1) * kd); hb[j] = pk2(lo2f(v2) * kd, hi2f(v2) * kd);
            }
            *(LAS u32x4*)(Q + t * LQ + 8 * g) = q1;
            *(LAS u32x4*)(Q + t * LQ + 64 + 8 * g) = q2;
            *(LAS u32x4*)(Kn + t * LQ + 8 * g) = k1;
            *(LAS u32x4*)(Kn + t * LQ + 64 + 8 * g) = k2;
            *(LAS u32x4*)(KH + t * LQ + 8 * g) = (u32x4){ha[0], ha[1], ha[2], ha[3]};
            *(LAS u32x4*)(KH + t * LQ + 64 + 8 * g) = (u32x4){hb[0], hb[1], hb[2], hb[3]};
#pragma unroll
            for (int i = 0; i < 4; ++i) {
                const int id = tid + 512 * i, tt = id >> 5, gv = id & 31;
                *(LAS u32x4*)(V + tt * LV + 8 * gv) = rawv[i];
            }
        } else {
            const int d = tid & 127, seg = tid >> 7;
            float lf[16], kv[16], qv[16];
            float run = 0.f;
#pragma unroll
            for (int j = 0; j < 16; ++j) {
                const float lfv = (float)__builtin_bit_cast(_Float16, rawf[j]);
                run += lfv; lf[j] = run;
                kv[j] = 1.0f - fexp(lfv);
                qv[j] = bf2f(rawq[j]);
            }
            segs[seg * 128 + d] = run;
            __syncthreads();
            const float s0 = segs[d], s1 = segs[128 + d], s2 = segs[256 + d], s3 = segs[384 + d];
            const float pre = (seg > 0 ? s0 : 0.f) + (seg > 1 ? s1 : 0.f) + (seg > 2 ? s2 : 0.f);
            const float bref = s0 + s1, bL = bref + s2 + s3;
#pragma unroll
            for (int j = 0; j < 16; ++j) {
                const int t = seg * 16 + j;
                const float bb = pre + lf[j];
                Q[t * LQ + d] = f2bf(qv[j] * fexp(bb - bref));
                Kn[t * LQ + d] = f2bf(kv[j] * fexp(bref - bb));
                KH[t * LQ + d] = f2bf(kv[j] * fexp(bL - bb));
            }
            if (seg == 0) { eL[d] = fexp(bL); eR[d] = fexp(bref); }
#pragma unroll
            for (int i = 0; i < 2; ++i) {
                const int id = tid + 512 * i, tt = id >> 4, gv = id & 15;
                *(LAS u32x4*)(V + tt * LV + 8 * gv) = rawv[i];
            }
        }
        __syncthreads();
        LOAD_RAW(c < 31 ? c + 1 : 31);
        {
            float e0 = 1.f, e1 = 1.f, e2 = 1.f, e3 = 1.f;
            if (HG) { const f32x4 ev = *(const LAS f32x4*)(eR + 16 * wid + 4 * fq); e0 = ev[0]; e1 = ev[1]; e2 = ev[2]; e3 = ev[3]; }
#pragma unroll
            for (int vt = 0; vt < NVT; ++vt) {
                u32x2 w; w.x = pk2(st[vt][0] * e0, st[vt][1] * e1); w.y = pk2(st[vt][2] * e2, st[vt][3] * e3);
                *(LAS u32x2*)(ST + (16 * vt + fr) * LQ + 16 * wid + 4 * fq) = w;
            }
        }
        f32x4 sc[2];
        sc[0] = (f32x4){0.f, 0.f, 0.f, 0.f}; sc[1] = sc[0];
        {
            const int tt = wid >> 1, s0t = (wid & 1) * 2;
#pragma unroll
            for (int ks = 0; ks < 4; ++ks) {
                const bf16x8 afr = ldfrag(Q, LQ, 16 * tt, 32 * ks, fr, fq);
#pragma unroll
                for (int si = 0; si < 2; ++si) { const bf16x8 bfr = ldfrag(Kn, LQ, 16 * (s0t + si), 32 * ks, fr, fq); MMA16(sc[si], bfr, afr); }
            }
            const int t = 16 * tt + fr;
#pragma unroll
            for (int si = 0; si < 2; ++si)
#pragma unroll
                for (int j = 0; j < 4; ++j) {
                    const int s = 16 * (s0t + si) + 4 * fq + j;
                    float v = sc[si][j];
                    if (!HG) v *= 0.08838834764831845f * fexp((float)(t - s) * log_g);
                    sc[si][j] = (s <= t) ? v : 0.f;
                }
        }
        __syncthreads();
        {
            const int tt = wid >> 1, s0t = (wid & 1) * 2, t = 16 * tt + fr;
#pragma unroll
            for (int si = 0; si < 2; ++si) { u32x2 w; w.x = pk2(sc[si][0], sc[si][1]); w.y = pk2(sc[si][2], sc[si][3]);
                *(LAS u32x2*)(P + t * LP + 16 * (s0t + si) + 4 * fq) = w; }
        }
        __syncthreads();
        {
            const int tt = wid & 3, vg = wid >> 2, t = 16 * tt + fr;
            bf16_t* zr = zb + (size_t)(row0 + t) * NZ + gcol;
            bf16_t* orow = (l == 0) ? og_compact(p, HG ? 1 : 0) + (size_t)(row0 + t) * DM + h * DV : zr;
            u32x2 gwv[NV];
#pragma unroll
            for (int i = 0; i < NV; ++i) gwv[i] = *(const u32x2*)(zr + 16 * (vg * NV + i) + 4 * fq);
            f32x4 oa[NV];
#pragma unroll
            for (int i = 0; i < NV; ++i) oa[i] = (f32x4){0.f, 0.f, 0.f, 0.f};
#pragma unroll
            for (int ks = 0; ks < 4; ++ks) {
                const bf16x8 afr = ldfrag(Q, LQ, 16 * tt, 32 * ks, fr, fq);
#pragma unroll
                for (int i = 0; i < NV; ++i) { const bf16x8 bfr = ldfrag(ST, LQ, 16 * (vg * NV + i), 32 * ks, fr, fq); MMA16(oa[i], bfr, afr); }
            }
            if (!HG) { const float qd = fexp((float)(t + 1) * log_g);
#pragma unroll
                for (int i = 0; i < NV; ++i) oa[i] *= qd; }
#pragma unroll
            for (int ks = 0; ks < 2; ++ks) {
                const bf16x8 afr = ldfrag(P, LP, 16 * tt, 32 * ks, fr, fq);
#pragma unroll
                for (int i = 0; i < NV; ++i) { const bf16x8 bfr = ldfrag_tr(V, LV, 16 * (vg * NV + i), 32 * ks, fr, fq); MMA16(oa[i], bfr, afr); }
            }
            float s = 0.f;
#pragma unroll
            for (int i = 0; i < NV; ++i) s += oa[i][0] * oa[i][0] + oa[i][1] * oa[i][1] + oa[i][2] * oa[i][2] + oa[i][3] * oa[i][3];
            s += __shfl_xor(s, 16); s += __shfl_xor(s, 32);
            if (fq == 0) red[vg * 64 + t] = s;
            __syncthreads();
            const float rs = frsq((red[t] + red[64 + t]) * (1.0f / (float)DV) + 1e-6f);
#pragma unroll
            for (int i = 0; i < NV; ++i) {
                const int v = 16 * (vg * NV + i) + 4 * fq;
                const u32x2 gw = gwv[i];
                float n0 = rs, n1 = rs, n2 = rs, n3 = rs;
                if (HG) { const f32x4 hn = *(const f32x4*)(p.in[15] + l * 1024 + h * 128 + v); n0 *= hn[0]; n1 *= hn[1]; n2 *= hn[2]; n3 *= hn[3]; }
                u32x2 w;
                w.x = pk2(oa[i][0] * n0 * siluf_(lo2f(gw.x)), oa[i][1] * n1 * siluf_(hi2f(gw.x)));
                w.y = pk2(oa[i][2] * n2 * siluf_(lo2f(gw.y)), oa[i][3] * n3 * siluf_(hi2f(gw.y)));
                if (!dry) *(u32x2*)(orow + v) = w;
            }
        }
        {
            if (HG) { const f32x4 ev = *(const LAS f32x4*)(eL + 16 * wid + 4 * fq);
#pragma unroll
                for (int vt = 0; vt < NVT; ++vt) st[vt] *= ev; }
            else { const float sd = fexp(64.0f * log_g);
#pragma unroll
                for (int vt = 0; vt < NVT; ++vt) st[vt] *= sd; }
#pragma unroll
            for (int ks = 0; ks < 2; ++ks) {
                const bf16x8 bfr = ldfrag_tr(KH, LQ, 16 * wid, 32 * ks, fr, fq);
#pragma unroll
                for (int vt = 0; vt < NVT; ++vt) { const bf16x8 afr = ldfrag_tr(V, LV, 16 * vt, 32 * ks, fr, fq); MMA16(st[vt], bfr, afr); }
            }
        }
        __syncthreads();
    }
    float* so = p.out + (HG ? O_HGP : O_RETP) + ((size_t)((l * 8 + b) * (HG ? 8 : 4) + h)) * 128 * DV;
#pragma unroll
    for (int vt = 0; vt < NVT; ++vt)
#pragma unroll
        for (int j = 0; j < 4; ++j) so[(size_t)(16 * wid + 4 * fq + j) * DV + 16 * vt + fr] = st[vt][j];
}

__device__ void lru_prompt(const Params& p, int l, int b, int n, LAS unsigned char* lds, int dry) {
    int tid = threadIdx.x; asm volatile("" : "+v"(tid));
    const int wid = __builtin_amdgcn_readfirstlane(tid >> 6), lane = tid & 63, fr = lane & 15, fq = lane >> 4;
    LAS float* XL = (LAS float*)lds;
    LAS bf16_t* XC = (LAS bf16_t*)(lds + 34304);
    LAS float* XCF = (LAS float*)(lds + 51712);
    LAS float* AA = (LAS float*)(lds + 84480);
    LAS float* UU = (LAS float*)(lds + 117248);
    LAS float* segA = (LAS float*)(lds + 150016);
    LAS float* segH = segA + 512;
    LAS float* hc = segH + 512;
    bf16_t* zb = (bf16_t*)(p.ws + WS_Z);
    const int e = tid & 127, seg = tid >> 7, ch = n * 128 + e;
    const float cw0 = p.in[17][(l * 4 + 0) * 1024 + ch], cw1 = p.in[17][(l * 4 + 1) * 1024 + ch], cw2 = p.in[17][(l * 4 + 2) * 1024 + ch], cw3 = p.in[17][(l * 4 + 3) * 1024 + ch];
    const float cb = p.in[18][l * 1024 + ch];
    bf16x8 Ba[4], Bx[4];
    {
        const float* wa = p.in[19] + ((size_t)(l * 8 + n)) * 16384;
        const float* wx = p.in[21] + ((size_t)(l * 8 + n)) * 16384;
#pragma unroll
        for (int ks = 0; ks < 4; ++ks)
#pragma unroll
            for (int j = 0; j < 8; ++j) {
                const int d = 32 * ks + 8 * fq + j;
                Ba[ks][j] = (short)f2bf(wa[d * 128 + 16 * wid + fr]);
                Bx[ks][j] = (short)f2bf(wx[d * 128 + 16 * wid + fr]);
            }
    }
    float ba[4], bx[4], sp[4];
#pragma unroll
    for (int j = 0; j < 4; ++j) {
        const int c2 = n * 128 + 16 * wid + 4 * fq + j;
        ba[j] = p.in[20][l * 1024 + c2]; bx[j] = p.in[22][l * 1024 + c2];
        const float lam = p.in[23][l * 1024 + c2];
        sp[j] = fmaxf(-lam, 0.f) + flog(1.0f + fexp(-fabsf(lam)));
    }
    if (tid < 384) XL[tid] = 0.f;
    if (tid < 128) hc[tid] = 0.f;
    __syncthreads();
    for (int c = 0; c < 32; ++c) {
        const int row0 = b * 2048 + c * 64;
        bf16_t glv[16];
#pragma unroll
        for (int j = 0; j < 16; ++j) glv[j] = zb[(size_t)(row0 + seg * 16 + j) * NZ + ZC_GL + ch];
#pragma unroll
        for (int i = 0; i < 2; ++i) {
            const int id = tid + 512 * i, tt = id >> 4, g = id & 15;
            const u32x4 w = *(const u32x4*)(zb + (size_t)(row0 + tt) * NZ + ZC_XL + n * 128 + 8 * g);
            LAS float* dst = XL + (3 + tt) * 128 + 8 * g;
            *(LAS f32x4*)dst = (f32x4){lo2f(w.x), hi2f(w.x), lo2f(w.y), hi2f(w.y)};
            *(LAS f32x4*)(dst + 4) = (f32x4){lo2f(w.z), hi2f(w.z), lo2f(w.w), hi2f(w.w)};
        }
        __syncthreads();
#pragma unroll 4
        for (int j = 0; j < 16; ++j) {
            const int t = seg * 16 + j;
            const float xc = cb + XL[t * 128 + e] * cw0 + XL[(t + 1) * 128 + e] * cw1 + XL[(t + 2) * 128 + e] * cw2 + XL[(t + 3) * 128 + e] * cw3;
            XCF[t * 128 + e] = xc; XC[t * 136 + e] = f2bf(xc);
        }
        __syncthreads();
#pragma unroll
        for (int tt = 0; tt < 4; ++tt) {
            f32x4 ga = (f32x4){0.f, 0.f, 0.f, 0.f}, gx = ga;
#pragma unroll
            for (int ks = 0; ks < 4; ++ks) { const bf16x8 afr = ldfrag(XC, 136, 16 * tt, 32 * ks, fr, fq); MMA16(ga, Ba[ks], afr); MMA16(gx, Bx[ks], afr); }
            const int t = 16 * tt + fr, e4 = 16 * wid + 4 * fq;
            const f32x4 xv = *(const LAS f32x4*)(XCF + t * 128 + e4);
            f32x4 av, uv;
#pragma unroll
            for (int j = 0; j < 4; ++j) {
                const float r = sigmoidf_(ga[j] + ba[j]), ii = sigmoidf_(gx[j] + bx[j]);
                const float la = -8.0f * r * sp[j];
                av[j] = fexp(la);
                uv[j] = __builtin_amdgcn_sqrtf(1.0f - fexp(2.0f * la)) * ii * xv[j];
            }
            *(LAS f32x4*)(AA + t * 128 + e4) = av; *(LAS f32x4*)(UU + t * 128 + e4) = uv;
        }
        __syncthreads();
        {
            float A = 1.f, H = 0.f;
#pragma unroll 4
            for (int j = 0; j < 16; ++j) { const int t = seg * 16 + j; const float a = AA[t * 128 + e]; H = a * H + UU[t * 128 + e]; A *= a; }
            segA[seg * 128 + e] = A; segH[seg * 128 + e] = H;
        }
        __syncthreads();
        float hh = hc[e];
        for (int s = 0; s < seg; ++s) hh = segA[s * 128 + e] * hh + segH[s * 128 + e];
#pragma unroll
        for (int j = 0; j < 16; ++j) {
            const int t = seg * 16 + j;
            hh = AA[t * 128 + e] * hh + UU[t * 128 + e];
            bf16_t* zp = (l == 0) ? og_compact(p, 2) + (size_t)(row0 + t) * DM + ch : zb + (size_t)(row0 + t) * NZ + ZC_GL + ch;
            if (!dry) *zp = f2bf(hh * geluf_(bf2f(glv[j])));
        }
        __syncthreads();
        if (seg == 3) hc[e] = hh;
        if (seg == 0) { XL[e] = XL[64 * 128 + e]; XL[128 + e] = XL[65 * 128 + e]; XL[256 + e] = XL[66 * 128 + e]; }
        __syncthreads();
    }
    if (seg == 0) {
        p.out[O_LRUP + (size_t)(l * 8 + b) * 1024 + ch] = hc[e];
#pragma unroll
        for (int i = 0; i < 3; ++i) p.out[O_CVP + ((size_t)(l * 8 + b) * 3 + i) * 1024 + ch] = XL[i * 128 + e];
    }
    __syncthreads();
}

template <bool HG>
__device__ void linattn_sample(const Params& p, int l, int b, int h, LAS unsigned char* lds, int dry) {
    constexpr int DV = HG ? 128 : 256, NVG = DV / 4, NPART = 512 / NVG, DPP = 128 / NPART;
    int tid = threadIdx.x; asm volatile("" : "+v"(tid));
    LAS float* qs = (LAS float*)lds;
    LAS float* ks = qs + 512;
    LAS float* fs = ks + 512;
    LAS float* vs = fs + 512;
    LAS float* op = vs + 4 * DV;
    LAS float* red = op + NPART * 4 * DV;
    bf16_t* zb = (bf16_t*)(p.ws + WS_Z);
    const int rowb = T_P + 4 * b;
    const float gam = HG ? 1.f : (1.0f - exp2f(-5.0f - (float)h));
    if (!HG) {
        if (tid < 256) {
            const int t = tid >> 6, i = tid & 63;
            const bf16_t* zr = zb + (size_t)(rowb + t) * NZ;
            qs[t * 128 + i] = bf2f(zr[ZC_QR + h * 128 + i]); qs[t * 128 + 64 + i] = bf2f(zr[ZC_QR + h * 128 + 64 + i]);
            ks[t * 128 + i] = bf2f(zr[ZC_KR + h * 128 + i]) * 0.08838834764831845f; ks[t * 128 + 64 + i] = bf2f(zr[ZC_KR + h * 128 + 64 + i]) * 0.08838834764831845f;
        }
#pragma unroll
        for (int i = 0; i < 2; ++i) { const int id = tid + 512 * i, t = id >> 8, v = id & 255; vs[t * 256 + v] = bf2f(zb[(size_t)(rowb + t) * NZ + ZC_VR + h * 256 + v]); }
    } else {
        const int t = tid >> 7, d = tid & 127;
        const bf16_t* zr = zb + (size_t)(rowb + t) * NZ;
        const float fv = fexp((float)__builtin_bit_cast(_Float16, zr[ZC_FH + h * 128 + d]));
        fs[t * 128 + d] = fv;
        ks[t * 128 + d] = 1.0f - fv;
        qs[t * 128 + d] = bf2f(zr[ZC_QH + h * 128 + d]);
        vs[t * 128 + d] = bf2f(zr[ZC_IH + h * 128 + d]);
    }
    const int vg = tid % NVG, part = tid / NVG;
    const size_t sbase = ((size_t)((l * 128 + b) * (HG ? 8 : 4) + h)) * 128 * DV;
    const float* Sin = (HG ? p.in[3] : p.in[2]) + sbase + (size_t)(part * DPP) * DV + 4 * vg;
    float* Sout = p.out + (HG ? O_HGS : O_RETS) + sbase + (size_t)(part * DPP) * DV + 4 * vg;
    f32x4 S[DPP];
#pragma unroll
    for (int i = 0; i < DPP; ++i) S[i] = __builtin_nontemporal_load((const f32x4*)(Sin + (size_t)i * DV));
    __syncthreads();
    {
        const f32x4 v0 = *(const LAS f32x4*)(vs + 4 * vg), v1 = *(const LAS f32x4*)(vs + DV + 4 * vg), v2 = *(const LAS f32x4*)(vs + 2 * DV + 4 * vg), v3 = *(const LAS f32x4*)(vs + 3 * DV + 4 * vg);
        f32x4 o0 = (f32x4){0.f, 0.f, 0.f, 0.f}, o1 = o0, o2 = o0, o3 = o0;
#pragma unroll
        for (int i = 0; i < DPP; ++i) {
            const int d = part * DPP + i;
            const float f0 = HG ? fs[d] : gam, f1 = HG ? fs[128 + d] : gam, f2 = HG ? fs[256 + d] : gam, f3 = HG ? fs[384 + d] : gam;
            f32x4 Sv = S[i];
            Sv = Sv * f0 + v0 * ks[d]; o0 += Sv * qs[d];
            Sv = Sv * f1 + v1 * ks[128 + d]; o1 += Sv * qs[128 + d];
            Sv = Sv * f2 + v2 * ks[256 + d]; o2 += Sv * qs[256 + d];
            Sv = Sv * f3 + v3 * ks[384 + d]; o3 += Sv * qs[384 + d];
            S[i] = Sv;
            if ((i & 3) == 3) asm volatile("" ::: "memory");
        }
#pragma unroll
        for (int i = 0; i < DPP; ++i) __builtin_nontemporal_store(S[i], (f32x4*)(Sout + (size_t)i * DV));
        *(LAS f32x4*)(op + (part * 4 + 0) * DV + 4 * vg) = o0; *(LAS f32x4*)(op + (part * 4 + 1) * DV + 4 * vg) = o1;
        *(LAS f32x4*)(op + (part * 4 + 2) * DV + 4 * vg) = o2; *(LAS f32x4*)(op + (part * 4 + 3) * DV + 4 * vg) = o3;
    }
    __syncthreads();
    {
        const int t = tid >> 7, vv = tid & 127;
        constexpr int NPT = DV / 128;
        const int gcol = HG ? ZC_GH + h * 128 : ZC_GR + h * 256;
        bf16_t* zr = zb + (size_t)(rowb + t) * NZ + gcol;
        float o[NPT], gv[NPT]; float s = 0.f;
#pragma unroll
        for (int i = 0; i < NPT; ++i) { const int v = vv + 128 * i; float a = 0.f;
            gv[i] = bf2f(zr[v]);
#pragma unroll
            for (int q = 0; q < NPART; ++q) a += op[(q * 4 + t) * DV + v];
            o[i] = a; s += a * a; }
#pragma unroll
        for (int off = 32; off >= 1; off >>= 1) s += __shfl_xor(s, off);
        if ((tid & 63) == 0) red[tid >> 6] = s;
        __syncthreads();
        const float rs = frsq((red[2 * t] + red[2 * t + 1]) * (1.0f / (float)DV) + 1e-6f);
#pragma unroll
        for (int i = 0; i < NPT; ++i) { const int v = vv + 128 * i;
            float nrm = rs; if (HG) nrm *= p.in[15][l * 1024 + h * 128 + v];
            const bf16_t ov = f2bf(o[i] * nrm * siluf_(gv[i])); if (!dry) zr[v] = ov; }
    }
    __syncthreads();
}

__device__ void lru_sample(const Params& p, int l, int b, LAS unsigned char* lds, int dry) {
    int tid = threadIdx.x; asm volatile("" : "+v"(tid));
    LAS float* XX = (LAS float*)lds;
    LAS float* XC = XX + 7 * 1024;
    bf16_t* zb = (bf16_t*)(p.ws + WS_Z);
    float cv[6]; bf16_t xr[8];
#pragma unroll
    for (int i = 0; i < 6; ++i) cv[i] = p.in[5][(size_t)(l * 128 + b) * 3072 + tid + 512 * i];
#pragma unroll
    for (int i = 0; i < 8; ++i) { const int e = tid + 512 * i; xr[i] = zb[(size_t)(T_P + 4 * b + (e >> 10)) * NZ + ZC_XL + (e & 1023)]; }
    float cw[2][4], cb[2], ba[2], bx[2], lam[2], h0[2]; bf16_t glv[2][4];
#pragma unroll
    for (int cc = 0; cc < 2; ++cc) {
        const int ch = tid + 512 * cc;
#pragma unroll
        for (int k = 0; k < 4; ++k) { cw[cc][k] = p.in[17][(l * 4 + k) * 1024 + ch]; glv[cc][k] = zb[(size_t)(T_P + 4 * b + k) * NZ + ZC_GL + ch]; }
        cb[cc] = p.in[18][l * 1024 + ch]; ba[cc] = p.in[20][l * 1024 + ch]; bx[cc] = p.in[22][l * 1024 + ch]; lam[cc] = p.in[23][l * 1024 + ch];
        h0[cc] = p.in[4][(size_t)(l * 128 + b) * 1024 + ch];
    }
#pragma unroll
    for (int i = 0; i < 6; ++i) XX[tid + 512 * i] = cv[i];
#pragma unroll
    for (int i = 0; i < 8; ++i) XX[3072 + tid + 512 * i] = bf2f(xr[i]);
    __syncthreads();
#pragma unroll
    for (int cc = 0; cc < 2; ++cc) {
        const int ch = tid + 512 * cc;
#pragma unroll
        for (int t = 0; t < 4; ++t) {
            float xc = cb[cc];
#pragma unroll
            for (int k = 0; k < 4; ++k) xc += XX[(t + k) * 1024 + ch] * cw[cc][k];
            XC[t * 1024 + ch] = xc;
        }
    }
    __syncthreads();
#pragma unroll 1
    for (int cc = 0; cc < 2; ++cc) {
        const int ch = tid + 512 * cc, n = ch >> 7, e = ch & 127;
        const float* wa = p.in[19] + ((size_t)(l * 8 + n)) * 16384 + e;
        const float* wx = p.in[21] + ((size_t)(l * 8 + n)) * 16384 + e;
        float ga[4], gx[4];
#pragma unroll
        for (int k = 0; k < 4; ++k) { ga[k] = 0.f; gx[k] = 0.f; }
#pragma unroll 1
        for (int d0 = 0; d0 < 128; d0 += 16) {
            float av[16], xv[16];
#pragma unroll
            for (int i = 0; i < 16; ++i) { av[i] = wa[(d0 + i) * 128]; xv[i] = wx[(d0 + i) * 128]; }
#pragma unroll
            for (int i = 0; i < 16; ++i)
#pragma unroll
                for (int k = 0; k < 4; ++k) { const float v = XC[k * 1024 + n * 128 + d0 + i]; ga[k] += v * av[i]; gx[k] += v * xv[i]; }
        }
        const float bav = cc == 0 ? ba[0] : ba[1], bxv = cc == 0 ? bx[0] : bx[1], lamv = cc == 0 ? lam[0] : lam[1];
        const float sp = fmaxf(-lamv, 0.f) + flog(1.0f + fexp(-fabsf(lamv)));
        float hh = cc == 0 ? h0[0] : h0[1];
#pragma unroll
        for (int t = 0; t < 4; ++t) {
            const float r = sigmoidf_(ga[t] + bav), ii = sigmoidf_(gx[t] + bxv);
            const float la = -8.0f * r * sp;
            const float a = fexp(la), u = __builtin_amdgcn_sqrtf(1.0f - fexp(2.0f * la)) * ii * XC[t * 1024 + ch];
            hh = a * hh + u;
            const bf16_t gl = cc == 0 ? glv[0][t] : glv[1][t];
            if (!dry) zb[(size_t)(T_P + 4 * b + t) * NZ + ZC_GL + ch] = f2bf(hh * geluf_(bf2f(gl)));
        }
        p.out[O_LRUS + (size_t)(l * 128 + b) * 1024 + ch] = hh;
#pragma unroll
        for (int r = 0; r < 3; ++r) p.out[O_CVS + ((size_t)(l * 128 + b) * 3 + r) * 1024 + ch] = XX[(4 + r) * 1024 + ch];
    }
    __syncthreads();
}

__device__ void chain_items(const Params& p, int l, LAS unsigned char* lds) {
    int bid = blockIdx.x; asm volatile("" : "+s"(bid));
    if (bid < 32) linattn_prompt<false>(p, l, bid >> 2, bid & 3, lds, 0);
    else if (bid < 96) linattn_prompt<true>(p, l, (bid - 32) >> 3, (bid - 32) & 7, lds, 0);
    else if (bid < 160) {
        lru_prompt(p, l, (bid - 96) >> 3, (bid - 96) & 7, lds, 0);
    }
}
__device__ __forceinline__ void sample_item(const Params& p, int l, int it, LAS unsigned char* lds) {
    if (it >= 1152) linattn_sample<false>(p, l, (it - 1152) >> 2, (it - 1152) & 3, lds, 0);
    else if (it >= 128) linattn_sample<true>(p, l, (it - 128) >> 3, (it - 128) & 7, lds, 0);
    else lru_sample(p, l, it, lds, 0);
}
__device__ void sample_items(const Params& p, int l, LAS unsigned char* lds, int Gx, int cx) {
    if (Gx == 256) {
        if (cx < 128) { for (int k = 0; k < 5; ++k) sample_item(p, l, k == 0 ? cx : 128 + cx + 128 * (k - 1), lds); }
        else { for (int k = 0; k < 8; ++k) sample_item(p, l, 640 + (cx - 128) + 128 * k, lds); }
    } else {
        for (int it = cx; it < 1664; it += Gx) sample_item(p, l, it, lds);
    }
}

__device__ void fin_x(const Params& p, float* sst, float scale, int nsl, int Gx, int cx) {
    float* x = p.out; bf16_t* xb = (bf16_t*)(p.ws + WS_XB); const float* pb = (const float*)(p.ws + WS_MF);
    int tid = threadIdx.x; asm volatile("" : "+v"(tid));
    const int wid = tid >> 6, lane = tid & 63;
    for (int row = T_P + cx * 8 + wid; row < T_ALL; row += Gx * 8) {
        float s = 0.f;
#pragma unroll
        for (int i = 0; i < 4; ++i) {
            const int c = i * 256 + lane * 4;
            f32x4 ps;
            {
                const float* pr = pb + (size_t)(row - T_P) * DM + c;
                f32x4 q[11];
#pragma unroll
                for (int sl = 0; sl < 2; ++sl) q[sl] = *(const f32x4*)(pr + (size_t)sl * 512 * DM);
                if (nsl == 11) {
#pragma unroll
                    for (int sl = 2; sl < 11; ++sl) q[sl] = *(const f32x4*)(pr + (size_t)sl * 512 * DM);
                    ps = ((q[0] + q[1]) + (q[2] + q[3])) + ((q[4] + q[5]) + (q[6] + q[7])) + ((q[8] + q[9]) + q[10]);
                } else ps = q[0] + q[1];
            }
            const f32x4 v = *(const f32x4*)(x + (size_t)row * DM + c) + ps * scale;
            *(f32x4*)(x + (size_t)row * DM + c) = v;
            u32x2 w; w.x = pk2(v[0], v[1]); w.y = pk2(v[2], v[3]);
            *(u32x2*)(xb + (size_t)row * DM + c) = w;
            s += v[0] * v[0] + v[1] * v[1] + v[2] * v[2] + v[3] * v[3];
        }
#pragma unroll
        for (int o = 32; o >= 1; o >>= 1) s += __shfl_xor(s, o);
        if (lane == 0) sst[row] = s;
    }
}
__device__ void fin_m(const Params& p, int l, int Gx, int cx) {
    float* mf = (float*)(p.ws + WS_MF); bf16_t* zb = (bf16_t*)(p.ws + WS_Z);
    const float* mb = p.in[12] + l * 3 * DM;
    int tid = threadIdx.x; asm volatile("" : "+v"(tid));
    const int wid = tid >> 6, lane = tid & 63;
    for (int r = cx * 8 + wid; r < T_ALL - T_P; r += Gx * 8) {
        bf16_t* zr = zb + (size_t)(T_P + r) * NZ;
#pragma unroll
        for (int i = 0; i < 4; ++i) {
            const int c = i * 256 + lane * 4;
            f32x4 o = (f32x4){0.f, 0.f, 0.f, 0.f};
#pragma unroll
            for (int br = 0; br < 3; ++br) {
                float* pm = mf + ((size_t)br * 512 + r) * DM + c;
                const f32x4 v = *(const f32x4*)pm;
                const u32x2 gw = *(const u32x2*)(zr + ZC_GATE + br * DM + c);
                const f32x4 bb = *(const f32x4*)(mb + br * DM + c);
                o[0] += sigmoidf_(lo2f(gw.x) + bb[0]) * v[0]; o[1] += sigmoidf_(hi2f(gw.x) + bb[1]) * v[1];
                o[2] += sigmoidf_(lo2f(gw.y) + bb[2]) * v[2]; o[3] += sigmoidf_(hi2f(gw.y) + bb[3]) * v[3];
            }
            u32x2 w; w.x = pk2(o[0], o[1]); w.y = pk2(o[2], o[3]);
            *(u32x2*)(zr + c) = w;
        }
    }
}

__device__ __forceinline__ void gbar(unsigned* bar, unsigned& gen, unsigned nblk) {
    asm volatile("s_waitcnt vmcnt(0)" ::: "memory");
    __syncthreads();
    if (threadIdx.x == 0) {
        __builtin_amdgcn_fence(__ATOMIC_RELEASE, "agent");
        asm volatile("s_waitcnt vmcnt(0)" ::: "memory");
        const unsigned target = (gen + 1u) * nblk;
        __hip_atomic_fetch_add(bar, 1u, __ATOMIC_RELAXED, __HIP_MEMORY_SCOPE_AGENT);
        while (__hip_atomic_load(bar, __ATOMIC_RELAXED, __HIP_MEMORY_SCOPE_AGENT) < target) __builtin_amdgcn_s_sleep(1);
        __builtin_amdgcn_fence(__ATOMIC_ACQUIRE, "agent");
        asm volatile("s_waitcnt vmcnt(0)" ::: "memory");
    }
    gen += 1u;
    __syncthreads();
}


__global__ void __launch_bounds__(512) fwd_megakernel(Params p) {
    extern __shared__ __attribute__((aligned(16))) unsigned char smem_raw[];
    LAS unsigned char* lds = (LAS unsigned char*)smem_raw;
    cg::grid_group grid = cg::this_grid();
    using namespace pg8;
    const int G = gridDim.x, c = blockIdx.x;
    bf16_t* wb = (bf16_t*)(p.ws + WS_W);
    bf16_t* xb = (bf16_t*)(p.ws + WS_XB);
    bf16_t* zb = (bf16_t*)(p.ws + WS_Z);
    float* ss = (float*)(p.ws + WS_SS);
    float* x = p.out;

    constexpr int NCHAIN = 160;
    unsigned* gbar_w = (unsigned*)(p.ws + WS_BAR); unsigned bgen = 0u, sgen = 0u;
    bf16_t* hids = (bf16_t*)(p.ws + WS_HIDS) - (size_t)T_P * FH;
    phase0(p, lds);
    grid.sync();
#pragma unroll 1
    for (int l = 0; l < 2; ++l) {
        bf16_t* wl = wb + (size_t)l * W_LAYER;
        bf16_t* mrg = (l == 0) ? (bf16_t*)(p.out + O_RETS + (size_t)128 * 4 * 128 * 256) : wb;
#pragma unroll 1
        for (int seg = 0; seg < 3; ++seg) {
            const int role_s = __builtin_amdgcn_readfirstlane((seg == 1 && c >= NCHAIN) ? 1 : 0);
            const int nsteps = (seg == 0) ? 5 : (seg == 2) ? 4 : (role_s ? 7 : 1);
            int Gx = role_s ? (G - NCHAIN) : G, cx = role_s ? (c - NCHAIN) : c;
#pragma unroll 1
            for (int idx = 0; idx < nsteps; ++idx) {
                asm volatile("" : "+s"(Gx), "+s"(cx));
                int op, f = 0, kx = 1, rows = 0;
                if (seg == 0) { op = (idx == 0) ? 0 : (idx == 1) ? 1 : (idx == 2) ? 8 : (idx == 3) ? 2 : 6; rows = (idx == 0 || idx == 3) ? 2 : 0; }
                else if (seg == 2) { op = (idx == 0) ? 4 : (idx == 1) ? 5 : (idx == 2) ? 0 : 1; f = idx >= 2; }
                else if (!role_s) op = 3;
                else { op = (idx == 0) ? 9 : (idx == 1) ? 10 : (idx == 2) ? 11 : (idx == 3 || idx == 6) ? 8 : (idx == 4) ? 0 : 7; f = idx >= 4; kx = (idx == 3) ? 2 : 3; rows = 1; }
                op = __builtin_amdgcn_readfirstlane(op); f = __builtin_amdgcn_readfirstlane(f); kx = __builtin_amdgcn_readfirstlane(kx); rows = __builtin_amdgcn_readfirstlane(rows);
                const int Mx = (rows == 2) ? T_ALL : (rows == 1) ? (T_ALL - T_P) : T_P, pm0 = (rows == 1) ? (T_P / 256) : 0;
#pragma unroll 1
                for (int rep = 0; rep < ((seg == 0 && idx == 1) ? 2 : 1); ++rep) {
                if (rep == 1) op = 7;
                if (op == 0) {
                    Gemm g{xb, xb, xb, wl + (f == 0 ? OFF_GU1 : OFF_GU2), 0, DM, DM, DM}; StaticOrder so; so.init(Mx, 2 * FH, Gx, cx, pm0);
                    EpiUp e{zb, hids, ss + (size_t)(3 * l + 2 * f) * T_ALL}; gemm_phase(lds, g, so, e);
                } else if (op == 1) {
                    Gemm g{zb, zb, zb, wl + (f == 0 ? OFF_D1 : OFF_D2), 0, FH, FH, FH}; StaticOrder so; so.init(Mx, DM, Gx, cx, pm0);
                    EpiRes e{x, xb, ss + (size_t)(3 * l + 2 * f + 1) * T_ALL, 0.5f, 0}; gemm_phase(lds, g, so, e);
                } else if (op == 2) {
                    Gemm g{xb, xb, xb, wl + OFF_WIN, 0, DM, DM, DM}; StaticOrder so; so.init(Mx, NZ, Gx, cx, pm0);
                    EpiWin e{zb, ss + (size_t)(3 * l + 1) * T_ALL, l == 1 ? (const float*)(p.ws + WS_LB) : (const float*)nullptr, (const float2*)(p.ws + WS_ROPE)}; gemm_phase(lds, g, so, e);
                } else if (op == 3) {
                    chain_items(p, l, lds);
                } else if (op == 4) {
                    Gemm g{l == 0 ? og_compact(p, 0) : zb + ZC_GR, l == 0 ? og_compact(p, 1) : zb + ZC_GH, l == 0 ? og_compact(p, 2) : zb + ZC_GL, wl + OFF_RO, (size_t)DM * DM, l == 0 ? DM : NZ, DM, DM}; BranchOrder bo; bo.so.init(Mx, DM, Gx, cx, pm0);
                    EpiBranch e{zb, mrg, p.in[12] + l * 3 * DM, 0}; gemm_phase(lds, g, bo, e);
                } else if (op == 5) {
                    Gemm g{mrg, mrg, mrg, wl + OFF_MO, 0, DM, DM, DM}; StaticOrder so; so.init(Mx, DM, Gx, cx, pm0);
                    EpiRes e{x, xb, ss + (size_t)(3 * l + 2) * T_ALL, 1.0f, 0}; gemm_phase(lds, g, so, e);
                } else if (op == 6) {
                    sample_items(p, l, lds, Gx, cx);
                } else if (op == 7 || op == 9 || op == 11) {
                    const bool dn = (op == 7), brn = (op == 9);
                    const int klen = dn ? 256 : (brn ? 1024 : 512), nspl = dn ? 11 : (brn ? 1 : 2);
                    Gemm g{dn ? hids : (brn ? zb + ZC_GR : zb), zb + ZC_GH, zb + ZC_GL, wl + (dn ? (f == 0 ? OFF_D1 : OFF_D2) : (brn ? OFF_RO : OFF_MO)), (size_t)DM * DM, dn ? FH : NZ, dn ? FH : DM, klen};
                    SplitOrder so{2, 4, brn ? 3 : 1, nspl, klen, Gx, cx, T_P / 256};
                    EpiStoreP e{(float*)(p.ws + WS_MF), klen, nspl}; gemm_phase(lds, g, so, e);
                } else if (op == 8) {
                    fin_x(p, ss + (size_t)(3 * l + kx) * T_ALL, kx == 2 ? 1.0f : 0.5f, kx == 2 ? 2 : 11, Gx, cx);
                } else {
                    fin_m(p, l, Gx, cx);
                }
                }
                if (seg == 1) { if (role_s && idx + 1 < nsteps) gbar(gbar_w + 64, sgen, (unsigned)(G - NCHAIN)); }
                else gbar(gbar_w, bgen, (unsigned)G);
            }
            if (seg == 1 && l == 0) {
                unsigned* qctr = (unsigned*)(p.ws + WS_CTR) + 8;
                LAS unsigned* slot = (LAS unsigned*)(lds + LDS_BYTES - 16);
                for (;;) {
                    __syncthreads();
                    if (threadIdx.x == 0) *slot = atomicAdd(qctr, 1u);
                    __syncthreads();
                    const int ti = __builtin_amdgcn_readfirstlane((int)*slot);
                    if (ti >= 2080) break;
                    conv_job(p, 2080 + ti, (LAS float*)lds);
                }
            }
            if (seg == 1) {
                gbar(gbar_w, bgen, (unsigned)G);
            }
        }
    }
    {
        const float* ssf = ss + (size_t)6 * T_ALL;
        int tid = threadIdx.x; asm volatile("" : "+v"(tid));
        const int wid = tid >> 6, lane = tid & 63;
        for (int row = c * 8 + wid; row < T_ALL; row += G * 8) {
            const float r = frsq(ssf[row] * (1.0f / 1024.0f) + 1e-6f);
#pragma unroll
            for (int i = 0; i < 4; ++i) {
                const int col = i * 256 + lane * 4;
                f32x4 v = *(f32x4*)(x + (size_t)row * DM + col);
                const f32x4 gn = *(const f32x4*)(p.in[30] + col);
                v = v * r * gn;
                *(f32x4*)(x + (size_t)row * DM + col) = v;
            }
        }
    }
}

extern "C" void kernel_launch(void* const* d_in, const int* in_sizes, int n_in, void* d_out, int out_size, void* d_ws, size_t ws_size, hipStream_t stream) {
    static int grid = 0;
    if (grid == 0) {
        if (n_in != 31 || ws_size < WS_END) { fprintf(stderr, "kernel_launch: need 31 inputs and %zu bytes of workspace (got %d, %zu)\n", (size_t)WS_END, n_in, ws_size); grid = -1; return; }
        int dev = 0, cus = 0, per_cu = 0;
        hipGetDevice(&dev);
        hipDeviceGetAttribute(&cus, hipDeviceAttributeMultiprocessorCount, dev);
        if (hipFuncSetAttribute((const void*)fwd_megakernel, hipFuncAttributeMaxDynamicSharedMemorySize, LDS_BYTES) != hipSuccess) { fprintf(stderr, "kernel_launch: hipFuncSetAttribute failed\n"); grid = -1; return; }
        hipOccupancyMaxActiveBlocksPerMultiprocessor(&per_cu, (const void*)fwd_megakernel, 512, LDS_BYTES);
        if (per_cu < 1) { fprintf(stderr, "kernel_launch: occupancy query says %d blocks per CU\n", per_cu); per_cu = 1; }
        (void)hipGetLastError();
        grid = cus;
    }
    if (grid < 0) return;
    if (hipMemsetAsync((char*)d_ws + WS_BAR, 0, 512, stream) != hipSuccess) { fprintf(stderr, "kernel_launch: memset failed\n"); return; }
    Params p{};
    for (int i = 0; i < 31; ++i) p.in[i] = (const float*)d_in[i];
    p.out = (float*)d_out; p.ws = (unsigned char*)d_ws;
    void* args[] = {&p};
    hipError_t e = hipLaunchCooperativeKernel((const void*)fwd_megakernel, dim3(grid), dim3(512), args, LDS_BYTES, stream);
    if (e != hipSuccess) fprintf(stderr, "cooperative launch failed: %s (grid %d)\n", hipGetErrorString(e), grid);
}
```
